# Optimizing an MI355X kernel written in HIP

```python
import jax, jax.numpy as jnp
from jax import lax
import numpy as np

D_MODEL = 2048
BATCH = 16
SEQ = 256
DEPTH = 2
DEC_BATCH = 4
DEC_SEQ = 1024
PAST_LEN = 512

f32 = jnp.float32
GRID_W = 64
MIX_W = D_MODEL
MLA_W = MIX_W // 2
LRU_W = MIX_W // 4
CONV_W = MIX_W // 4
V_HEAD = 128
MLA_HEADS = MLA_W // V_HEAD
QK_NOPE = 128
QK_ROPE = 64
QK_HEAD = QK_NOPE + QK_ROPE
Q_LORA = D_MODEL // 4
KV_LORA = D_MODEL // 8
ROPE_THETA = 10000.0
Q_BLOCK = 128
LRU_HEADS = 8
LRU_HD = LRU_W // LRU_HEADS
LRU_CONV = 4
RG_C = 8.0
CM_K = 31
PEER_HEADS = 8
N_KEYS = 128
N_EXPERTS = N_KEYS * N_KEYS
PEER_QDIM = 256
PEER_TOPK = 16
TOK_BLOCK = 128
IN_SPLITS = (Q_LORA, KV_LORA, QK_ROPE, LRU_W, LRU_W, 2 * CONV_W)
IN_W = Q_LORA + KV_LORA + QK_ROPE + 2 * LRU_W + 2 * CONV_W
EPS = 1e-6

kernel_name = 'hymba_mla_rglru_conformer_peer_dit_step'


def rms_norm(x, g):
    xf = x.astype(f32)
    y = xf * lax.rsqrt(jnp.mean(xf * xf, -1, keepdims=True) + EPS)
    return (y * g.astype(f32)).astype(x.dtype)


def layer_norm(x, g, b):
    xf = x.astype(f32)
    mu = jnp.mean(xf, -1, keepdims=True)
    var = jnp.mean(jnp.square(xf - mu), -1, keepdims=True)
    return ((xf - mu) * lax.rsqrt(var + 1e-5) * g.astype(f32) + b.astype(f32)).astype(x.dtype)


def depthwise_conv(x, w, b, pad_l, pad_r):
    y = lax.conv_general_dilated(x, w[:, None, :].astype(x.dtype), window_strides=(1,),
                                 padding=[(pad_l, pad_r)], dimension_numbers=('NWC', 'WIO', 'NWC'),
                                 feature_group_count=x.shape[-1])
    return y + b


def axial_rope(n_tokens):
    n_rows = n_tokens // GRID_W
    row = jnp.repeat(jnp.arange(n_rows), GRID_W).astype(f32)
    col = jnp.tile(jnp.arange(GRID_W), n_rows).astype(f32)
    n_freq = QK_ROPE // 4
    inv = 1.0 / (ROPE_THETA ** (jnp.arange(n_freq, dtype=f32) / n_freq))
    ang = jnp.concatenate([row[:, None] * inv, col[:, None] * inv], -1)
    return jnp.cos(ang), jnp.sin(ang)


def rope_tail(x, cos, sin):
    r = x[..., QK_NOPE:].astype(f32)
    r1, r2 = jnp.split(r, 2, -1)
    rot = jnp.concatenate([r1 * cos - r2 * sin, r1 * sin + r2 * cos], -1).astype(x.dtype)
    return jnp.concatenate([x[..., :QK_NOPE], rot], -1)


def mla_kv(ckv, krope, w_kvb, k_g):
    B, T, _ = ckv.shape
    kv = (ckv @ w_kvb).reshape(B, T, MLA_HEADS, QK_NOPE + V_HEAD)
    k_nope, v = kv[..., :QK_NOPE], kv[..., QK_NOPE:]
    k_r = jnp.broadcast_to(krope[:, :, None, :], (B, T, MLA_HEADS, QK_ROPE)).astype(k_nope.dtype)
    k = rms_norm(jnp.concatenate([k_nope, k_r], -1), k_g)
    return k, v


def block_attention(q, k, v):
    B, Tq, H, dk = q.shape
    nb = Tq // Q_BLOCK
    qb = jnp.moveaxis(q.reshape(B, nb, Q_BLOCK, H, dk), 1, 0)
    scale = dk ** -0.5

    def one(q_blk):
        s = jnp.einsum('bqhd,bkhd->bhqk', q_blk, k).astype(f32) * scale
        p = jax.nn.softmax(s, -1).astype(v.dtype)
        return jnp.einsum('bhqk,bkhd->bqhd', p, v)

    o = lax.map(one, qb)
    return jnp.moveaxis(o, 0, 1).reshape(B, Tq, H, v.shape[-1])


def bidir_rglru(xc, w_a, b_a, w_i, b_i, lam, h0):
    B, T, W = xc.shape
    xh = xc.reshape(B, T, LRU_HEADS, LRU_HD)
    r = jax.nn.sigmoid((jnp.einsum('bthi,dhij->dbthj', xh, w_a).reshape(2, B, T, W)
                        + b_a[:, None, None, :]).astype(f32))
    i = jax.nn.sigmoid((jnp.einsum('bthi,dhij->dbthj', xh, w_i).reshape(2, B, T, W)
                        + b_i[:, None, None, :]).astype(f32))
    log_a = -RG_C * r * jax.nn.softplus(-lam.astype(f32))[:, None, None, :]
    a = jnp.exp(log_a)
    u = jnp.sqrt(-jnp.expm1(2.0 * log_a)) * i * xc.astype(f32)[None]
    a = jnp.stack([a[0], a[1][:, ::-1]])
    u = jnp.stack([u[0], u[1][:, ::-1]])

    def step(h, au):
        a_t, u_t = au
        h = a_t * h + u_t
        return h, h

    h_fin, hs = lax.scan(step, h0, (jnp.moveaxis(a, 2, 0), jnp.moveaxis(u, 2, 0)))
    hs = jnp.moveaxis(hs, 0, 2)
    return hs[0] + hs[1][:, ::-1], h_fin


def conformer_conv(zc, dw_w, dw_b, ln_g, ln_b):
    a, b = jnp.split(zc, 2, -1)
    h = a * jax.nn.sigmoid(b)
    h = depthwise_conv(h, dw_w, dw_b, CM_K // 2, CM_K // 2)
    h = layer_norm(h, ln_g, ln_b)
    return jax.nn.silu(h)


def peer(h, w_q, sub_keys, u, v):
    B, T, D = h.shape
    n = B * T
    hf = h.reshape(n, D)
    q = (hf @ w_q).reshape(n, PEER_HEADS, 2, PEER_QDIM // 2)
    s = jnp.einsum('nhpd,hpkd->nhpk', q, sub_keys).astype(f32)
    s1, i1 = lax.top_k(s[:, :, 0], PEER_TOPK)
    s2, i2 = lax.top_k(s[:, :, 1], PEER_TOPK)
    cand_s = (s1[..., :, None] + s2[..., None, :]).reshape(n, PEER_HEADS, PEER_TOPK * PEER_TOPK)
    cand_i = (i1[..., :, None] * N_KEYS + i2[..., None, :]).reshape(n, PEER_HEADS, PEER_TOPK * PEER_TOPK)
    top_s, pos = lax.top_k(cand_s, PEER_TOPK)
    idx = jnp.take_along_axis(cand_i, pos, -1)
    gate = jax.nn.softmax(top_s, -1)
    nblk = n // TOK_BLOCK
    idx = idx.reshape(nblk, TOK_BLOCK, PEER_HEADS * PEER_TOPK)
    gate = gate.reshape(nblk, TOK_BLOCK, PEER_HEADS * PEER_TOPK)
    xb = hf.reshape(nblk, TOK_BLOCK, D)

    def apply(args):
        x_b, i_b, g_b = args
        act = jax.nn.gelu(jnp.einsum('tkd,td->tk', u[i_b], x_b).astype(f32))
        wgt = (g_b * act).astype(x_b.dtype)
        return jnp.einsum('tk,tkd->td', wgt, v[i_b])

    out = lax.map(apply, (xb, idx, gate))
    return out.reshape(B, T, D)


def trunk_layer(x, cvec, p, ctx_ckv=None, ctx_krope=None, h0=None):
    latent = ctx_ckv is not None
    B, T, _ = x.shape
    mod = jax.nn.silu(cvec) @ p['ada_w'] + p['ada_b']
    sh1, sc1, g1, sh2, sc2, g2 = jnp.split(mod[:, None, :], 6, -1)
    hn = rms_norm(x, p['norm_mix_g']) * (1 + sc1) + sh1
    offs = [int(o) for o in np.cumsum(IN_SPLITS)[:-1]]
    zq, zkv, zkr, zx, zg, zc = jnp.split(hn @ p['w_in'], offs, -1)
    q = (rms_norm(zq, p['mla_qa_g']) @ p['mla_w_qb']).reshape(B, T, MLA_HEADS, QK_HEAD)
    q = rms_norm(q, p['mla_q_g'])
    ckv = rms_norm(zkv, p['mla_kva_g'])
    k, v = mla_kv(ckv, zkr, p['mla_w_kvb'], p['mla_k_g'])
    if latent:
        cos, sin = axial_rope(T)
        cos, sin = cos[:, None, :], sin[:, None, :]
        q = rope_tail(q, cos, sin)
        k = rope_tail(k, cos, sin)
        kc, vc = mla_kv(ctx_ckv, ctx_krope, p['mla_w_kvb'], p['mla_k_g'])
        k = jnp.concatenate([kc, k], 1)
        v = jnp.concatenate([vc, v], 1)
    else:
        h0 = jnp.zeros((2, B, LRU_W), f32)
    attn = block_attention(q, k, v).reshape(B, T, MLA_W)
    xc = depthwise_conv(zx, p['lru_conv_w'], p['lru_conv_b'], 2, 1)
    y_lru, h_fin = bidir_rglru(xc, p['lru_w_a'], p['lru_b_a'], p['lru_w_i'], p['lru_b_i'], p['lru_lam'], h0)
    lru = y_lru.astype(x.dtype) * jax.nn.gelu(zg)
    conv = conformer_conv(zc, p['cm_dw_w'], p['cm_dw_b'], p['cm_ln_g'], p['cm_ln_b'])
    g_att, g_lru, g_conv = jnp.split(p['grp_g'], [MLA_W, MLA_W + LRU_W])
    mixed = jnp.concatenate([rms_norm(attn, g_att), rms_norm(lru, g_lru), rms_norm(conv, g_conv)], -1)
    x = x + g1 * (mixed @ p['w_out'])
    hf = rms_norm(x, p['norm_ffn_g']) * (1 + sc2) + sh2
    x = x + g2 * peer(hf, p['peer_w_q'], p['peer_keys'], p['peer_u'], p['peer_v'])
    return x, ckv, zkr, jnp.swapaxes(h_fin, 0, 1).astype(x.dtype)


def setup_inputs(seed: int = 0) -> dict:
    key = jax.random.key(seed)
    ks = iter(jax.random.split(key, 48))

    def nrm(shape, scale=1.0):
        return scale * jax.random.normal(next(ks), shape, f32)

    def gain(shape):
        return 1.0 + nrm(shape, 0.01)

    L = DEPTH
    s_lam = jax.random.uniform(next(ks), (L, 2, LRU_W), f32, 0.9, 0.999) ** (1.0 / RG_C)
    return {
        'x_prompt': nrm((BATCH, SEQ, D_MODEL)),
        'x_sample': nrm((DEC_BATCH, DEC_SEQ, D_MODEL)),
        'cache_ckv': nrm((DEC_BATCH, L, PAST_LEN, KV_LORA)),
        'cache_krope': nrm((DEC_BATCH, L, PAST_LEN, QK_ROPE)),
        'state_lru': nrm((DEC_BATCH, L, 2, LRU_W), 0.5),
        'c': nrm((DEC_BATCH, D_MODEL)),
        'c_ctx': nrm((D_MODEL,)),
        'ada_w': nrm((L, D_MODEL, 6 * D_MODEL), 0.5 * D_MODEL ** -0.5),
        'ada_b': nrm((L, 6 * D_MODEL), 0.01),
        'norm_mix_g': gain((L, D_MODEL)),
        'w_in': nrm((L, D_MODEL, IN_W), D_MODEL ** -0.5),
        'mla_qa_g': gain((L, Q_LORA)),
        'mla_w_qb': nrm((L, Q_LORA, MLA_HEADS * QK_HEAD), Q_LORA ** -0.5),
        'mla_q_g': gain((L, QK_HEAD)),
        'mla_kva_g': gain((L, KV_LORA)),
        'mla_w_kvb': nrm((L, KV_LORA, MLA_HEADS * (QK_NOPE + V_HEAD)), KV_LORA ** -0.5),
        'mla_k_g': gain((L, QK_HEAD)),
        'lru_conv_w': nrm((L, LRU_CONV, LRU_W), LRU_CONV ** -0.5),
        'lru_conv_b': nrm((L, LRU_W), 0.01),
        'lru_w_a': nrm((L, 2, LRU_HEADS, LRU_HD, LRU_HD), LRU_HD ** -0.5),
        'lru_b_a': nrm((L, 2, LRU_W), 0.01),
        'lru_w_i': nrm((L, 2, LRU_HEADS, LRU_HD, LRU_HD), LRU_HD ** -0.5),
        'lru_b_i': nrm((L, 2, LRU_W), 0.01),
        'lru_lam': jnp.log(s_lam) - jnp.log1p(-s_lam),
        'cm_dw_w': nrm((L, CM_K, CONV_W), CM_K ** -0.5),
        'cm_dw_b': nrm((L, CONV_W), 0.01),
        'cm_ln_g': gain((L, CONV_W)),
        'cm_ln_b': nrm((L, CONV_W), 0.01),
        'grp_g': gain((L, MIX_W)),
        'w_out': nrm((L, MIX_W, D_MODEL), MIX_W ** -0.5),
        'norm_ffn_g': gain((L, D_MODEL)),
        'peer_w_q': nrm((L, D_MODEL, PEER_HEADS * PEER_QDIM), D_MODEL ** -0.5),
        'peer_keys': nrm((L, PEER_HEADS, 2, N_KEYS, PEER_QDIM // 2), (PEER_QDIM // 2) ** -0.5),
        'peer_u': nrm((L, N_EXPERTS, D_MODEL), D_MODEL ** -0.5),
        'peer_v': nrm((L, N_EXPERTS, D_MODEL), 0.25),
    }


def reference(x_prompt, x_sample, cache_ckv, cache_krope, state_lru, c, c_ctx,
              ada_w, ada_b, norm_mix_g, w_in, mla_qa_g, mla_w_qb, mla_q_g, mla_kva_g, mla_w_kvb, mla_k_g,
              lru_conv_w, lru_conv_b, lru_w_a, lru_b_a, lru_w_i, lru_b_i, lru_lam,
              cm_dw_w, cm_dw_b, cm_ln_g, cm_ln_b, grp_g, w_out, norm_ffn_g,
              peer_w_q, peer_keys, peer_u, peer_v):
    stacked = {
        'ada_w': ada_w, 'ada_b': ada_b, 'norm_mix_g': norm_mix_g, 'w_in': w_in,
        'mla_qa_g': mla_qa_g, 'mla_w_qb': mla_w_qb, 'mla_q_g': mla_q_g, 'mla_kva_g': mla_kva_g,
        'mla_w_kvb': mla_w_kvb, 'mla_k_g': mla_k_g,
        'lru_conv_w': lru_conv_w, 'lru_conv_b': lru_conv_b, 'lru_w_a': lru_w_a, 'lru_b_a': lru_b_a,
        'lru_w_i': lru_w_i, 'lru_b_i': lru_b_i, 'lru_lam': lru_lam,
        'cm_dw_w': cm_dw_w, 'cm_dw_b': cm_dw_b, 'cm_ln_g': cm_ln_g, 'cm_ln_b': cm_ln_b,
        'grp_g': grp_g, 'w_out': w_out, 'norm_ffn_g': norm_ffn_g,
        'peer_w_q': peer_w_q, 'peer_keys': peer_keys, 'peer_u': peer_u, 'peer_v': peer_v,
    }
    yp, ys = x_prompt, x_sample
    ckv_list, kr_list, h_list = [], [], []
    for l in range(DEPTH):
        p = {name: arr[l] for name, arr in stacked.items()}
        yp, ckv_l, kr_l, h_l = trunk_layer(yp, c_ctx[None, :], p)
        ckv_list.append(ckv_l)
        kr_list.append(kr_l)
        h_list.append(h_l)
        h0 = jnp.swapaxes(state_lru[:, l], 0, 1).astype(f32)
        ys, _, _, _ = trunk_layer(ys, c, p, cache_ckv[:, l], cache_krope[:, l], h0)
    new_ckv = jnp.stack(ckv_list, 1)
    new_krope = jnp.stack(kr_list, 1)
    new_lru = jnp.stack(h_list, 1)
    return (yp, ys, new_ckv, new_krope, new_lru)
```

```cpp
#include <hip/hip_runtime.h>
#include <hip/hip_cooperative_groups.h>
#include <cstdio>
#include <cstdint>
namespace cg = cooperative_groups;

typedef unsigned short ushort_t;
typedef __attribute__((ext_vector_type(8))) short bf16x8;
typedef __attribute__((ext_vector_type(16))) float f32x16;
typedef __attribute__((ext_vector_type(4))) unsigned u32x4;
typedef __attribute__((ext_vector_type(4))) float f32x4;
typedef __attribute__((ext_vector_type(2))) float f32x2_t;
typedef __attribute__((ext_vector_type(2))) __bf16 bf16x2_t;
#define DI __device__ __forceinline__
#define GAS __attribute__((address_space(1)))
#define GLD16(ptr) (*(const GAS u32x4*)(ptr))
#define MFMA32(a, b, c) __builtin_amdgcn_mfma_f32_32x32x16_bf16((a), (b), (c), 0, 0, 0)

#define DM 2048
#define NTOK 8192
#define NCTX 4096
#define INW 2880
#define NKV 10240
#define OFF_ZKV 512
#define OFF_ZKR 768
#define OFF_ZX 832
#define OFF_ZG 1344
#define OFF_ZC 1856
#define NEXP 16384
#define SMEM_BYTES 78848
#ifndef REP_A
#define REP_A 1
#define REP_B 1
#define REP_C 1
#define REP_D 1
#endif

struct Params {
  const float *x_prompt, *x_sample, *cache_ckv, *cache_krope, *state_lru, *c, *c_ctx;
  const float *ada_w, *ada_b, *norm_mix_g, *w_in, *mla_qa_g, *mla_w_qb, *mla_q_g, *mla_kva_g, *mla_w_kvb, *mla_k_g;
  const float *lru_conv_w, *lru_conv_b, *lru_w_a, *lru_b_a, *lru_w_i, *lru_b_i, *lru_lam;
  const float *cm_dw_w, *cm_dw_b, *cm_ln_g, *cm_ln_b, *grp_g, *w_out, *norm_ffn_g;
  const float *peer_w_q, *peer_keys, *peer_u, *peer_v;
  float* out;
  unsigned* bar;
  ushort_t *WinT, *WqbT, *WkvbT, *WoutT, *WpqT, *KeysB, *LruW;
  unsigned char *Ub, *Vb;
  float *Us, *Vs;
  ushort_t *hn, *qa, *ckv, *Q, *K, *Vt, *mixed;
  ushort_t *qraw, *kvraw, *attn, *hs, *Pc;
  float *z, *hend, *Pend, *x1, *xA, *mod, *rope;
};

DI unsigned pack_bf16(float lo, float hi) { f32x2_t v = {lo, hi}; bf16x2_t b = __builtin_convertvector(v, bf16x2_t); return __builtin_bit_cast(unsigned, b); }
DI ushort_t f2bf(float x) { return (ushort_t)(pack_bf16(x, 0.f) & 0xffffu); }
DI float bf_lo(unsigned u) { return __uint_as_float(u << 16); }
DI float bf_hi(unsigned u) { return __uint_as_float(u & 0xffff0000u); }
DI float wave_sum(float v) { for (int o = 32; o; o >>= 1) v += __shfl_xor(v, o); return v; }
DI float sigmoidf_(float x) { return 1.f / (1.f + __expf(-x)); }
DI float gelu_tanh(float x) { return 0.5f * x * (1.f + tanhf(0.7978845608028654f * (x + 0.044715f * x * x * x))); }
DI int crow(int reg, int h) { return (reg & 3) + 8 * (reg >> 2) + 4 * h; }
DI int cvidx(int t) { return t < NCTX ? 0 : 1 + ((t - NCTX) >> 10); }
DI int kvrow_of_token(int t) { if (t < NCTX) return t; int tl = t - NCTX; return NCTX + (tl >> 10) * 1536 + 512 + (tl & 1023); }
DI const float* xrow_in(const Params& p, int l, int t) {
  if (l == 0) return t < NCTX ? p.x_prompt + (size_t)t * DM : p.x_sample + (size_t)(t - NCTX) * DM;
  return p.xA + (size_t)t * DM;
}
DI float dot2bf(unsigned a, unsigned b, float acc) { return __builtin_amdgcn_fdot2_f32_bf16(__builtin_bit_cast(bf16x2_t, a), __builtin_bit_cast(bf16x2_t, b), acc, false); }
DI int opaque(int x) { asm volatile("" : "+v"(x)); return x; }
DI float rdlane_f(float v, int l) { return __int_as_float(__builtin_amdgcn_readlane(__float_as_int(v), l)); }

#define GLD 72
template <class Epi>
DI void gemm_tile(const ushort_t* A, int lda, const ushort_t* Bt, int ldb, int K, int N, int m0, int n0, char* smem, Epi epi) {
  ushort_t* sA = (ushort_t*)smem;
  ushort_t* sB = sA + 128 * GLD;
  const int tid = opaque(threadIdx.x), wave = tid >> 6, lane = tid & 63, wm = wave & 1, wn = wave >> 1;
  const int r = lane & 31, h = lane >> 5;
  f32x16 acc[2][2];
#pragma unroll
  for (int i = 0; i < 2; i++)
#pragma unroll
    for (int j = 0; j < 2; j++)
#pragma unroll
      for (int e = 0; e < 16; e++) acc[i][j][e] = 0.f;
  u32x4 ra0[4], rb0[4], ra1[4], rb1[4];
  const int lrow = tid >> 3, lkc = (tid & 7) * 8;
  const ushort_t* Ap = A + (size_t)(m0 + lrow) * lda + lkc;
  const ushort_t* Bp[4];
#pragma unroll
  for (int i = 0; i < 4; i++) { int br = n0 + lrow + 32 * i; br = br < N ? br : N - 1; Bp[i] = Bt + (size_t)br * ldb + lkc; }
  auto gload = [&](u32x4* ra, u32x4* rb, int k0) {
#pragma unroll
    for (int i = 0; i < 4; i++) {
      ra[i] = GLD16(Ap + (size_t)(32 * i) * lda + k0);
      rb[i] = GLD16(Bp[i] + k0);
    }
  };
  auto lstore = [&](const u32x4* ra, const u32x4* rb, int buf) {
    ushort_t* dA = sA + buf * (2 * 128 * GLD) + lrow * GLD + lkc;
    ushort_t* dB = sB + buf * (2 * 128 * GLD) + lrow * GLD + lkc;
#pragma unroll
    for (int i = 0; i < 4; i++) { *(u32x4*)(dA + 32 * i * GLD) = ra[i]; *(u32x4*)(dB + 32 * i * GLD) = rb[i]; }
  };
  auto compute = [&](int buf) {
    const ushort_t* cA = sA + buf * (2 * 128 * GLD);
    const ushort_t* cB = sB + buf * (2 * 128 * GLD);
#pragma unroll
    for (int ks = 0; ks < 4; ks++) {
      bf16x8 a[2], b[2];
#pragma unroll
      for (int i = 0; i < 2; i++) {
        a[i] = *(const bf16x8*)(cA + (wm * 64 + i * 32 + r) * GLD + ks * 16 + h * 8);
        b[i] = *(const bf16x8*)(cB + (wn * 64 + i * 32 + r) * GLD + ks * 16 + h * 8);
      }
#pragma unroll
      for (int i = 0; i < 2; i++)
#pragma unroll
        for (int j = 0; j < 2; j++) acc[i][j] = MFMA32(a[i], b[j], acc[i][j]);
    }
  };
  gload(ra0, rb0, 0);
  gload(ra1, rb1, 64);
  lstore(ra0, rb0, 0);
  __syncthreads();
  const int klast = K - 64;
  gload(ra0, rb0, 128 < K ? 128 : klast);
  for (int k0 = 0; k0 < K; k0 += 128) {
    compute(0);
    lstore(ra1, rb1, 1);
    __syncthreads();
    gload(ra1, rb1, k0 + 192 < K ? k0 + 192 : klast);
    compute(1);
    lstore(ra0, rb0, 0);
    __syncthreads();
    gload(ra0, rb0, k0 + 256 < K ? k0 + 256 : klast);
  }
#pragma unroll
  for (int i = 0; i < 2; i++)
#pragma unroll
    for (int j = 0; j < 2; j++)
#pragma unroll
      for (int e = 0; e < 16; e++) {
        int row = m0 + wm * 64 + i * 32 + crow(e, h);
        int col = n0 + wn * 64 + j * 32 + r;
        if (col < N) epi(row, col, acc[i][j][e]);
      }
  __syncthreads();
}

DI void transpose_item(const float* src, int lds_, ushort_t* dst, int ldd, int kt, int nt, float* tile) {
  int tid = opaque(threadIdx.x); int c = tid & 63, r0 = tid >> 6;
#pragma unroll 4
  for (int i = 0; i < 16; i++) { int r = r0 + 4 * i; tile[r * 65 + c] = src[(size_t)(kt * 64 + r) * lds_ + nt * 64 + c]; }
  __syncthreads();
#pragma unroll 4
  for (int i = 0; i < 16; i++) { int r = r0 + 4 * i; dst[(size_t)(nt * 64 + r) * ldd + kt * 64 + c] = f2bf(tile[c * 65 + r]); }
  __syncthreads();
}

DI void convert_chunk(const float* src, ushort_t* dst, size_t base) {
  int tid = opaque(threadIdx.x);
#pragma unroll
  for (int it = 0; it < 4; it++) {
    size_t e = base + it * 2048 + tid * 8;
    float4 a = *(const float4*)(src + e), b = *(const float4*)(src + e + 4);
    uint4 o; o.x = pack_bf16(a.x, a.y); o.y = pack_bf16(a.z, a.w); o.z = pack_bf16(b.x, b.y); o.w = pack_bf16(b.z, b.w);
    *(uint4*)(dst + e) = o;
  }
}


DI void quant_rows(const float* src, unsigned char* dst, float* scl, size_t row0) {
  int tid = opaque(threadIdx.x); int wave = tid >> 6, lane = tid & 63;
  size_t row = row0 + wave;
  const float* r = src + row * DM;
  float4 v[8]; float am = 0.f;
#pragma unroll
  for (int j = 0; j < 8; j++) { v[j] = *(const float4*)(r + (j * 64 + lane) * 4); am = fmaxf(am, fmaxf(fmaxf(fabsf(v[j].x), fabsf(v[j].y)), fmaxf(fabsf(v[j].z), fabsf(v[j].w)))); }
  for (int o = 32; o; o >>= 1) am = fmaxf(am, __shfl_xor(am, o));
  float sc = am > 0.f ? 224.f / am : 1.f;
  if (lane == 0) scl[row] = am > 0.f ? am * (1.f / 224.f) : 1.f;
#pragma unroll
  for (int j = 0; j < 8; j++) {
    int w = 0;
    w = __builtin_amdgcn_cvt_pk_fp8_f32(v[j].x * sc, v[j].y * sc, w, false);
    w = __builtin_amdgcn_cvt_pk_fp8_f32(v[j].z * sc, v[j].w * sc, w, true);
    *(int*)(dst + row * DM + (j * 64 + lane) * 4) = w;
  }
}

DI void mod_item(const Params& p, int item, char* smem) {
  int l = item / 48, cgp = item % 48;
  float* s = (float*)smem;
  float* red = s + 5 * 2048;
  int tid = opaque(threadIdx.x), wave = tid >> 6, lane = tid & 63;
  for (int i = tid; i < 5 * 2048; i += 256) {
    int cv = i >> 11, k = i & 2047;
    float v = cv == 0 ? p.c_ctx[k] : p.c[(cv - 1) * DM + k];
    s[i] = v * sigmoidf_(v);
  }
  __syncthreads();
  const float* W = p.ada_w + (size_t)l * DM * 12288 + cgp * 256 + lane * 4;
  float4 acc[5];
#pragma unroll
  for (int cv = 0; cv < 5; cv++) acc[cv] = make_float4(0, 0, 0, 0);
  int kb = wave * 512;
#pragma unroll 8
  for (int k = kb; k < kb + 512; k++) {
    float4 w = *(const float4*)(W + (size_t)k * 12288);
#pragma unroll
    for (int cv = 0; cv < 5; cv++) {
      float sv = s[cv * 2048 + k];
      acc[cv].x += sv * w.x; acc[cv].y += sv * w.y; acc[cv].z += sv * w.z; acc[cv].w += sv * w.w;
    }
  }
#pragma unroll
  for (int cv = 0; cv < 5; cv++) *(float4*)(red + (wave * 5 + cv) * 256 + lane * 4) = acc[cv];
  __syncthreads();
  for (int i = tid; i < 5 * 256; i += 256) {
    int cv = i >> 8, col = i & 255;
    float v = red[(0 * 5 + cv) * 256 + col] + red[(1 * 5 + cv) * 256 + col] + red[(2 * 5 + cv) * 256 + col] + red[(3 * 5 + cv) * 256 + col];
    int gc = cgp * 256 + col;
    p.mod[(size_t)(l * 5 + cv) * 12288 + gc] = v + p.ada_b[l * 12288 + gc];
  }
  __syncthreads();
}

#define N_MOD 96
#define N_TR_LAYER 3840
#define N_TR (2 * N_TR_LAYER)
#define N_CV_KEYS 64
#define N_CV_U 8192
#define N_PREP (N_MOD + N_TR + N_CV_KEYS + 2 * N_CV_U + 1)

DI void prep_phase(const Params& p, char* smem) {
  for (int it = blockIdx.x; it < N_PREP; it += gridDim.x) {
    if (it < N_MOD) { mod_item(p, it, smem); continue; }
    int i = it - N_MOD;
    if (i < N_TR) {
      int l = i / N_TR_LAYER, j = i % N_TR_LAYER;
      float* tile = (float*)smem;
      if (j < 1440) { transpose_item(p.w_in + (size_t)l * DM * INW, INW, p.WinT + (size_t)l * INW * DM, DM, j / 45, j % 45, tile); continue; }
      j -= 1440;
      if (j < 192) { transpose_item(p.mla_w_qb + (size_t)l * 512 * 1536, 1536, p.WqbT + (size_t)l * 1536 * 512, 512, j / 24, j % 24, tile); continue; }
      j -= 192;
      if (j < 128) { transpose_item(p.mla_w_kvb + (size_t)l * 256 * 2048, 2048, p.WkvbT + (size_t)l * 2048 * 256, 256, j / 32, j % 32, tile); continue; }
      j -= 128;
      if (j < 1024) { transpose_item(p.w_out + (size_t)l * DM * DM, DM, p.WoutT + (size_t)l * DM * DM, DM, j / 32, j % 32, tile); continue; }
      j -= 1024;
      if (j < 1024) { transpose_item(p.peer_w_q + (size_t)l * DM * DM, DM, p.WpqT + (size_t)l * DM * DM, DM, j / 32, j % 32, tile); continue; }
      j -= 1024;
      {
        int mat = j >> 4, dh = j & 15;
        const float* src = (mat ? p.lru_w_i : p.lru_w_a) + (size_t)(l * 16 + dh) * 4096;
        ushort_t* dst = p.LruW + ((size_t)(l * 16 + dh) * 2 + mat) * 4096;
        transpose_item(src, 64, dst, 64, 0, 0, tile);
      }
      continue;
    }
    i -= N_TR;
    if (i < N_CV_KEYS) { convert_chunk(p.peer_keys, p.KeysB, (size_t)i * 8192); continue; }
    i -= N_CV_KEYS;
    if (i < N_CV_U) { quant_rows(p.peer_u, p.Ub, p.Us, (size_t)i * 4); continue; }
    i -= N_CV_U;
    if (i < N_CV_U) { quant_rows(p.peer_v, p.Vb, p.Vs, (size_t)i * 4); continue; }
    for (int e = threadIdx.x; e < 1024 * 32; e += 256) {
      int pos = e >> 5, f = e & 31;
      int fi = f & 15;
      float inv = 1.0f / powf(10000.0f, (float)fi / 16.0f);
      float base = (f < 16) ? (float)(pos >> 6) : (float)(pos & 63);
      float ang = base * inv;
      float sn, cs; sincosf(ang, &sn, &cs);
      p.rope[pos * 64 + f] = cs; p.rope[pos * 64 + 32 + f] = sn;
    }
  }
}

DI void norm_phase(const Params& p, int l, int which) {
  int tidq = opaque(threadIdx.x); int lane = tidq & 63, gw = blockIdx.x * 4 + (tidq >> 6), nw = gridDim.x * 4;
  const float* g = (which ? p.norm_ffn_g : p.norm_mix_g) + l * DM;
  int sh_off = which ? 6144 : 0, sc_off = which ? 8192 : 2048;
  for (int t = gw; t < NTOK; t += nw) {
    const float* xr = which ? p.x1 + (size_t)t * DM : xrow_in(p, l, t);
    const float* md = p.mod + (size_t)(l * 5 + cvidx(t)) * 12288;
    float4 v[8]; float ss = 0.f;
#pragma unroll
    for (int j = 0; j < 8; j++) { v[j] = *(const float4*)(xr + j * 256 + lane * 4); ss += v[j].x * v[j].x + v[j].y * v[j].y + v[j].z * v[j].z + v[j].w * v[j].w; }
    ss = wave_sum(ss);
    float rinv = rsqrtf(ss * (1.f / DM) + 1e-6f);
#pragma unroll
    for (int j = 0; j < 8; j++) {
      int col = j * 256 + lane * 4;
      float4 gg = *(const float4*)(g + col), sc = *(const float4*)(md + sc_off + col), sh = *(const float4*)(md + sh_off + col);
      float y0 = v[j].x * rinv * gg.x * (1.f + sc.x) + sh.x;
      float y1 = v[j].y * rinv * gg.y * (1.f + sc.y) + sh.y;
      float y2 = v[j].z * rinv * gg.z * (1.f + sc.z) + sh.z;
      float y3 = v[j].w * rinv * gg.w * (1.f + sc.w) + sh.w;
      uint2 o; o.x = pack_bf16(y0, y1); o.y = pack_bf16(y2, y3);
      *(uint2*)(p.hn + (size_t)t * DM + col) = o;
    }
  }
}

DI void lru_item(const Params& p, int l, int item, char* smem) {
  int ch = item >> 4, hd = (item >> 1) & 7, d = item & 1;
  int t0 = ch * 256, seq_t0, T, p0;
  if (ch < 16) { seq_t0 = ch * 256; T = 256; p0 = 0; }
  else { int b = (ch - 16) >> 2, cc = (ch - 16) & 3; seq_t0 = NCTX + b * 1024; T = 1024; p0 = cc * 256; }
  ushort_t* sBt = (ushort_t*)smem;
  ushort_t* sA = sBt + 128 * GLD;
  float* sXc = (float*)(sA + 64 * GLD);
  float* sG = sXc + 64 * 64;
  const int tid = opaque(threadIdx.x), wave = tid >> 6, lane = tid & 63;
  const int c = tid & 63, tg = tid >> 6;
  const ushort_t* Bt = p.LruW + ((size_t)((l * 2 + d) * 8 + hd) * 2) * 4096;
#pragma unroll
  for (int i = 0; i < 4; i++) { int cidx = tid + i * 256; int row = cidx >> 3, kc = (cidx & 7) * 8; *(uint4*)(sBt + row * GLD + kc) = *(const uint4*)(Bt + row * 64 + kc); }
  const int chn = hd * 64 + c;
  float cw[4];
#pragma unroll
  for (int j = 0; j < 4; j++) cw[j] = p.lru_conv_w[(l * 4 + j) * 512 + chn];
  const float cb = p.lru_conv_b[l * 512 + chn];
  const float ba = p.lru_b_a[(l * 2 + d) * 512 + chn], bi = p.lru_b_i[(l * 2 + d) * 512 + chn];
  const float lam = p.lru_lam[(l * 2 + d) * 512 + chn];
  const float sp = log1pf(expf(-lam));
  float hst = 0.f, Pp = 1.f;
  const int r = lane & 31, h8 = lane >> 5;
  for (int si = 0; si < 4; si++) {
    int sub = d ? 3 - si : si;
#pragma unroll 4
    for (int i = 0; i < 16; i++) {
      int lt = tg * 16 + i; int pos = p0 + sub * 64 + lt;
      float xc = cb;
#pragma unroll
      for (int j = 0; j < 4; j++) {
        int q = pos - 2 + j;
        float zv = (q >= 0 && q < T) ? p.z[(size_t)(seq_t0 + q) * INW + OFF_ZX + chn] : 0.f;
        xc += cw[j] * zv;
      }
      sXc[lt * 64 + c] = xc; sA[lt * GLD + c] = f2bf(xc);
    }
    __syncthreads();
    {
      int mt = wave & 1, nh = wave >> 1;
      f32x16 acc[2];
#pragma unroll
      for (int i = 0; i < 2; i++)
#pragma unroll
        for (int e = 0; e < 16; e++) acc[i][e] = 0.f;
#pragma unroll
      for (int ks = 0; ks < 4; ks++) {
        bf16x8 a = *(const bf16x8*)(sA + (mt * 32 + r) * GLD + ks * 16 + h8 * 8);
#pragma unroll
        for (int ni = 0; ni < 2; ni++) {
          bf16x8 b = *(const bf16x8*)(sBt + (nh * 64 + ni * 32 + r) * GLD + ks * 16 + h8 * 8);
          acc[ni] = MFMA32(a, b, acc[ni]);
        }
      }
#pragma unroll
      for (int ni = 0; ni < 2; ni++)
#pragma unroll
        for (int e = 0; e < 16; e++) sG[(mt * 32 + crow(e, h8)) * 132 + nh * 64 + ni * 32 + r] = acc[ni][e];
    }
    __syncthreads();
#pragma unroll 4
    for (int i = 0; i < 16; i++) {
      int lt = tg * 16 + i;
      float ga = sG[lt * 132 + c] + ba, gi = sG[lt * 132 + 64 + c] + bi;
      float rr = 1.f / (1.f + expf(-ga)), ii = 1.f / (1.f + expf(-gi));
      float la = -8.0f * rr * sp;
      float a = expf(la);
      float u = sqrtf(-expm1f(2.f * la)) * ii * sXc[lt * 64 + c];
      sG[lt * 132 + c] = a; sG[lt * 132 + 64 + c] = u;
    }
    __syncthreads();
    if (tid < 64) {
      for (int s = 0; s < 64; s++) {
        int lt = d ? 63 - s : s;
        float a = sG[lt * 132 + c], u = sG[lt * 132 + 64 + c];
        hst = a * hst + u; Pp *= a;
        size_t o = ((size_t)d * NTOK + t0 + sub * 64 + lt) * 512 + chn;
        p.hs[o] = f2bf(hst); p.Pc[o] = f2bf(Pp);
      }
    }
    __syncthreads();
  }
  if (tid < 64) {
    p.hend[(d * 32 + ch) * 512 + chn] = hst; p.Pend[(d * 32 + ch) * 512 + chn] = Pp;
    if (ch < 16) p.out[(size_t)NTOK * DM + 16 * 2 * 256 * 256 + 16 * 2 * 256 * 64 + ((ch * 2 + l) * 2 + d) * 512 + chn] = hst;
  }
}

#define CMT 16
DI void cm_item(const Params& p, int l, int item, char* smem) {
  int t0 = item * CMT, seq_t0, T;
  if (t0 < NCTX) { seq_t0 = (t0 >> 8) << 8; T = 256; } else { seq_t0 = NCTX + (((t0 - NCTX) >> 10) << 10); T = 1024; }
  int p0 = t0 - seq_t0;
  unsigned* sGlu = (unsigned*)smem;
  float* red = (float*)(sGlu + (CMT + 30) * 256);
  float* red2 = red + 256;
  const int tid = opaque(threadIdx.x), wave = tid >> 6, lane = tid & 63;
#pragma unroll 8
  for (int rr = 0; rr < CMT + 30; rr++) {
    int pos = p0 - 15 + rr;
    unsigned v = 0;
    if (pos >= 0 && pos < T) {
      const float* zr = p.z + (size_t)(seq_t0 + pos) * INW + OFF_ZC;
      float2 a = *(const float2*)(zr + 2 * tid), b = *(const float2*)(zr + 512 + 2 * tid);
      v = pack_bf16(a.x * sigmoidf_(b.x), a.y * sigmoidf_(b.y));
    }
    sGlu[rr * 256 + tid] = v;
  }
  __syncthreads();
  float acc0[CMT], acc1[CMT];
  {
    float2 bb = *(const float2*)(p.cm_dw_b + l * 512 + 2 * tid);
#pragma unroll
    for (int t = 0; t < CMT; t++) { acc0[t] = bb.x; acc1[t] = bb.y; }
  }
  for (int j = 0; j < 31; j++) {
    float2 w = *(const float2*)(p.cm_dw_w + (size_t)(l * 31 + j) * 512 + 2 * tid);
#pragma unroll
    for (int t = 0; t < CMT; t++) { unsigned u = sGlu[(t + j) * 256 + tid]; acc0[t] += w.x * bf_lo(u); acc1[t] += w.y * bf_hi(u); }
  }
  {
    float ks = 0.f, kss = 0.f;
#pragma unroll
    for (int t = 0; t < CMT; t++) {
      float s = wave_sum(acc0[t] + acc1[t]);
      float ss = wave_sum(acc0[t] * acc0[t] + acc1[t] * acc1[t]);
      if (lane == t) { ks = s; kss = ss; }
    }
    if (lane < CMT) { red[(wave * CMT + lane) * 2] = ks; red[(wave * CMT + lane) * 2 + 1] = kss; }
  }
  __syncthreads();
  {
    float2 lg = *(const float2*)(p.cm_ln_g + l * 512 + 2 * tid), lb = *(const float2*)(p.cm_ln_b + l * 512 + 2 * tid);
    float k2 = 0.f;
#pragma unroll
    for (int t = 0; t < CMT; t++) {
      float s = red[(0 * CMT + t) * 2] + red[(1 * CMT + t) * 2] + red[(2 * CMT + t) * 2] + red[(3 * CMT + t) * 2];
      float ss = red[(0 * CMT + t) * 2 + 1] + red[(1 * CMT + t) * 2 + 1] + red[(2 * CMT + t) * 2 + 1] + red[(3 * CMT + t) * 2 + 1];
      float mu = s * (1.f / 512.f); float var = ss * (1.f / 512.f) - mu * mu; float rstd = rsqrtf(var + 1e-5f);
      float y0 = (acc0[t] - mu) * rstd * lg.x + lb.x, y1 = (acc1[t] - mu) * rstd * lg.y + lb.y;
      y0 = y0 * sigmoidf_(y0); y1 = y1 * sigmoidf_(y1);
      acc0[t] = y0; acc1[t] = y1;
      float s2 = wave_sum(y0 * y0 + y1 * y1);
      if (lane == t) k2 = s2;
    }
    if (lane < CMT) red2[wave * CMT + lane] = k2;
  }
  __syncthreads();
  {
    float2 gg = *(const float2*)(p.grp_g + l * DM + 1536 + 2 * tid);
#pragma unroll
    for (int t = 0; t < CMT; t++) {
      float tot = red2[t] + red2[CMT + t] + red2[2 * CMT + t] + red2[3 * CMT + t];
      float rinv = rsqrtf(tot * (1.f / 512.f) + 1e-6f);
      *(unsigned*)(p.mixed + (size_t)(t0 + t) * DM + 1536 + 2 * tid) = pack_bf16(acc0[t] * rinv * gg.x, acc1[t] * rinv * gg.y);
    }
  }
  __syncthreads();
}

DI void post_inproj_tokens(const Params& p, int l) {
  int tidq = opaque(threadIdx.x); int lane = tidq & 63, gw = blockIdx.x * 4 + (tidq >> 6), nw = gridDim.x * 4;
  float* new_ckv = p.out + (size_t)NTOK * DM;
  float* new_krope = new_ckv + 16 * 2 * 256 * 256;
  for (int t = gw; t < NTOK + 2048; t += nw) {
    if (t >= NTOK) {
      int rr = t - NTOK; int b = rr >> 9, j = rr & 511;
      float4 v = *(const float4*)(p.cache_ckv + ((size_t)(b * 2 + l) * 512 + j) * 256 + lane * 4);
      uint2 o; o.x = pack_bf16(v.x, v.y); o.y = pack_bf16(v.z, v.w);
      *(uint2*)(p.ckv + (size_t)(NCTX + b * 1536 + j) * 256 + lane * 4) = o;
      continue;
    }
    const float* zr = p.z + (size_t)t * INW;
    {
      float4 a = *(const float4*)(zr + lane * 4), b = *(const float4*)(zr + 256 + lane * 4);
      float ss = a.x * a.x + a.y * a.y + a.z * a.z + a.w * a.w + b.x * b.x + b.y * b.y + b.z * b.z + b.w * b.w;
      ss = wave_sum(ss);
      float rinv = rsqrtf(ss * (1.f / 512.f) + 1e-6f);
      float4 g0 = *(const float4*)(p.mla_qa_g + l * 512 + lane * 4), g1 = *(const float4*)(p.mla_qa_g + l * 512 + 256 + lane * 4);
      uint2 o0, o1;
      o0.x = pack_bf16(a.x * rinv * g0.x, a.y * rinv * g0.y); o0.y = pack_bf16(a.z * rinv * g0.z, a.w * rinv * g0.w);
      o1.x = pack_bf16(b.x * rinv * g1.x, b.y * rinv * g1.y); o1.y = pack_bf16(b.z * rinv * g1.z, b.w * rinv * g1.w);
      *(uint2*)(p.qa + (size_t)t * 512 + lane * 4) = o0;
      *(uint2*)(p.qa + (size_t)t * 512 + 256 + lane * 4) = o1;
    }
    {
      float4 a = *(const float4*)(zr + OFF_ZKV + lane * 4);
      float ss = wave_sum(a.x * a.x + a.y * a.y + a.z * a.z + a.w * a.w);
      float rinv = rsqrtf(ss * (1.f / 256.f) + 1e-6f);
      float4 g = *(const float4*)(p.mla_kva_g + l * 256 + lane * 4);
      float4 o = make_float4(a.x * rinv * g.x, a.y * rinv * g.y, a.z * rinv * g.z, a.w * rinv * g.w);
      uint2 ob; ob.x = pack_bf16(o.x, o.y); ob.y = pack_bf16(o.z, o.w);
      *(uint2*)(p.ckv + (size_t)kvrow_of_token(t) * 256 + lane * 4) = ob;
      if (t < NCTX) {
        int b = t >> 8, pos = t & 255;
        *(float4*)(new_ckv + ((size_t)(b * 2 + l) * 256 + pos) * 256 + lane * 4) = o;
        new_krope[((size_t)(b * 2 + l) * 256 + pos) * 64 + lane] = zr[OFF_ZKR + lane];
      }
    }
  }
}

DI void qnorm_tokens(const Params& p, int l) {
  int tidq = opaque(threadIdx.x); int lane = tidq & 63, gw = blockIdx.x * 4 + (tidq >> 6), nw = gridDim.x * 4;
  const float qscale = 0.07216878364870322f * 1.4426950408889634f;
  const float* g = p.mla_q_g + l * 192;
  float g0 = g[lane], g1 = g[64 + lane], g2 = g[128 + lane];
  for (int t = gw; t < NTOK; t += nw) {
    const ushort_t* qr = p.qraw + (size_t)t * 1536;
    bool lat = t >= NCTX; int pos = (t - NCTX) & 1023;
    float cs = 1.f, sn = 0.f;
    if (lat) { cs = p.rope[pos * 64 + (lane & 31)]; sn = p.rope[pos * 64 + 32 + (lane & 31)]; }
#pragma unroll
    for (int hh = 0; hh < 8; hh++) {
      float a = __uint_as_float((unsigned)qr[hh * 192 + lane] << 16), b = __uint_as_float((unsigned)qr[hh * 192 + 64 + lane] << 16), c = __uint_as_float((unsigned)qr[hh * 192 + 128 + lane] << 16);
      float ss = wave_sum(a * a + b * b + c * c);
      float rinv = rsqrtf(ss * (1.f / 192.f) + 1e-6f);
      a *= rinv * g0; b *= rinv * g1; c *= rinv * g2;
      if (lat) {
        float o = __shfl_xor(c, 32);
        c = (lane < 32) ? (c * cs - o * sn) : (o * sn + c * cs);
      }
      ushort_t* qo = p.Q + (size_t)t * 1536 + hh * 192;
      qo[lane] = f2bf(a * qscale); qo[64 + lane] = f2bf(b * qscale); qo[128 + lane] = f2bf(c * qscale);
    }
  }
}

DI void kv_item(const Params& p, int l, int item, char* smem) {
  int rt = item >> 3, hh = item & 7;
  int row0 = rt * 64;
  const int tid = opaque(threadIdx.x), wave = tid >> 6, lane = tid & 63;
  float* tile = (float*)smem;
  const float* g = p.mla_k_g + l * 192;
  float g0 = g[lane], g1 = g[64 + lane], g2 = g[128 + lane];
#pragma unroll 4
  for (int i = 0; i < 16; i++) {
    int lr = wave * 16 + i; int row = row0 + lr;
    const float* kr_src; bool rot = false; int pos = 0;
    if (row < NCTX) { kr_src = p.z + (size_t)row * INW + OFF_ZKR; }
    else {
      int rr = row - NCTX; int b = rr / 1536, j = rr % 1536;
      if (j < 512) kr_src = p.cache_krope + ((size_t)(b * 2 + l) * 512 + j) * 64;
      else { pos = j - 512; kr_src = p.z + (size_t)(NCTX + b * 1024 + pos) * INW + OFF_ZKR; rot = true; }
    }
    const ushort_t* kv = p.kvraw + (size_t)row * 2048 + hh * 256;
    float a = __uint_as_float((unsigned)kv[lane] << 16), b2 = __uint_as_float((unsigned)kv[64 + lane] << 16), c = kr_src[lane];
    float ss = wave_sum(a * a + b2 * b2 + c * c);
    float rinv = rsqrtf(ss * (1.f / 192.f) + 1e-6f);
    a *= rinv * g0; b2 *= rinv * g1; c *= rinv * g2;
    if (rot) {
      float cs = p.rope[pos * 64 + (lane & 31)], sn = p.rope[pos * 64 + 32 + (lane & 31)];
      float o = __shfl_xor(c, 32);
      c = (lane < 32) ? (c * cs - o * sn) : (o * sn + c * cs);
    }
    ushort_t* ko = p.K + (size_t)row * 1536 + hh * 192;
    ko[lane] = f2bf(a); ko[64 + lane] = f2bf(b2); ko[128 + lane] = f2bf(c);
    tile[lr * 129 + lane] = __uint_as_float((unsigned)kv[128 + lane] << 16); tile[lr * 129 + 64 + lane] = __uint_as_float((unsigned)kv[192 + lane] << 16);
  }
  __syncthreads();
  size_t vbase; int T, krow0;
  if (row0 < NCTX) { int sid = row0 >> 8; vbase = (size_t)(sid * 8 + hh) * 128 * 256; T = 256; krow0 = row0 & 255; }
  else { int rr = row0 - NCTX; int b = rr / 1536; vbase = (size_t)16 * 8 * 128 * 256 + (size_t)(b * 8 + hh) * 128 * 1536; T = 1536; krow0 = rr % 1536; }
#pragma unroll
  for (int i = 0; i < 4; i++) {
    int cidx = tid + i * 256; int dv = cidx >> 3, kg = cidx & 7;
    int G = kg >> 1, hhalf = kg & 1;
    float v[8];
#pragma unroll
    for (int s = 0; s < 8; s++) { int key = 16 * G + 8 * (s >> 2) + 4 * hhalf + (s & 3); v[s] = tile[key * 129 + dv]; }
    uint4 o; o.x = pack_bf16(v[0], v[1]); o.y = pack_bf16(v[2], v[3]); o.z = pack_bf16(v[4], v[5]); o.w = pack_bf16(v[6], v[7]);
    *(uint4*)(p.Vt + vbase + (size_t)dv * T + krow0 + kg * 8) = o;
  }
  __syncthreads();
}

#define KLD 200
#define VLD 72
DI void attn_item(const Params& p, int item, char* smem) {
  const int tid = opaque(threadIdx.x), wave = tid >> 6, lane = tid & 63;
  const int qs = wave & 1, kh = wave >> 1;
  int hh, Tk, tq0, kvbase; size_t vbase;
  if (item < 512) {
    int b = item >> 7; hh = (item >> 4) & 7; int qb = item & 15;
    Tk = 1536; tq0 = NCTX + b * 1024 + qb * 64; kvbase = NCTX + b * 1536;
    vbase = (size_t)16 * 8 * 128 * 256 + (size_t)(b * 8 + hh) * 128 * 1536;
  } else {
    int i2 = item - 512; int s = i2 >> 5; hh = (i2 >> 2) & 7; int qb = i2 & 3;
    Tk = 256; tq0 = s * 256 + qb * 64; kvbase = s * 256;
    vbase = (size_t)(s * 8 + hh) * 128 * 256;
  }
  ushort_t* sK = (ushort_t*)smem;
  ushort_t* sV = sK + 64 * KLD;
  const int r = lane & 31, h = lane >> 5;
  bf16x8 qf[12];
  {
    const ushort_t* qp = p.Q + (size_t)(tq0 + qs * 32 + r) * 1536 + hh * 192 + h * 8;
#pragma unroll
    for (int s = 0; s < 12; s++) qf[s] = *(const bf16x8*)(qp + s * 16);
  }
  f32x16 O[4];
#pragma unroll
  for (int i = 0; i < 4; i++)
#pragma unroll
    for (int e = 0; e < 16; e++) O[i][e] = 0.f;
  float m = -INFINITY, lsum = 0.f;
  const int nkt = Tk >> 6;
  const ushort_t* Kg = p.K + (size_t)kvbase * 1536 + hh * 192;
  const ushort_t* Vg = p.Vt + vbase;
  u32x4 rk[6], rv[4];
#pragma unroll
  for (int i = 0; i < 6; i++) { int c = tid + i * 256; int row = c / 24, kc = (c % 24) * 8; rk[i] = GLD16(Kg + (size_t)row * 1536 + kc); }
#pragma unroll
  for (int i = 0; i < 4; i++) { int c = tid + i * 256; int dv = c >> 3, kc = (c & 7) * 8; rv[i] = GLD16(Vg + (size_t)dv * Tk + kc); }
  for (int kt = 0; kt < nkt; kt++) {
    __syncthreads();
#pragma unroll
    for (int i = 0; i < 6; i++) { int c = tid + i * 256; int row = c / 24, kc = (c % 24) * 8; *(u32x4*)(sK + row * KLD + kc) = rk[i]; }
#pragma unroll
    for (int i = 0; i < 4; i++) { int c = tid + i * 256; int dv = c >> 3, kc = (c & 7) * 8; *(u32x4*)(sV + dv * VLD + kc) = rv[i]; }
    __syncthreads();
    if (kt + 1 < nkt) {
#pragma unroll
      for (int i = 0; i < 6; i++) { int c = tid + i * 256; int row = c / 24, kc = (c % 24) * 8; rk[i] = GLD16(Kg + (size_t)((kt + 1) * 64 + row) * 1536 + kc); }
#pragma unroll
      for (int i = 0; i < 4; i++) { int c = tid + i * 256; int dv = c >> 3, kc = (c & 7) * 8; rv[i] = GLD16(Vg + (size_t)dv * Tk + (kt + 1) * 64 + kc); }
    }
    f32x16 S;
#pragma unroll
    for (int e = 0; e < 16; e++) S[e] = 0.f;
    const ushort_t* kp = sK + (kh * 32 + r) * KLD + h * 8;
#pragma unroll
    for (int s = 0; s < 12; s++) { bf16x8 kf = *(const bf16x8*)(kp + s * 16); S = MFMA32(kf, qf[s], S); }
    float mx = S[0];
#pragma unroll
    for (int e = 1; e < 16; e++) mx = fmaxf(mx, S[e]);
    mx = fmaxf(mx, __shfl_xor(mx, 32));
    float mn = fmaxf(m, mx);
    float alpha = exp2f(m - mn);
    float rs = 0.f;
#pragma unroll
    for (int e = 0; e < 16; e++) { S[e] = exp2f(S[e] - mn); rs += S[e]; }
    rs += __shfl_xor(rs, 32);
    lsum = lsum * alpha + rs; m = mn;
#pragma unroll
    for (int i = 0; i < 4; i++)
#pragma unroll
      for (int e = 0; e < 16; e++) O[i][e] *= alpha;
    bf16x8 pf[2];
#pragma unroll
    for (int s2 = 0; s2 < 2; s2++) {
      u32x4 u; u.x = pack_bf16(S[8 * s2], S[8 * s2 + 1]); u.y = pack_bf16(S[8 * s2 + 2], S[8 * s2 + 3]);
      u.z = pack_bf16(S[8 * s2 + 4], S[8 * s2 + 5]); u.w = pack_bf16(S[8 * s2 + 6], S[8 * s2 + 7]);
      pf[s2] = __builtin_bit_cast(bf16x8, u);
    }
    const ushort_t* vp = sV + r * VLD + kh * 32 + h * 8;
#pragma unroll
    for (int dt = 0; dt < 4; dt++)
#pragma unroll
      for (int s2 = 0; s2 < 2; s2++) {
        bf16x8 vf = *(const bf16x8*)(vp + dt * 32 * VLD + s2 * 16);
        O[dt] = MFMA32(vf, pf[s2], O[dt]);
      }
  }
  __syncthreads();
  float* cO = (float*)smem;
  float* cML = cO + 2 * 64 * 64;
  if (kh == 1) {
#pragma unroll
    for (int dt = 0; dt < 4; dt++)
#pragma unroll
      for (int e = 0; e < 16; e++) cO[(qs * 64 + dt * 16 + e) * 64 + lane] = O[dt][e];
    cML[(qs * 2 + 0) * 64 + lane] = m; cML[(qs * 2 + 1) * 64 + lane] = lsum;
  }
  __syncthreads();
  if (kh == 0) {
    float m1 = cML[(qs * 2 + 0) * 64 + lane], l1 = cML[(qs * 2 + 1) * 64 + lane];
    float mf = fmaxf(m, m1);
    float a0 = exp2f(m - mf), a1 = exp2f(m1 - mf);
    float inv = 1.f / (lsum * a0 + l1 * a1);
    a0 *= inv; a1 *= inv;
    ushort_t* op = p.attn + (size_t)(tq0 + qs * 32 + r) * 1024 + hh * 128;
#pragma unroll
    for (int dt = 0; dt < 4; dt++)
#pragma unroll
      for (int gq = 0; gq < 4; gq++) {
        float o0 = O[dt][4 * gq] * a0 + cO[(qs * 64 + dt * 16 + 4 * gq) * 64 + lane] * a1;
        float o1 = O[dt][4 * gq + 1] * a0 + cO[(qs * 64 + dt * 16 + 4 * gq + 1) * 64 + lane] * a1;
        float o2 = O[dt][4 * gq + 2] * a0 + cO[(qs * 64 + dt * 16 + 4 * gq + 2) * 64 + lane] * a1;
        float o3 = O[dt][4 * gq + 3] * a0 + cO[(qs * 64 + dt * 16 + 4 * gq + 3) * 64 + lane] * a1;
        uint2 ov; ov.x = pack_bf16(o0, o1); ov.y = pack_bf16(o2, o3); *(uint2*)(op + dt * 32 + 8 * gq + 4 * h) = ov;
      }
  }
  __syncthreads();
}

DI void merge_tokens(const Params& p, int l) {
  int tidq = opaque(threadIdx.x); int lane = tidq & 63, gw = blockIdx.x * 4 + (tidq >> 6), nw = gridDim.x * 4;
  const float* gg = p.grp_g + l * DM;
  for (int t = gw; t < NTOK; t += nw) {
    {
      const ushort_t* ar = p.attn + (size_t)t * 1024;
      float4 v[4]; float ss = 0.f;
#pragma unroll
      for (int j = 0; j < 4; j++) { uint2 u_ = *(const uint2*)(ar + j * 256 + lane * 4); v[j] = make_float4(bf_lo(u_.x), bf_hi(u_.x), bf_lo(u_.y), bf_hi(u_.y)); ss += v[j].x * v[j].x + v[j].y * v[j].y + v[j].z * v[j].z + v[j].w * v[j].w; }
      ss = wave_sum(ss);
      float rinv = rsqrtf(ss * (1.f / 1024.f) + 1e-6f);
#pragma unroll
      for (int j = 0; j < 4; j++) {
        int col = j * 256 + lane * 4; float4 g = *(const float4*)(gg + col);
        uint2 o; o.x = pack_bf16(v[j].x * rinv * g.x, v[j].y * rinv * g.y); o.y = pack_bf16(v[j].z * rinv * g.z, v[j].w * rinv * g.w);
        *(uint2*)(p.mixed + (size_t)t * DM + col) = o;
      }
    }
    {
      float val[8]; float ss = 0.f;
      int ch = t >> 8;
#pragma unroll
      for (int j = 0; j < 2; j++) {
        int col = j * 256 + lane * 4;
        float cf[4] = {0, 0, 0, 0}, cbk[4] = {0, 0, 0, 0};
        if (t >= NCTX) {
          int b = (t - NCTX) >> 10, cc = (ch - 16) & 3, chb = 16 + b * 4;
          float4 h0f = *(const float4*)(p.state_lru + ((size_t)(b * 2 + l) * 2 + 0) * 512 + col);
          float4 h0b = *(const float4*)(p.state_lru + ((size_t)(b * 2 + l) * 2 + 1) * 512 + col);
          cf[0] = h0f.x; cf[1] = h0f.y; cf[2] = h0f.z; cf[3] = h0f.w;
          cbk[0] = h0b.x; cbk[1] = h0b.y; cbk[2] = h0b.z; cbk[3] = h0b.w;
          for (int jj = 0; jj < cc; jj++) {
            float4 he = *(const float4*)(p.hend + (size_t)(0 * 32 + chb + jj) * 512 + col), pe = *(const float4*)(p.Pend + (size_t)(0 * 32 + chb + jj) * 512 + col);
            cf[0] = he.x + pe.x * cf[0]; cf[1] = he.y + pe.y * cf[1]; cf[2] = he.z + pe.z * cf[2]; cf[3] = he.w + pe.w * cf[3];
          }
          for (int jj = 3; jj > cc; jj--) {
            float4 he = *(const float4*)(p.hend + (size_t)(1 * 32 + chb + jj) * 512 + col), pe = *(const float4*)(p.Pend + (size_t)(1 * 32 + chb + jj) * 512 + col);
            cbk[0] = he.x + pe.x * cbk[0]; cbk[1] = he.y + pe.y * cbk[1]; cbk[2] = he.z + pe.z * cbk[2]; cbk[3] = he.w + pe.w * cbk[3];
          }
        }
        uint2 uhf = *(const uint2*)(p.hs + ((size_t)0 * NTOK + t) * 512 + col), upf = *(const uint2*)(p.Pc + ((size_t)0 * NTOK + t) * 512 + col);
        uint2 uhb = *(const uint2*)(p.hs + ((size_t)1 * NTOK + t) * 512 + col), upb = *(const uint2*)(p.Pc + ((size_t)1 * NTOK + t) * 512 + col);
        float4 hf_ = make_float4(bf_lo(uhf.x), bf_hi(uhf.x), bf_lo(uhf.y), bf_hi(uhf.y)), pf_ = make_float4(bf_lo(upf.x), bf_hi(upf.x), bf_lo(upf.y), bf_hi(upf.y));
        float4 hb_ = make_float4(bf_lo(uhb.x), bf_hi(uhb.x), bf_lo(uhb.y), bf_hi(uhb.y)), pb_ = make_float4(bf_lo(upb.x), bf_hi(upb.x), bf_lo(upb.y), bf_hi(upb.y));
        float4 zg = *(const float4*)(p.z + (size_t)t * INW + OFF_ZG + col);
        float y0 = hf_.x + pf_.x * cf[0] + hb_.x + pb_.x * cbk[0];
        float y1 = hf_.y + pf_.y * cf[1] + hb_.y + pb_.y * cbk[1];
        float y2 = hf_.z + pf_.z * cf[2] + hb_.z + pb_.z * cbk[2];
        float y3 = hf_.w + pf_.w * cf[3] + hb_.w + pb_.w * cbk[3];
        y0 *= gelu_tanh(zg.x); y1 *= gelu_tanh(zg.y); y2 *= gelu_tanh(zg.z); y3 *= gelu_tanh(zg.w);
        val[j * 4] = y0; val[j * 4 + 1] = y1; val[j * 4 + 2] = y2; val[j * 4 + 3] = y3;
        ss += y0 * y0 + y1 * y1 + y2 * y2 + y3 * y3;
      }
      ss = wave_sum(ss);
      float rinv = rsqrtf(ss * (1.f / 512.f) + 1e-6f);
#pragma unroll
      for (int j = 0; j < 2; j++) {
        int col = j * 256 + lane * 4; float4 g = *(const float4*)(gg + 1024 + col);
        uint2 o; o.x = pack_bf16(val[j * 4] * rinv * g.x, val[j * 4 + 1] * rinv * g.y); o.y = pack_bf16(val[j * 4 + 2] * rinv * g.z, val[j * 4 + 3] * rinv * g.w);
        *(uint2*)(p.mixed + (size_t)t * DM + 1024 + col) = o;
      }
    }
  }
}

#define TOPK_INS(TV, TI, XV, XI) { float xv_ = (XV); int xi_ = (XI); _Pragma("unroll") for (int i_ = 0; i_ < 16; i_++) { bool c_ = xv_ > TV[i_]; float nv_ = c_ ? xv_ : TV[i_]; float ov_ = c_ ? TV[i_] : xv_; int ni_ = c_ ? xi_ : TI[i_]; int oi_ = c_ ? TI[i_] : xi_; TV[i_] = nv_; TI[i_] = ni_; xv_ = ov_; xi_ = oi_; } }
DI void peer_phase(const Params& p, int l, char* smem) {
  const int tid = opaque(threadIdx.x), wave = tid >> 6, lane = tid & 63;
  float* wsm = (float*)(smem + wave * 12288);
  float* lv = wsm;
  int* lidx = (int*)(wsm + 1024);
  int* pki = (int*)(wsm + 2048);
  float* pkg = wsm + 2560;
  const float* scores = p.z;
  const unsigned char* Ub = p.Ub + (size_t)l * NEXP * DM;
  const unsigned char* Vb = p.Vb + (size_t)l * NEXP * DM;
  const float* Us = p.Us + l * NEXP;
  const float* Vs = p.Vs + l * NEXP;
  float* dst = l == 0 ? p.xA : p.out;
  for (int tb = blockIdx.x; tb < NTOK / 16; tb += gridDim.x) {
    const int tg = tb * 4 + wave;
    {
      const GAS f32x4* sp = (const GAS f32x4*)(scores + (size_t)(tg * 4 + (lane >> 4)) * 2048 + (lane & 15) * 128);
      float tv[16]; int ti[16];
#pragma unroll
      for (int i = 0; i < 16; i++) { tv[i] = -INFINITY; ti[i] = 0; }
      for (int k = 0; k < 128; k += 8) {
        float x[8];
        { f32x4 xa_ = sp[k >> 2], xb_ = sp[(k >> 2) + 1]; x[0] = xa_[0]; x[1] = xa_[1]; x[2] = xa_[2]; x[3] = xa_[3]; x[4] = xb_[0]; x[5] = xb_[1]; x[6] = xb_[2]; x[7] = xb_[3]; }
#pragma unroll
        for (int u = 0; u < 8; u++) TOPK_INS(tv, ti, x[u], k + u);
      }
#pragma unroll
      for (int i = 0; i < 16; i++) { lv[i * 64 + lane] = tv[i]; lidx[i * 64 + lane] = ti[i]; }
    }
    __syncthreads();
    if (lane < 32) {
      const int tt = lane >> 3, hh = lane & 7;
      const int la = tt * 16 + 2 * hh, lb = la + 1;
      float s1[16], s2[16];
#pragma unroll
      for (int i = 0; i < 16; i++) { s1[i] = lv[i * 64 + la]; s2[i] = lv[i * 64 + lb]; }
      float cv[16]; int cf[16];
#pragma unroll
      for (int i = 0; i < 16; i++) { cv[i] = -INFINITY; cf[i] = 0; }
#pragma unroll
      for (int i = 0; i < 16; i++) {
#pragma unroll
        for (int j = 0; j < 16; j++) {
          if ((i + 1) * (j + 1) <= 16) TOPK_INS(cv, cf, s1[i] + s2[j], i * 16 + j);
        }
      }
      float e[16]; float sum = 0.f;
#pragma unroll
      for (int r = 0; r < 16; r++) { e[r] = __expf(cv[r] - cv[0]); sum += e[r]; }
      const float inv = 1.f / sum;
#pragma unroll
      for (int r = 0; r < 16; r++) {
        int id = lidx[(cf[r] >> 4) * 64 + la] * 128 + lidx[(cf[r] & 15) * 64 + lb];
        pki[tt * 128 + hh * 16 + r] = id; pkg[tt * 128 + hh * 16 + r] = e[r] * inv;
      }
    }
    __syncthreads();
    for (int tt = 0; tt < 4; tt++) {
    const int t = tg * 4 + tt;
    const int idx0 = pki[tt * 128 + lane], idx1 = pki[tt * 128 + 64 + lane];
    const float g0 = pkg[tt * 128 + lane], g1 = pkg[tt * 128 + 64 + lane];
    float xs[32];
#pragma unroll
    for (int j = 0; j < 2; j++) {
      const uint4* xp = (const uint4*)(p.hn + (size_t)t * DM + (j * 64 + lane) * 16);
      uint4 xa = xp[0], xb = xp[1];
      xs[j * 16 + 0] = bf_lo(xa.x); xs[j * 16 + 1] = bf_hi(xa.x); xs[j * 16 + 2] = bf_lo(xa.y); xs[j * 16 + 3] = bf_hi(xa.y);
      xs[j * 16 + 4] = bf_lo(xa.z); xs[j * 16 + 5] = bf_hi(xa.z); xs[j * 16 + 6] = bf_lo(xa.w); xs[j * 16 + 7] = bf_hi(xa.w);
      xs[j * 16 + 8] = bf_lo(xb.x); xs[j * 16 + 9] = bf_hi(xb.x); xs[j * 16 + 10] = bf_lo(xb.y); xs[j * 16 + 11] = bf_hi(xb.y);
      xs[j * 16 + 12] = bf_lo(xb.z); xs[j * 16 + 13] = bf_hi(xb.z); xs[j * 16 + 14] = bf_lo(xb.w); xs[j * 16 + 15] = bf_hi(xb.w);
    }
    const float us0 = Us[idx0], us1 = Us[idx1], vs0 = Vs[idx0], vs1 = Vs[idx1];
    float a0 = 0.f, a1 = 0.f;
    {
      u32x4 ld[8][2];
#pragma unroll
      for (int rr = 0; rr < 8; rr++) {
        int idx = __builtin_amdgcn_readlane(idx0, rr);
        const unsigned char* row = Ub + (size_t)idx * DM;
#pragma unroll
        for (int j = 0; j < 2; j++) ld[rr][j] = GLD16(row + (j * 64 + lane) * 16);
      }
      for (int k0 = 0; k0 < 128; k0 += 8) {
        int nsrc = (k0 + 8 < 64) ? idx0 : idx1;
        float part[8];
#pragma unroll
        for (int rr = 0; rr < 8; rr++) {
          float s = 0.f;
#pragma unroll
          for (int j = 0; j < 2; j++)
#pragma unroll
            for (int q = 0; q < 4; q++) {
              f32x2_t lo = __builtin_amdgcn_cvt_pk_f32_fp8((int)ld[rr][j][q], false);
              f32x2_t hi = __builtin_amdgcn_cvt_pk_f32_fp8((int)ld[rr][j][q], true);
              s += lo[0] * xs[j * 16 + q * 4] + lo[1] * xs[j * 16 + q * 4 + 1] + hi[0] * xs[j * 16 + q * 4 + 2] + hi[1] * xs[j * 16 + q * 4 + 3];
            }
          part[rr] = s;
          if (k0 + 8 < 128) {
            int idx = __builtin_amdgcn_readlane(nsrc, (k0 + 8 + rr) & 63);
            const unsigned char* row = Ub + (size_t)idx * DM;
#pragma unroll
            for (int j = 0; j < 2; j++) ld[rr][j] = GLD16(row + (j * 64 + lane) * 16);
          }
        }
#pragma unroll
        for (int o = 32; o; o >>= 1) {
#pragma unroll
          for (int rr = 0; rr < 8; rr++) part[rr] += __shfl_xor(part[rr], o);
        }
#pragma unroll
        for (int rr = 0; rr < 8; rr++) {
          if (lane == ((k0 + rr) & 63)) { if (k0 < 64) a0 = part[rr]; else a1 = part[rr]; }
        }
      }
    }
    float w0 = g0 * gelu_tanh(a0 * us0) * vs0, w1 = g1 * gelu_tanh(a1 * us1) * vs1;
    float acc[32];
#pragma unroll
    for (int e = 0; e < 32; e++) acc[e] = 0.f;
    {
      u32x4 ld[8][2];
#pragma unroll
      for (int rr = 0; rr < 8; rr++) {
        int idx = __builtin_amdgcn_readlane(idx0, rr);
        const unsigned char* row = Vb + (size_t)idx * DM;
#pragma unroll
        for (int j = 0; j < 2; j++) ld[rr][j] = GLD16(row + (j * 64 + lane) * 16);
      }
      for (int k0 = 0; k0 < 128; k0 += 8) {
        float wsrc = (k0 < 64) ? w0 : w1;
        int nsrc = (k0 + 8 < 64) ? idx0 : idx1;
#pragma unroll
        for (int rr = 0; rr < 8; rr++) {
          float w = rdlane_f(wsrc, (k0 + rr) & 63);
#pragma unroll
          for (int j = 0; j < 2; j++)
#pragma unroll
            for (int q = 0; q < 4; q++) {
              f32x2_t lo = __builtin_amdgcn_cvt_pk_f32_fp8((int)ld[rr][j][q], false);
              f32x2_t hi = __builtin_amdgcn_cvt_pk_f32_fp8((int)ld[rr][j][q], true);
              acc[j * 16 + q * 4 + 0] += w * lo[0]; acc[j * 16 + q * 4 + 1] += w * lo[1];
              acc[j * 16 + q * 4 + 2] += w * hi[0]; acc[j * 16 + q * 4 + 3] += w * hi[1];
            }
          if (k0 + 8 < 128) {
            int idx = __builtin_amdgcn_readlane(nsrc, (k0 + 8 + rr) & 63);
            const unsigned char* row = Vb + (size_t)idx * DM;
#pragma unroll
            for (int j = 0; j < 2; j++) ld[rr][j] = GLD16(row + (j * 64 + lane) * 16);
          }
        }
      }
    }
    const float* md = p.mod + (size_t)(l * 5 + cvidx(t)) * 12288 + 10240;
    float ssq = 0.f;
#pragma unroll
    for (int j = 0; j < 2; j++)
#pragma unroll
      for (int q = 0; q < 4; q++) {
        int col = (j * 64 + lane) * 16 + q * 4;
        float4 xa = *(const float4*)(p.x1 + (size_t)t * DM + col);
        float4 ga = *(const float4*)(md + col);
        float4 oa = make_float4(xa.x + ga.x * acc[j * 16 + q * 4], xa.y + ga.y * acc[j * 16 + q * 4 + 1], xa.z + ga.z * acc[j * 16 + q * 4 + 2], xa.w + ga.w * acc[j * 16 + q * 4 + 3]);
        *(float4*)(dst + (size_t)t * DM + col) = oa;
        acc[j * 16 + q * 4] = oa.x; acc[j * 16 + q * 4 + 1] = oa.y; acc[j * 16 + q * 4 + 2] = oa.z; acc[j * 16 + q * 4 + 3] = oa.w;
        ssq += oa.x * oa.x + oa.y * oa.y + oa.z * oa.z + oa.w * oa.w;
      }
    if (l == 0) {
      ssq = wave_sum(ssq);
      const float rinv = rsqrtf(ssq * (1.f / DM) + 1e-6f);
      const float* g = p.norm_mix_g + DM;
      const float* md1 = p.mod + (size_t)(5 + cvidx(t)) * 12288;
#pragma unroll
      for (int j = 0; j < 2; j++)
#pragma unroll
        for (int q = 0; q < 4; q++) {
          int col = (j * 64 + lane) * 16 + q * 4;
          float4 gg = *(const float4*)(g + col), sc = *(const float4*)(md1 + 2048 + col), sh = *(const float4*)(md1 + col);
          float y0 = acc[j * 16 + q * 4] * rinv * gg.x * (1.f + sc.x) + sh.x;
          float y1 = acc[j * 16 + q * 4 + 1] * rinv * gg.y * (1.f + sc.y) + sh.y;
          float y2 = acc[j * 16 + q * 4 + 2] * rinv * gg.z * (1.f + sc.z) + sh.z;
          float y3 = acc[j * 16 + q * 4 + 3] * rinv * gg.w * (1.f + sc.w) + sh.w;
          uint2 o; o.x = pack_bf16(y0, y1); o.y = pack_bf16(y2, y3);
          *(uint2*)(p.hn + (size_t)t * DM + col) = o;
        }
    }
    }
    __syncthreads();
  }
}

DI void gsync(unsigned* bar, unsigned& gen) {
  asm volatile("s_waitcnt vmcnt(0) lgkmcnt(0)" ::: "memory");
  __syncthreads();
  if (threadIdx.x == 0) {
    __builtin_amdgcn_fence(__ATOMIC_RELEASE, "agent");
    asm volatile("s_waitcnt vmcnt(0)" ::: "memory");
    gen++;
    const unsigned target = gen * gridDim.x;
    __hip_atomic_fetch_add(bar, 1u, __ATOMIC_RELAXED, __HIP_MEMORY_SCOPE_AGENT);
    while (__hip_atomic_load(bar, __ATOMIC_RELAXED, __HIP_MEMORY_SCOPE_AGENT) < target) __builtin_amdgcn_s_sleep(4);
    __builtin_amdgcn_fence(__ATOMIC_ACQUIRE, "agent");
    asm volatile("s_waitcnt vmcnt(0)" ::: "memory");
  }
  __syncthreads();
}

DI void dump_bf16(const Params& p, const ushort_t* src) {
  size_t n = (size_t)NTOK * DM; size_t tot = n + 16 * 2 * 256 * 256 + 16 * 2 * 256 * 64 + 16 * 2 * 2 * 512;
  for (size_t i = (size_t)blockIdx.x * 256 + threadIdx.x; i < tot; i += (size_t)gridDim.x * 256)
    p.out[i] = i < n ? __uint_as_float(((unsigned)src[i]) << 16) : (i < n + 2 * 5 * 12288 ? p.mod[i - n] : 0.f);
}


DI void dump_f32(const Params& p, const float* src, size_t n) {
  size_t tot = (size_t)NTOK * DM + 16 * 2 * 256 * 256 + 16 * 2 * 256 * 64 + 16 * 2 * 2 * 512;
  for (size_t i = (size_t)blockIdx.x * 256 + threadIdx.x; i < tot; i += (size_t)gridDim.x * 256)
    p.out[i] = i < n ? src[i] : 0.f;
}

__global__ void __launch_bounds__(256, 2) fwd_megakernel(Params pk) {
  __shared__ __attribute__((aligned(16))) char smem[SMEM_BYTES];
  __shared__ __attribute__((aligned(16))) unsigned long long spw[(sizeof(Params) + 7) / 8];
  {
    const unsigned long long* ka = (const unsigned long long*)__builtin_amdgcn_kernarg_segment_ptr();
    if (threadIdx.x < (sizeof(Params) + 7) / 8) spw[threadIdx.x] = ka[threadIdx.x];
    __syncthreads();
  }
#define PP (*(const Params*)((const char*)spw + opaque(0)))
  unsigned gen = 0; unsigned* bar = PP.bar;
  const int nb = gridDim.x, bid = blockIdx.x;
  const int wave = threadIdx.x >> 6, lane = threadIdx.x & 63;

  for (int rep = 0; rep < REP_A; rep++) {
  { const Params& p = PP; prep_phase(p, smem); }
  gsync(bar, gen);
  }

  for (int l = 0; l < 2; l++) {
    for (int rep = 0; rep < REP_D; rep++) {
    if (l == 0) { { const Params& p = PP; norm_phase(p, l, 0); } gsync(bar, gen); }
    }
    for (int rep = 0; rep < REP_B; rep++) {
    {
      const Params& p = PP;
      const ushort_t* Bt = p.WinT + (size_t)l * INW * DM;
      float* z = p.z;
      for (int j = bid >> 3; j < 192; j += nb >> 3) {
        int mt = (bid & 7) * 8 + ((j & 63) >> 3), nt = (j >> 6) * 8 + (j & 7);
        if (nt >= 23) continue;
        gemm_tile(p.hn, DM, Bt, DM, DM, INW, mt * 128, nt * 128, smem, [&](int row, int col, float v) { z[(size_t)row * INW + col] = v; });
      }
    }
    gsync(bar, gen);
    }
    for (int rep = 0; rep < REP_D; rep++) {
    {
      const Params& p = PP;
      for (int it = bid; it < 512 + NTOK / CMT; it += nb) {
        if (it < 512) lru_item(p, l, it, smem); else cm_item(p, l, it - 512, smem);
      }
    }
    { const Params& p = PP; post_inproj_tokens(p, l); }
    gsync(bar, gen);
    }
    for (int rep = 0; rep < REP_B; rep++) {
    {
      const Params& p = PP;
      const ushort_t* Bq = p.WqbT + (size_t)l * 1536 * 512;
      const ushort_t* Bkv = p.WkvbT + (size_t)l * 2048 * 256;
      ushort_t* qraw = p.qraw; ushort_t* kvraw = p.kvraw;
      for (int j = bid >> 3; j < 256; j += nb >> 3) {
        if (j < 160) {
          int rem = j % 80; int mt = (bid & 7) * 10 + (rem >> 3), nt = (j / 80) * 8 + (rem & 7);
          gemm_tile(p.ckv, 256, Bkv, 256, 256, 2048, mt * 128, nt * 128, smem, [&](int row, int col, float v) { kvraw[(size_t)row * 2048 + col] = f2bf(v); });
        } else {
          int j2 = j - 160; int rem = j2 % 48; int mt = (bid & 7) * 8 + rem / 6, nt = (j2 / 48) * 6 + rem % 6;
          gemm_tile(p.qa, 512, Bq, 512, 512, 1536, mt * 128, nt * 128, smem, [&](int row, int col, float v) { qraw[(size_t)row * 1536 + col] = f2bf(v); });
        }
      }
    }
    gsync(bar, gen);
    }
    for (int rep = 0; rep < REP_D; rep++) {
    { const Params& p = PP; for (int it = bid; it < 160 * 8; it += nb) kv_item(p, l, it, smem); }
    { const Params& p = PP; qnorm_tokens(p, l); }
    gsync(bar, gen);
    }
    for (int rep = 0; rep < REP_D; rep++) {
    { const Params& p = PP; for (int it = bid; it < 1024; it += nb) attn_item(p, it, smem); }
    gsync(bar, gen);
    }
    for (int rep = 0; rep < REP_D; rep++) {
    { const Params& p = PP; merge_tokens(p, l); }
    gsync(bar, gen);
    }
    for (int rep = 0; rep < REP_B; rep++) {
    {
      const Params& p = PP;
      const ushort_t* Bt = p.WoutT + (size_t)l * DM * DM;
      float* x1 = p.x1;
      for (int j = bid >> 3; j < 128; j += nb >> 3) {
        int mt = (bid & 7) * 8 + ((j & 63) >> 3), nt = (j >> 6) * 8 + (j & 7);
        gemm_tile(p.mixed, DM, Bt, DM, DM, DM, mt * 128, nt * 128, smem, [&](int row, int col, float v) {
          const float* xr = xrow_in(p, l, row);
          float g1 = p.mod[(size_t)(l * 5 + cvidx(row)) * 12288 + 4096 + col];
          x1[(size_t)row * DM + col] = xr[col] + g1 * v;
        });
      }
    }
    gsync(bar, gen);
    }
    for (int rep = 0; rep < REP_D; rep++) {
    { const Params& p = PP; norm_phase(p, l, 1); }
    gsync(bar, gen);
    }
    for (int rep = 0; rep < REP_B; rep++) {
    {
      const Params& p = PP;
      const ushort_t* Bt = p.WpqT + (size_t)l * DM * DM;
      ushort_t* pq = p.mixed;
      for (int j = bid >> 3; j < 128; j += nb >> 3) {
        int mt = (bid & 7) * 8 + ((j & 63) >> 3), nt = (j >> 6) * 8 + (j & 7);
        gemm_tile(p.hn, DM, Bt, DM, DM, DM, mt * 128, nt * 128, smem, [&](int row, int col, float v) { pq[(size_t)row * DM + col] = f2bf(v); });
      }
    }
    gsync(bar, gen);
    }
    for (int rep = 0; rep < REP_B; rep++) {
    {
      const Params& p = PP;
      const ushort_t* Kb = p.KeysB + (size_t)l * 2048 * 128;
      float* sc = p.z;
      for (int j = bid >> 3; j < 128; j += nb >> 3) {
        int mt = (bid & 7) * 8 + ((j & 63) >> 3), nt = (j >> 6) * 8 + (j & 7);
        gemm_tile(p.mixed + nt * 128, DM, Kb + (size_t)nt * 128 * 128, 128, 128, 128, mt * 128, 0, smem, [&](int row, int col, float v) { sc[(size_t)row * 2048 + nt * 128 + col] = v; });
      }
    }
    gsync(bar, gen);
    }
    for (int rep = 0; rep < REP_C; rep++) {
    { const Params& p = PP; peer_phase(p, l, smem); }
    gsync(bar, gen);
    }
  }
}

extern "C" void kernel_launch(void* const* d_in, const int* in_sizes, int n_in, void* d_out, int out_size, void* d_ws, size_t ws_size, hipStream_t stream) {
  static int grid_blocks = 0;
  if (!grid_blocks) {
    int dev = 0, cus = 0, per_cu = 0;
    hipGetDevice(&dev);
    hipDeviceGetAttribute(&cus, hipDeviceAttributeMultiprocessorCount, dev);
    hipOccupancyMaxActiveBlocksPerMultiprocessor(&per_cu, fwd_megakernel, 256, 0);
    if (per_cu > 2) per_cu = 2;
    if (per_cu < 1) per_cu = 1;
    grid_blocks = cus * per_cu;
  }
  Params p{};
  const float** pin = (const float**)&p;
  for (int i = 0; i < 35; i++) pin[i] = (const float*)d_in[i];
  p.out = (float*)d_out;
  char* w = (char*)d_ws; size_t off = 0;
  auto take = [&](size_t bytes) { char* r = w + off; off += (bytes + 255) & ~(size_t)255; return r; };
  p.bar = (unsigned*)take(256);
  p.WinT = (ushort_t*)take((size_t)2 * INW * DM * 2);
  p.WqbT = (ushort_t*)take((size_t)2 * 1536 * 512 * 2);
  p.WkvbT = (ushort_t*)take((size_t)2 * 2048 * 256 * 2);
  p.WoutT = (ushort_t*)take((size_t)2 * DM * DM * 2);
  p.WpqT = (ushort_t*)take((size_t)2 * DM * DM * 2);
  p.KeysB = (ushort_t*)take((size_t)2 * 2048 * 128 * 2);
  p.LruW = (ushort_t*)take((size_t)2 * 16 * 2 * 4096 * 2);
  p.Ub = (unsigned char*)take((size_t)2 * NEXP * DM);
  p.Vb = (unsigned char*)take((size_t)2 * NEXP * DM);
  p.Us = (float*)take((size_t)2 * NEXP * 4);
  p.Vs = (float*)take((size_t)2 * NEXP * 4);
  p.hn = (ushort_t*)take((size_t)NTOK * DM * 2);
  p.qa = (ushort_t*)take((size_t)NTOK * 512 * 2);
  p.ckv = (ushort_t*)take((size_t)NKV * 256 * 2);
  p.Q = (ushort_t*)take((size_t)NTOK * 1536 * 2);
  p.K = (ushort_t*)take((size_t)NKV * 1536 * 2);
  p.Vt = (ushort_t*)take((size_t)NKV * 1024 * 2);
  p.mixed = (ushort_t*)take((size_t)NTOK * DM * 2);
  p.z = (float*)take((size_t)NTOK * INW * 4);
  p.qraw = (ushort_t*)take((size_t)NTOK * 1536 * 2);
  p.kvraw = (ushort_t*)take((size_t)NKV * 2048 * 2);
  p.attn = (ushort_t*)take((size_t)NTOK * 1024 * 2);
  p.hs = (ushort_t*)take((size_t)2 * NTOK * 512 * 2);
  p.Pc = (ushort_t*)take((size_t)2 * NTOK * 512 * 2);
  p.hend = (float*)take((size_t)2 * 32 * 512 * 4);
  p.Pend = (float*)take((size_t)2 * 32 * 512 * 4);
  p.x1 = (float*)take((size_t)NTOK * DM * 4);
  p.xA = (float*)take((size_t)NTOK * DM * 4);
  p.mod = (float*)take((size_t)2 * 5 * 12288 * 4);
  p.rope = (float*)take((size_t)1024 * 64 * 4);
  if (off > ws_size) { fprintf(stderr, "workspace too small: need %zu have %zu\n", off, ws_size); return; }
  if (hipMemsetAsync(p.bar, 0, 256, stream) != hipSuccess) { fprintf(stderr, "memset failed\n"); return; }
  hipLaunchKernelGGL(fwd_megakernel, dim3(grid_blocks), dim3(256), 0, stream, p);
}
```

```cpp
#include <hip/hip_runtime.h>
#include <hip/hip_cooperative_groups.h>
#include <cstdio>
#include <cstdint>
namespace cg = cooperative_groups;

typedef unsigned short ushort_t;
typedef __attribute__((ext_vector_type(8))) short bf16x8;
typedef __attribute__((ext_vector_type(16))) float f32x16;
typedef __attribute__((ext_vector_type(4))) unsigned u32x4;
typedef __attribute__((ext_vector_type(4))) float f32x4;
typedef __attribute__((ext_vector_type(2))) float f32x2_t;
typedef __attribute__((ext_vector_type(2))) __bf16 bf16x2_t;
#define DI __device__ __forceinline__
#define GAS __attribute__((address_space(1)))
#define GLD16(ptr) (*(const GAS u32x4*)(ptr))
#define MFMA32(a, b, c) __builtin_amdgcn_mfma_f32_32x32x16_bf16((a), (b), (c), 0, 0, 0)

#define DM 2048
#define NTOK 8192
#define NCTX 4096
#define INW 2880
#define NKV 10240
#define OFF_ZKV 512
#define OFF_ZKR 768
#define OFF_ZX 832
#define OFF_ZG 1344
#define OFF_ZC 1856
#define NEXP 16384
#define SMEM_BYTES 78848
#ifndef REP_A
#define REP_A 1
#define REP_B 1
#define REP_C 1
#define REP_D 1
#endif

struct Params {
  const float *x_prompt, *x_sample, *cache_ckv, *cache_krope, *state_lru, *c, *c_ctx;
  const float *ada_w, *ada_b, *norm_mix_g, *w_in, *mla_qa_g, *mla_w_qb, *mla_q_g, *mla_kva_g, *mla_w_kvb, *mla_k_g;
  const float *lru_conv_w, *lru_conv_b, *lru_w_a, *lru_b_a, *lru_w_i, *lru_b_i, *lru_lam;
  const float *cm_dw_w, *cm_dw_b, *cm_ln_g, *cm_ln_b, *grp_g, *w_out, *norm_ffn_g;
  const float *peer_w_q, *peer_keys, *peer_u, *peer_v;
  float* out;
  unsigned* bar;
  ushort_t *WinT, *WqbT, *WkvbT, *WoutT, *WpqT, *KeysB, *LruW;
  unsigned char *Ub, *Vb;
  float *Us, *Vs;
  ushort_t *hn, *qa, *ckv, *Q, *K, *Vt, *mixed;
  ushort_t *qraw, *kvraw, *attn, *hs, *Pc;
  float *z, *hend, *Pend, *x1, *xA, *mod, *rope;
};

DI unsigned pack_bf16(float lo, float hi) { f32x2_t v = {lo, hi}; bf16x2_t b = __builtin_convertvector(v, bf16x2_t); return __builtin_bit_cast(unsigned, b); }
DI ushort_t f2bf(float x) { return (ushort_t)(pack_bf16(x, 0.f) & 0xffffu); }
DI float bf_lo(unsigned u) { return __uint_as_float(u << 16); }
DI float bf_hi(unsigned u) { return __uint_as_float(u & 0xffff0000u); }
DI float wave_sum(float v) { for (int o = 32; o; o >>= 1) v += __shfl_xor(v, o); return v; }
DI float sigmoidf_(float x) { return 1.f / (1.f + __expf(-x)); }
DI float gelu_tanh(float x) { return 0.5f * x * (1.f + tanhf(0.7978845608028654f * (x + 0.044715f * x * x * x))); }
DI int crow(int reg, int h) { return (reg & 3) + 8 * (reg >> 2) + 4 * h; }
DI int cvidx(int t) { return t < NCTX ? 0 : 1 + ((t - NCTX) >> 10); }
DI int kvrow_of_token(int t) { if (t < NCTX) return t; int tl = t - NCTX; return NCTX + (tl >> 10) * 1536 + 512 + (tl & 1023); }
DI const float* xrow_in(const Params& p, int l, int t) {
  if (l == 0) return t < NCTX ? p.x_prompt + (size_t)t * DM : p.x_sample + (size_t)(t - NCTX) * DM;
  return p.xA + (size_t)t * DM;
}
DI float dot2bf(unsigned a, unsigned b, float acc) { return __builtin_amdgcn_fdot2_f32_bf16(__builtin_bit_cast(bf16x2_t, a), __builtin_bit_cast(bf16x2_t, b), acc, false); }
DI int opaque(int x) { asm volatile("" : "+v"(x)); return x; }
DI float rdlane_f(float v, int l) { return __int_as_float(__builtin_amdgcn_readlane(__float_as_int(v), l)); }

#define GLD 72
template <class Epi>
DI void gemm_tile(const ushort_t* A, int lda, const ushort_t* Bt, int ldb, int K, int N, int m0, int n0, char* smem, Epi epi) {
  ushort_t* sA = (ushort_t*)smem;
  ushort_t* sB = sA + 128 * GLD;
  const int tid = opaque(threadIdx.x), wave = tid >> 6, lane = tid & 63, wm = wave & 1, wn = wave >> 1;
  const int r = lane & 31, h = lane >> 5;
  f32x16 acc[2][2];
#pragma unroll
  for (int i = 0; i < 2; i++)
#pragma unroll
    for (int j = 0; j < 2; j++)
#pragma unroll
      for (int e = 0; e < 16; e++) acc[i][j][e] = 0.f;
  u32x4 ra0[4], rb0[4], ra1[4], rb1[4];
  const int lrow = tid >> 3, lkc = (tid & 7) * 8;
  const ushort_t* Ap = A + (size_t)(m0 + lrow) * lda + lkc;
  const ushort_t* Bp[4];
#pragma unroll
  for (int i = 0; i < 4; i++) { int br = n0 + lrow + 32 * i; br = br < N ? br : N - 1; Bp[i] = Bt + (size_t)br * ldb + lkc; }
  auto gload = [&](u32x4* ra, u32x4* rb, int k0) {
#pragma unroll
    for (int i = 0; i < 4; i++) {
      ra[i] = GLD16(Ap + (size_t)(32 * i) * lda + k0);
      rb[i] = GLD16(Bp[i] + k0);
    }
  };
  auto lstore = [&](const u32x4* ra, const u32x4* rb, int buf) {
    ushort_t* dA = sA + buf * (2 * 128 * GLD) + lrow * GLD + lkc;
    ushort_t* dB = sB + buf * (2 * 128 * GLD) + lrow * GLD + lkc;
#pragma unroll
    for (int i = 0; i < 4; i++) { *(u32x4*)(dA + 32 * i * GLD) = ra[i]; *(u32x4*)(dB + 32 * i * GLD) = rb[i]; }
  };
  auto compute = [&](int buf) {
    const ushort_t* cA = sA + buf * (2 * 128 * GLD);
    const ushort_t* cB = sB + buf * (2 * 128 * GLD);
    bf16x8 a[2][2], b[2][2];
#pragma unroll
    for (int i = 0; i < 2; i++) {
      a[0][i] = *(const bf16x8*)(cA + (wm * 64 + i * 32 + r) * GLD + h * 8);
      b[0][i] = *(const bf16x8*)(cB + (wn * 64 + i * 32 + r) * GLD + h * 8);
    }
#pragma unroll
    for (int ks = 0; ks < 4; ks++) {
      if (ks < 3) {
#pragma unroll
        for (int i = 0; i < 2; i++) {
          a[(ks + 1) & 1][i] = *(const bf16x8*)(cA + (wm * 64 + i * 32 + r) * GLD + (ks + 1) * 16 + h * 8);
          b[(ks + 1) & 1][i] = *(const bf16x8*)(cB + (wn * 64 + i * 32 + r) * GLD + (ks + 1) * 16 + h * 8);
        }
      }
#pragma unroll
      for (int i = 0; i < 2; i++)
#pragma unroll
        for (int j = 0; j < 2; j++) acc[i][j] = MFMA32(a[ks & 1][i], b[ks & 1][j], acc[i][j]);
    }
  };
  gload(ra0, rb0, 0);
  gload(ra1, rb1, 64);
  lstore(ra0, rb0, 0);
  __syncthreads();
  const int klast = K - 64;
  gload(ra0, rb0, 128 < K ? 128 : klast);
  for (int k0 = 0; k0 < K; k0 += 128) {
    compute(0);
    lstore(ra1, rb1, 1);
    __syncthreads();
    gload(ra1, rb1, k0 + 192 < K ? k0 + 192 : klast);
    compute(1);
    lstore(ra0, rb0, 0);
    __syncthreads();
    gload(ra0, rb0, k0 + 256 < K ? k0 + 256 : klast);
  }
#pragma unroll
  for (int i = 0; i < 2; i++)
#pragma unroll
    for (int j = 0; j < 2; j++)
#pragma unroll
      for (int e = 0; e < 16; e++) {
        int row = m0 + wm * 64 + i * 32 + crow(e, h);
        int col = n0 + wn * 64 + j * 32 + r;
        if (col < N) epi(row, col, acc[i][j][e]);
      }
  __syncthreads();
}

DI void transpose_item(const float* src, int lds_, ushort_t* dst, int ldd, int kt, int nt, float* tile) {
  int tid = opaque(threadIdx.x); int c = tid & 63, r0 = tid >> 6;
#pragma unroll 4
  for (int i = 0; i < 16; i++) { int r = r0 + 4 * i; tile[r * 65 + c] = src[(size_t)(kt * 64 + r) * lds_ + nt * 64 + c]; }
  __syncthreads();
#pragma unroll 4
  for (int i = 0; i < 16; i++) { int r = r0 + 4 * i; dst[(size_t)(nt * 64 + r) * ldd + kt * 64 + c] = f2bf(tile[c * 65 + r]); }
  __syncthreads();
}

DI void convert_chunk(const float* src, ushort_t* dst, size_t base) {
  int tid = opaque(threadIdx.x);
#pragma unroll
  for (int it = 0; it < 4; it++) {
    size_t e = base + it * 2048 + tid * 8;
    float4 a = *(const float4*)(src + e), b = *(const float4*)(src + e + 4);
    uint4 o; o.x = pack_bf16(a.x, a.y); o.y = pack_bf16(a.z, a.w); o.z = pack_bf16(b.x, b.y); o.w = pack_bf16(b.z, b.w);
    *(uint4*)(dst + e) = o;
  }
}


DI void quant_rows(const float* src, unsigned char* dst, float* scl, size_t row0) {
  int tid = opaque(threadIdx.x); int wave = tid >> 6, lane = tid & 63;
  size_t row = row0 + wave;
  const float* r = src + row * DM;
  float4 v[8]; float am = 0.f;
#pragma unroll
  for (int j = 0; j < 8; j++) { v[j] = *(const float4*)(r + (j * 64 + lane) * 4); am = fmaxf(am, fmaxf(fmaxf(fabsf(v[j].x), fabsf(v[j].y)), fmaxf(fabsf(v[j].z), fabsf(v[j].w)))); }
  for (int o = 32; o; o >>= 1) am = fmaxf(am, __shfl_xor(am, o));
  float sc = am > 0.f ? 224.f / am : 1.f;
  if (lane == 0) scl[row] = am > 0.f ? am * (1.f / 224.f) : 1.f;
#pragma unroll
  for (int j = 0; j < 8; j++) {
    int w = 0;
    w = __builtin_amdgcn_cvt_pk_fp8_f32(v[j].x * sc, v[j].y * sc, w, false);
    w = __builtin_amdgcn_cvt_pk_fp8_f32(v[j].z * sc, v[j].w * sc, w, true);
    *(int*)(dst + row * DM + (j * 64 + lane) * 4) = w;
  }
}

DI void mod_item(const Params& p, int item, char* smem) {
  int l = item / 48, cgp = item % 48;
  float* s = (float*)smem;
  float* red = s + 5 * 2048;
  int tid = opaque(threadIdx.x), wave = tid >> 6, lane = tid & 63;
  for (int i = tid; i < 5 * 2048; i += 256) {
    int cv = i >> 11, k = i & 2047;
    float v = cv == 0 ? p.c_ctx[k] : p.c[(cv - 1) * DM + k];
    s[i] = v * sigmoidf_(v);
  }
  __syncthreads();
  const float* W = p.ada_w + (size_t)l * DM * 12288 + cgp * 256 + lane * 4;
  float4 acc[5];
#pragma unroll
  for (int cv = 0; cv < 5; cv++) acc[cv] = make_float4(0, 0, 0, 0);
  int kb = wave * 512;
#pragma unroll 8
  for (int k = kb; k < kb + 512; k++) {
    float4 w = *(const float4*)(W + (size_t)k * 12288);
#pragma unroll
    for (int cv = 0; cv < 5; cv++) {
      float sv = s[cv * 2048 + k];
      acc[cv].x += sv * w.x; acc[cv].y += sv * w.y; acc[cv].z += sv * w.z; acc[cv].w += sv * w.w;
    }
  }
#pragma unroll
  for (int cv = 0; cv < 5; cv++) *(float4*)(red + (wave * 5 + cv) * 256 + lane * 4) = acc[cv];
  __syncthreads();
  for (int i = tid; i < 5 * 256; i += 256) {
    int cv = i >> 8, col = i & 255;
    float v = red[(0 * 5 + cv) * 256 + col] + red[(1 * 5 + cv) * 256 + col] + red[(2 * 5 + cv) * 256 + col] + red[(3 * 5 + cv) * 256 + col];
    int gc = cgp * 256 + col;
    p.mod[(size_t)(l * 5 + cv) * 12288 + gc] = v + p.ada_b[l * 12288 + gc];
  }
  __syncthreads();
}

#define N_MOD 96
#define N_TR_LAYER 3840
#define N_TR (2 * N_TR_LAYER)
#define N_CV_KEYS 64
#define N_CV_U 8192
#define N_PREP (N_MOD + N_TR + N_CV_KEYS + 2 * N_CV_U + 1)

DI void prep_phase(const Params& p, char* smem) {
  for (int it = blockIdx.x; it < N_PREP; it += gridDim.x) {
    if (it < N_MOD) { mod_item(p, it, smem); continue; }
    int i = it - N_MOD;
    if (i < N_TR) {
      int l = i / N_TR_LAYER, j = i % N_TR_LAYER;
      float* tile = (float*)smem;
      if (j < 1440) { transpose_item(p.w_in + (size_t)l * DM * INW, INW, p.WinT + (size_t)l * INW * DM, DM, j / 45, j % 45, tile); continue; }
      j -= 1440;
      if (j < 192) { transpose_item(p.mla_w_qb + (size_t)l * 512 * 1536, 1536, p.WqbT + (size_t)l * 1536 * 512, 512, j / 24, j % 24, tile); continue; }
      j -= 192;
      if (j < 128) { transpose_item(p.mla_w_kvb + (size_t)l * 256 * 2048, 2048, p.WkvbT + (size_t)l * 2048 * 256, 256, j / 32, j % 32, tile); continue; }
      j -= 128;
      if (j < 1024) { transpose_item(p.w_out + (size_t)l * DM * DM, DM, p.WoutT + (size_t)l * DM * DM, DM, j / 32, j % 32, tile); continue; }
      j -= 1024;
      if (j < 1024) { transpose_item(p.peer_w_q + (size_t)l * DM * DM, DM, p.WpqT + (size_t)l * DM * DM, DM, j / 32, j % 32, tile); continue; }
      j -= 1024;
      {
        int mat = j >> 4, dh = j & 15;
        const float* src = (mat ? p.lru_w_i : p.lru_w_a) + (size_t)(l * 16 + dh) * 4096;
        ushort_t* dst = p.LruW + ((size_t)(l * 16 + dh) * 2 + mat) * 4096;
        transpose_item(src, 64, dst, 64, 0, 0, tile);
      }
      continue;
    }
    i -= N_TR;
    if (i < N_CV_KEYS) { convert_chunk(p.peer_keys, p.KeysB, (size_t)i * 8192); continue; }
    i -= N_CV_KEYS;
    if (i < N_CV_U) { quant_rows(p.peer_u, p.Ub, p.Us, (size_t)i * 4); continue; }
    i -= N_CV_U;
    if (i < N_CV_U) { quant_rows(p.peer_v, p.Vb, p.Vs, (size_t)i * 4); continue; }
    for (int e = threadIdx.x; e < 1024 * 32; e += 256) {
      int pos = e >> 5, f = e & 31;
      int fi = f & 15;
      float inv = 1.0f / powf(10000.0f, (float)fi / 16.0f);
      float base = (f < 16) ? (float)(pos >> 6) : (float)(pos & 63);
      float ang = base * inv;
      float sn, cs; sincosf(ang, &sn, &cs);
      p.rope[pos * 64 + f] = cs; p.rope[pos * 64 + 32 + f] = sn;
    }
  }
}

DI void norm_phase(const Params& p, int l, int which) {
  int tidq = opaque(threadIdx.x); int lane = tidq & 63, gw = blockIdx.x * 4 + (tidq >> 6), nw = gridDim.x * 4;
  const float* g = (which ? p.norm_ffn_g : p.norm_mix_g) + l * DM;
  int sh_off = which ? 6144 : 0, sc_off = which ? 8192 : 2048;
  for (int t = gw; t < NTOK; t += nw) {
    const float* xr = which ? p.x1 + (size_t)t * DM : xrow_in(p, l, t);
    const float* md = p.mod + (size_t)(l * 5 + cvidx(t)) * 12288;
    float4 v[8]; float ss = 0.f;
#pragma unroll
    for (int j = 0; j < 8; j++) { v[j] = *(const float4*)(xr + j * 256 + lane * 4); ss += v[j].x * v[j].x + v[j].y * v[j].y + v[j].z * v[j].z + v[j].w * v[j].w; }
    ss = wave_sum(ss);
    float rinv = rsqrtf(ss * (1.f / DM) + 1e-6f);
#pragma unroll
    for (int j = 0; j < 8; j++) {
      int col = j * 256 + lane * 4;
      float4 gg = *(const float4*)(g + col), sc = *(const float4*)(md + sc_off + col), sh = *(const float4*)(md + sh_off + col);
      float y0 = v[j].x * rinv * gg.x * (1.f + sc.x) + sh.x;
      float y1 = v[j].y * rinv * gg.y * (1.f + sc.y) + sh.y;
      float y2 = v[j].z * rinv * gg.z * (1.f + sc.z) + sh.z;
      float y3 = v[j].w * rinv * gg.w * (1.f + sc.w) + sh.w;
      uint2 o; o.x = pack_bf16(y0, y1); o.y = pack_bf16(y2, y3);
      *(uint2*)(p.hn + (size_t)t * DM + col) = o;
    }
  }
}

DI void lru_item(const Params& p, int l, int item, char* smem) {
  int ch = item >> 4, hd = (item >> 1) & 7, d = item & 1;
  int t0 = ch * 256, seq_t0, T, p0;
  if (ch < 16) { seq_t0 = ch * 256; T = 256; p0 = 0; }
  else { int b = (ch - 16) >> 2, cc = (ch - 16) & 3; seq_t0 = NCTX + b * 1024; T = 1024; p0 = cc * 256; }
  ushort_t* sBt = (ushort_t*)smem;
  ushort_t* sA = sBt + 128 * GLD;
  float* sXc = (float*)(sA + 64 * GLD);
  float* sG = sXc + 64 * 64;
  const int tid = opaque(threadIdx.x), wave = tid >> 6, lane = tid & 63;
  const int c = tid & 63, tg = tid >> 6;
  const ushort_t* Bt = p.LruW + ((size_t)((l * 2 + d) * 8 + hd) * 2) * 4096;
#pragma unroll
  for (int i = 0; i < 4; i++) { int cidx = tid + i * 256; int row = cidx >> 3, kc = (cidx & 7) * 8; *(uint4*)(sBt + row * GLD + kc) = *(const uint4*)(Bt + row * 64 + kc); }
  const int chn = hd * 64 + c;
  float cw[4];
#pragma unroll
  for (int j = 0; j < 4; j++) cw[j] = p.lru_conv_w[(l * 4 + j) * 512 + chn];
  const float cb = p.lru_conv_b[l * 512 + chn];
  const float ba = p.lru_b_a[(l * 2 + d) * 512 + chn], bi = p.lru_b_i[(l * 2 + d) * 512 + chn];
  const float lam = p.lru_lam[(l * 2 + d) * 512 + chn];
  const float sp = log1pf(expf(-lam));
  float hst = 0.f, Pp = 1.f;
  const int r = lane & 31, h8 = lane >> 5;
  for (int si = 0; si < 4; si++) {
    int sub = d ? 3 - si : si;
#pragma unroll 4
    for (int i = 0; i < 16; i++) {
      int lt = tg * 16 + i; int pos = p0 + sub * 64 + lt;
      float xc = cb;
#pragma unroll
      for (int j = 0; j < 4; j++) {
        int q = pos - 2 + j;
        float zv = (q >= 0 && q < T) ? p.z[(size_t)(seq_t0 + q) * INW + OFF_ZX + chn] : 0.f;
        xc += cw[j] * zv;
      }
      sXc[lt * 64 + c] = xc; sA[lt * GLD + c] = f2bf(xc);
    }
    __syncthreads();
    {
      int mt = wave & 1, nh = wave >> 1;
      f32x16 acc[2];
#pragma unroll
      for (int i = 0; i < 2; i++)
#pragma unroll
        for (int e = 0; e < 16; e++) acc[i][e] = 0.f;
#pragma unroll
      for (int ks = 0; ks < 4; ks++) {
        bf16x8 a = *(const bf16x8*)(sA + (mt * 32 + r) * GLD + ks * 16 + h8 * 8);
#pragma unroll
        for (int ni = 0; ni < 2; ni++) {
          bf16x8 b = *(const bf16x8*)(sBt + (nh * 64 + ni * 32 + r) * GLD + ks * 16 + h8 * 8);
          acc[ni] = MFMA32(a, b, acc[ni]);
        }
      }
#pragma unroll
      for (int ni = 0; ni < 2; ni++)
#pragma unroll
        for (int e = 0; e < 16; e++) sG[(mt * 32 + crow(e, h8)) * 132 + nh * 64 + ni * 32 + r] = acc[ni][e];
    }
    __syncthreads();
#pragma unroll 4
    for (int i = 0; i < 16; i++) {
      int lt = tg * 16 + i;
      float ga = sG[lt * 132 + c] + ba, gi = sG[lt * 132 + 64 + c] + bi;
      float rr = 1.f / (1.f + expf(-ga)), ii = 1.f / (1.f + expf(-gi));
      float la = -8.0f * rr * sp;
      float a = expf(la);
      float u = sqrtf(-expm1f(2.f * la)) * ii * sXc[lt * 64 + c];
      sG[lt * 132 + c] = a; sG[lt * 132 + 64 + c] = u;
    }
    __syncthreads();
    if (tid < 64) {
      for (int s = 0; s < 64; s++) {
        int lt = d ? 63 - s : s;
        float a = sG[lt * 132 + c], u = sG[lt * 132 + 64 + c];
        hst = a * hst + u; Pp *= a;
        size_t o = ((size_t)d * NTOK + t0 + sub * 64 + lt) * 512 + chn;
        p.hs[o] = f2bf(hst); p.Pc[o] = f2bf(Pp);
      }
    }
    __syncthreads();
  }
  if (tid < 64) {
    p.hend[(d * 32 + ch) * 512 + chn] = hst; p.Pend[(d * 32 + ch) * 512 + chn] = Pp;
    if (ch < 16) p.out[(size_t)NTOK * DM + 16 * 2 * 256 * 256 + 16 * 2 * 256 * 64 + ((ch * 2 + l) * 2 + d) * 512 + chn] = hst;
  }
}

#define CMT 16
DI void cm_item(const Params& p, int l, int item, char* smem) {
  int t0 = item * CMT, seq_t0, T;
  if (t0 < NCTX) { seq_t0 = (t0 >> 8) << 8; T = 256; } else { seq_t0 = NCTX + (((t0 - NCTX) >> 10) << 10); T = 1024; }
  int p0 = t0 - seq_t0;
  unsigned* sGlu = (unsigned*)smem;
  float* red = (float*)(sGlu + (CMT + 30) * 256);
  float* red2 = red + 256;
  const int tid = opaque(threadIdx.x), wave = tid >> 6, lane = tid & 63;
#pragma unroll 8
  for (int rr = 0; rr < CMT + 30; rr++) {
    int pos = p0 - 15 + rr;
    unsigned v = 0;
    if (pos >= 0 && pos < T) {
      const float* zr = p.z + (size_t)(seq_t0 + pos) * INW + OFF_ZC;
      float2 a = *(const float2*)(zr + 2 * tid), b = *(const float2*)(zr + 512 + 2 * tid);
      v = pack_bf16(a.x * sigmoidf_(b.x), a.y * sigmoidf_(b.y));
    }
    sGlu[rr * 256 + tid] = v;
  }
  __syncthreads();
  float acc0[CMT], acc1[CMT];
  {
    float2 bb = *(const float2*)(p.cm_dw_b + l * 512 + 2 * tid);
#pragma unroll
    for (int t = 0; t < CMT; t++) { acc0[t] = bb.x; acc1[t] = bb.y; }
  }
  for (int j = 0; j < 31; j++) {
    float2 w = *(const float2*)(p.cm_dw_w + (size_t)(l * 31 + j) * 512 + 2 * tid);
#pragma unroll
    for (int t = 0; t < CMT; t++) { unsigned u = sGlu[(t + j) * 256 + tid]; acc0[t] += w.x * bf_lo(u); acc1[t] += w.y * bf_hi(u); }
  }
  {
    float ks = 0.f, kss = 0.f;
#pragma unroll
    for (int t = 0; t < CMT; t++) {
      float s = wave_sum(acc0[t] + acc1[t]);
      float ss = wave_sum(acc0[t] * acc0[t] + acc1[t] * acc1[t]);
      if (lane == t) { ks = s; kss = ss; }
    }
    if (lane < CMT) { red[(wave * CMT + lane) * 2] = ks; red[(wave * CMT + lane) * 2 + 1] = kss; }
  }
  __syncthreads();
  {
    float2 lg = *(const float2*)(p.cm_ln_g + l * 512 + 2 * tid), lb = *(const float2*)(p.cm_ln_b + l * 512 + 2 * tid);
    float k2 = 0.f;
#pragma unroll
    for (int t = 0; t < CMT; t++) {
      float s = red[(0 * CMT + t) * 2] + red[(1 * CMT + t) * 2] + red[(2 * CMT + t) * 2] + red[(3 * CMT + t) * 2];
      float ss = red[(0 * CMT + t) * 2 + 1] + red[(1 * CMT + t) * 2 + 1] + red[(2 * CMT + t) * 2 + 1] + red[(3 * CMT + t) * 2 + 1];
      float mu = s * (1.f / 512.f); float var = ss * (1.f / 512.f) - mu * mu; float rstd = rsqrtf(var + 1e-5f);
      float y0 = (acc0[t] - mu) * rstd * lg.x + lb.x, y1 = (acc1[t] - mu) * rstd * lg.y + lb.y;
      y0 = y0 * sigmoidf_(y0); y1 = y1 * sigmoidf_(y1);
      acc0[t] = y0; acc1[t] = y1;
      float s2 = wave_sum(y0 * y0 + y1 * y1);
      if (lane == t) k2 = s2;
    }
    if (lane < CMT) red2[wave * CMT + lane] = k2;
  }
  __syncthreads();
  {
    float2 gg = *(const float2*)(p.grp_g + l * DM + 1536 + 2 * tid);
#pragma unroll
    for (int t = 0; t < CMT; t++) {
      float tot = red2[t] + red2[CMT + t] + red2[2 * CMT + t] + red2[3 * CMT + t];
      float rinv = rsqrtf(tot * (1.f / 512.f) + 1e-6f);
      *(unsigned*)(p.mixed + (size_t)(t0 + t) * DM + 1536 + 2 * tid) = pack_bf16(acc0[t] * rinv * gg.x, acc1[t] * rinv * gg.y);
    }
  }
  __syncthreads();
}

DI void post_inproj_tokens(const Params& p, int l) {
  int tidq = opaque(threadIdx.x); int lane = tidq & 63, gw = blockIdx.x * 4 + (tidq >> 6), nw = gridDim.x * 4;
  float* new_ckv = p.out + (size_t)NTOK * DM;
  float* new_krope = new_ckv + 16 * 2 * 256 * 256;
  for (int t = gw; t < NTOK + 2048; t += nw) {
    if (t >= NTOK) {
      int rr = t - NTOK; int b = rr >> 9, j = rr & 511;
      float4 v = *(const float4*)(p.cache_ckv + ((size_t)(b * 2 + l) * 512 + j) * 256 + lane * 4);
      uint2 o; o.x = pack_bf16(v.x, v.y); o.y = pack_bf16(v.z, v.w);
      *(uint2*)(p.ckv + (size_t)(NCTX + b * 1536 + j) * 256 + lane * 4) = o;
      continue;
    }
    const float* zr = p.z + (size_t)t * INW;
    {
      float4 a = *(const float4*)(zr + lane * 4), b = *(const float4*)(zr + 256 + lane * 4);
      float ss = a.x * a.x + a.y * a.y + a.z * a.z + a.w * a.w + b.x * b.x + b.y * b.y + b.z * b.z + b.w * b.w;
      ss = wave_sum(ss);
      float rinv = rsqrtf(ss * (1.f / 512.f) + 1e-6f);
      float4 g0 = *(const float4*)(p.mla_qa_g + l * 512 + lane * 4), g1 = *(const float4*)(p.mla_qa_g + l * 512 + 256 + lane * 4);
      uint2 o0, o1;
      o0.x = pack_bf16(a.x * rinv * g0.x, a.y * rinv * g0.y); o0.y = pack_bf16(a.z * rinv * g0.z, a.w * rinv * g0.w);
      o1.x = pack_bf16(b.x * rinv * g1.x, b.y * rinv * g1.y); o1.y = pack_bf16(b.z * rinv * g1.z, b.w * rinv * g1.w);
      *(uint2*)(p.qa + (size_t)t * 512 + lane * 4) = o0;
      *(uint2*)(p.qa + (size_t)t * 512 + 256 + lane * 4) = o1;
    }
    {
      float4 a = *(const float4*)(zr + OFF_ZKV + lane * 4);
      float ss = wave_sum(a.x * a.x + a.y * a.y + a.z * a.z + a.w * a.w);
      float rinv = rsqrtf(ss * (1.f / 256.f) + 1e-6f);
      float4 g = *(const float4*)(p.mla_kva_g + l * 256 + lane * 4);
      float4 o = make_float4(a.x * rinv * g.x, a.y * rinv * g.y, a.z * rinv * g.z, a.w * rinv * g.w);
      uint2 ob; ob.x = pack_bf16(o.x, o.y); ob.y = pack_bf16(o.z, o.w);
      *(uint2*)(p.ckv + (size_t)kvrow_of_token(t) * 256 + lane * 4) = ob;
      if (t < NCTX) {
        int b = t >> 8, pos = t & 255;
        *(float4*)(new_ckv + ((size_t)(b * 2 + l) * 256 + pos) * 256 + lane * 4) = o;
        new_krope[((size_t)(b * 2 + l) * 256 + pos) * 64 + lane] = zr[OFF_ZKR + lane];
      }
    }
  }
}

DI void qnorm_tokens(const Params& p, int l) {
  int tidq = opaque(threadIdx.x); int lane = tidq & 63, gw = blockIdx.x * 4 + (tidq >> 6), nw = gridDim.x * 4;
  const float qscale = 0.07216878364870322f * 1.4426950408889634f;
  const float* g = p.mla_q_g + l * 192;
  float g0 = g[lane], g1 = g[64 + lane], g2 = g[128 + lane];
  for (int t = gw; t < NTOK; t += nw) {
    const ushort_t* qr = p.qraw + (size_t)t * 1536;
    bool lat = t >= NCTX; int pos = (t - NCTX) & 1023;
    float cs = 1.f, sn = 0.f;
    if (lat) { cs = p.rope[pos * 64 + (lane & 31)]; sn = p.rope[pos * 64 + 32 + (lane & 31)]; }
#pragma unroll
    for (int hh = 0; hh < 8; hh++) {
      float a = __uint_as_float((unsigned)qr[hh * 192 + lane] << 16), b = __uint_as_float((unsigned)qr[hh * 192 + 64 + lane] << 16), c = __uint_as_float((unsigned)qr[hh * 192 + 128 + lane] << 16);
      float ss = wave_sum(a * a + b * b + c * c);
      float rinv = rsqrtf(ss * (1.f / 192.f) + 1e-6f);
      a *= rinv * g0; b *= rinv * g1; c *= rinv * g2;
      if (lat) {
        float o = __shfl_xor(c, 32);
        c = (lane < 32) ? (c * cs - o * sn) : (o * sn + c * cs);
      }
      ushort_t* qo = p.Q + (size_t)t * 1536 + hh * 192;
      qo[lane] = f2bf(a * qscale); qo[64 + lane] = f2bf(b * qscale); qo[128 + lane] = f2bf(c * qscale);
    }
  }
}

DI void kv_item(const Params& p, int l, int item, char* smem) {
  int rt = item >> 3, hh = item & 7;
  int row0 = rt * 64;
  const int tid = opaque(threadIdx.x), wave = tid >> 6, lane = tid & 63;
  float* tile = (float*)smem;
  const float* g = p.mla_k_g + l * 192;
  float g0 = g[lane], g1 = g[64 + lane], g2 = g[128 + lane];
#pragma unroll 4
  for (int i = 0; i < 16; i++) {
    int lr = wave * 16 + i; int row = row0 + lr;
    const float* kr_src; bool rot = false; int pos = 0;
    if (row < NCTX) { kr_src = p.z + (size_t)row * INW + OFF_ZKR; }
    else {
      int rr = row - NCTX; int b = rr / 1536, j = rr % 1536;
      if (j < 512) kr_src = p.cache_krope + ((size_t)(b * 2 + l) * 512 + j) * 64;
      else { pos = j - 512; kr_src = p.z + (size_t)(NCTX + b * 1024 + pos) * INW + OFF_ZKR; rot = true; }
    }
    const ushort_t* kv = p.kvraw + (size_t)row * 2048 + hh * 256;
    float a = __uint_as_float((unsigned)kv[lane] << 16), b2 = __uint_as_float((unsigned)kv[64 + lane] << 16), c = kr_src[lane];
    float ss = wave_sum(a * a + b2 * b2 + c * c);
    float rinv = rsqrtf(ss * (1.f / 192.f) + 1e-6f);
    a *= rinv * g0; b2 *= rinv * g1; c *= rinv * g2;
    if (rot) {
      float cs = p.rope[pos * 64 + (lane & 31)], sn = p.rope[pos * 64 + 32 + (lane & 31)];
      float o = __shfl_xor(c, 32);
      c = (lane < 32) ? (c * cs - o * sn) : (o * sn + c * cs);
    }
    ushort_t* ko = p.K + (size_t)row * 1536 + hh * 192;
    ko[lane] = f2bf(a); ko[64 + lane] = f2bf(b2); ko[128 + lane] = f2bf(c);
    tile[lr * 129 + lane] = __uint_as_float((unsigned)kv[128 + lane] << 16); tile[lr * 129 + 64 + lane] = __uint_as_float((unsigned)kv[192 + lane] << 16);
  }
  __syncthreads();
  size_t vbase; int T, krow0;
  if (row0 < NCTX) { int sid = row0 >> 8; vbase = (size_t)(sid * 8 + hh) * 128 * 256; T = 256; krow0 = row0 & 255; }
  else { int rr = row0 - NCTX; int b = rr / 1536; vbase = (size_t)16 * 8 * 128 * 256 + (size_t)(b * 8 + hh) * 128 * 1536; T = 1536; krow0 = rr % 1536; }
#pragma unroll
  for (int i = 0; i < 4; i++) {
    int cidx = tid + i * 256; int dv = cidx >> 3, kg = cidx & 7;
    int G = kg >> 1, hhalf = kg & 1;
    float v[8];
#pragma unroll
    for (int s = 0; s < 8; s++) { int key = 16 * G + 8 * (s >> 2) + 4 * hhalf + (s & 3); v[s] = tile[key * 129 + dv]; }
    uint4 o; o.x = pack_bf16(v[0], v[1]); o.y = pack_bf16(v[2], v[3]); o.z = pack_bf16(v[4], v[5]); o.w = pack_bf16(v[6], v[7]);
    *(uint4*)(p.Vt + vbase + (size_t)dv * T + krow0 + kg * 8) = o;
  }
  __syncthreads();
}

#define KLD 200
#define VLD 72
DI void attn_item(const Params& p, int item, char* smem) {
  const int tid = opaque(threadIdx.x), wave = tid >> 6, lane = tid & 63;
  const int qs = wave & 1, kh = wave >> 1;
  int hh, Tk, tq0, kvbase; size_t vbase;
  if (item < 512) {
    int b = item >> 7; hh = (item >> 4) & 7; int qb = item & 15;
    Tk = 1536; tq0 = NCTX + b * 1024 + qb * 64; kvbase = NCTX + b * 1536;
    vbase = (size_t)16 * 8 * 128 * 256 + (size_t)(b * 8 + hh) * 128 * 1536;
  } else {
    int i2 = item - 512; int s = i2 >> 5; hh = (i2 >> 2) & 7; int qb = i2 & 3;
    Tk = 256; tq0 = s * 256 + qb * 64; kvbase = s * 256;
    vbase = (size_t)(s * 8 + hh) * 128 * 256;
  }
  ushort_t* sK = (ushort_t*)smem;
  ushort_t* sV = sK + 64 * KLD;
  const int r = lane & 31, h = lane >> 5;
  bf16x8 qf[12];
  {
    const ushort_t* qp = p.Q + (size_t)(tq0 + qs * 32 + r) * 1536 + hh * 192 + h * 8;
#pragma unroll
    for (int s = 0; s < 12; s++) qf[s] = *(const bf16x8*)(qp + s * 16);
  }
  f32x16 O[4];
#pragma unroll
  for (int i = 0; i < 4; i++)
#pragma unroll
    for (int e = 0; e < 16; e++) O[i][e] = 0.f;
  float m = -INFINITY, lsum = 0.f;
  const int nkt = Tk >> 6;
  const ushort_t* Kg = p.K + (size_t)kvbase * 1536 + hh * 192;
  const ushort_t* Vg = p.Vt + vbase;
  u32x4 rk[6], rv[4];
#pragma unroll
  for (int i = 0; i < 6; i++) { int c = tid + i * 256; int row = c / 24, kc = (c % 24) * 8; rk[i] = GLD16(Kg + (size_t)row * 1536 + kc); }
#pragma unroll
  for (int i = 0; i < 4; i++) { int c = tid + i * 256; int dv = c >> 3, kc = (c & 7) * 8; rv[i] = GLD16(Vg + (size_t)dv * Tk + kc); }
  for (int kt = 0; kt < nkt; kt++) {
    __syncthreads();
#pragma unroll
    for (int i = 0; i < 6; i++) { int c = tid + i * 256; int row = c / 24, kc = (c % 24) * 8; *(u32x4*)(sK + row * KLD + kc) = rk[i]; }
#pragma unroll
    for (int i = 0; i < 4; i++) { int c = tid + i * 256; int dv = c >> 3, kc = (c & 7) * 8; *(u32x4*)(sV + dv * VLD + kc) = rv[i]; }
    __syncthreads();
    if (kt + 1 < nkt) {
#pragma unroll
      for (int i = 0; i < 6; i++) { int c = tid + i * 256; int row = c / 24, kc = (c % 24) * 8; rk[i] = GLD16(Kg + (size_t)((kt + 1) * 64 + row) * 1536 + kc); }
#pragma unroll
      for (int i = 0; i < 4; i++) { int c = tid + i * 256; int dv = c >> 3, kc = (c & 7) * 8; rv[i] = GLD16(Vg + (size_t)dv * Tk + (kt + 1) * 64 + kc); }
    }
    f32x16 S;
#pragma unroll
    for (int e = 0; e < 16; e++) S[e] = 0.f;
    const ushort_t* kp = sK + (kh * 32 + r) * KLD + h * 8;
#pragma unroll
    for (int s = 0; s < 12; s++) { bf16x8 kf = *(const bf16x8*)(kp + s * 16); S = MFMA32(kf, qf[s], S); }
    float mx = S[0];
#pragma unroll
    for (int e = 1; e < 16; e++) mx = fmaxf(mx, S[e]);
    mx = fmaxf(mx, __shfl_xor(mx, 32));
    float mn = fmaxf(m, mx);
    float alpha = exp2f(m - mn);
    float rs = 0.f;
#pragma unroll
    for (int e = 0; e < 16; e++) { S[e] = exp2f(S[e] - mn); rs += S[e]; }
    rs += __shfl_xor(rs, 32);
    lsum = lsum * alpha + rs; m = mn;
#pragma unroll
    for (int i = 0; i < 4; i++)
#pragma unroll
      for (int e = 0; e < 16; e++) O[i][e] *= alpha;
    bf16x8 pf[2];
#pragma unroll
    for (int s2 = 0; s2 < 2; s2++) {
      u32x4 u; u.x = pack_bf16(S[8 * s2], S[8 * s2 + 1]); u.y = pack_bf16(S[8 * s2 + 2], S[8 * s2 + 3]);
      u.z = pack_bf16(S[8 * s2 + 4], S[8 * s2 + 5]); u.w = pack_bf16(S[8 * s2 + 6], S[8 * s2 + 7]);
      pf[s2] = __builtin_bit_cast(bf16x8, u);
    }
    const ushort_t* vp = sV + r * VLD + kh * 32 + h * 8;
#pragma unroll
    for (int dt = 0; dt < 4; dt++)
#pragma unroll
      for (int s2 = 0; s2 < 2; s2++) {
        bf16x8 vf = *(const bf16x8*)(vp + dt * 32 * VLD + s2 * 16);
        O[dt] = MFMA32(vf, pf[s2], O[dt]);
      }
  }
  __syncthreads();
  float* cO = (float*)smem;
  float* cML = cO + 2 * 64 * 64;
  if (kh == 1) {
#pragma unroll
    for (int dt = 0; dt < 4; dt++)
#pragma unroll
      for (int e = 0; e < 16; e++) cO[(qs * 64 + dt * 16 + e) * 64 + lane] = O[dt][e];
    cML[(qs * 2 + 0) * 64 + lane] = m; cML[(qs * 2 + 1) * 64 + lane] = lsum;
  }
  __syncthreads();
  if (kh == 0) {
    float m1 = cML[(qs * 2 + 0) * 64 + lane], l1 = cML[(qs * 2 + 1) * 64 + lane];
    float mf = fmaxf(m, m1);
    float a0 = exp2f(m - mf), a1 = exp2f(m1 - mf);
    float inv = 1.f / (lsum * a0 + l1 * a1);
    a0 *= inv; a1 *= inv;
    ushort_t* op = p.attn + (size_t)(tq0 + qs * 32 + r) * 1024 + hh * 128;
#pragma unroll
    for (int dt = 0; dt < 4; dt++)
#pragma unroll
      for (int gq = 0; gq < 4; gq++) {
        float o0 = O[dt][4 * gq] * a0 + cO[(qs * 64 + dt * 16 + 4 * gq) * 64 + lane] * a1;
        float o1 = O[dt][4 * gq + 1] * a0 + cO[(qs * 64 + dt * 16 + 4 * gq + 1) * 64 + lane] * a1;
        float o2 = O[dt][4 * gq + 2] * a0 + cO[(qs * 64 + dt * 16 + 4 * gq + 2) * 64 + lane] * a1;
        float o3 = O[dt][4 * gq + 3] * a0 + cO[(qs * 64 + dt * 16 + 4 * gq + 3) * 64 + lane] * a1;
        uint2 ov; ov.x = pack_bf16(o0, o1); ov.y = pack_bf16(o2, o3); *(uint2*)(op + dt * 32 + 8 * gq + 4 * h) = ov;
      }
  }
  __syncthreads();
}

DI void merge_tokens(const Params& p, int l) {
  int tidq = opaque(threadIdx.x); int lane = tidq & 63, gw = blockIdx.x * 4 + (tidq >> 6), nw = gridDim.x * 4;
  const float* gg = p.grp_g + l * DM;
  for (int t = gw; t < NTOK; t += nw) {
    {
      const ushort_t* ar = p.attn + (size_t)t * 1024;
      float4 v[4]; float ss = 0.f;
#pragma unroll
      for (int j = 0; j < 4; j++) { uint2 u_ = *(const uint2*)(ar + j * 256 + lane * 4); v[j] = make_float4(bf_lo(u_.x), bf_hi(u_.x), bf_lo(u_.y), bf_hi(u_.y)); ss += v[j].x * v[j].x + v[j].y * v[j].y + v[j].z * v[j].z + v[j].w * v[j].w; }
      ss = wave_sum(ss);
      float rinv = rsqrtf(ss * (1.f / 1024.f) + 1e-6f);
#pragma unroll
      for (int j = 0; j < 4; j++) {
        int col = j * 256 + lane * 4; float4 g = *(const float4*)(gg + col);
        uint2 o; o.x = pack_bf16(v[j].x * rinv * g.x, v[j].y * rinv * g.y); o.y = pack_bf16(v[j].z * rinv * g.z, v[j].w * rinv * g.w);
        *(uint2*)(p.mixed + (size_t)t * DM + col) = o;
      }
    }
    {
      float val[8]; float ss = 0.f;
      int ch = t >> 8;
#pragma unroll
      for (int j = 0; j < 2; j++) {
        int col = j * 256 + lane * 4;
        float cf[4] = {0, 0, 0, 0}, cbk[4] = {0, 0, 0, 0};
        if (t >= NCTX) {
          int b = (t - NCTX) >> 10, cc = (ch - 16) & 3, chb = 16 + b * 4;
          float4 h0f = *(const float4*)(p.state_lru + ((size_t)(b * 2 + l) * 2 + 0) * 512 + col);
          float4 h0b = *(const float4*)(p.state_lru + ((size_t)(b * 2 + l) * 2 + 1) * 512 + col);
          cf[0] = h0f.x; cf[1] = h0f.y; cf[2] = h0f.z; cf[3] = h0f.w;
          cbk[0] = h0b.x; cbk[1] = h0b.y; cbk[2] = h0b.z; cbk[3] = h0b.w;
          for (int jj = 0; jj < cc; jj++) {
            float4 he = *(const float4*)(p.hend + (size_t)(0 * 32 + chb + jj) * 512 + col), pe = *(const float4*)(p.Pend + (size_t)(0 * 32 + chb + jj) * 512 + col);
            cf[0] = he.x + pe.x * cf[0]; cf[1] = he.y + pe.y * cf[1]; cf[2] = he.z + pe.z * cf[2]; cf[3] = he.w + pe.w * cf[3];
          }
          for (int jj = 3; jj > cc; jj--) {
            float4 he = *(const float4*)(p.hend + (size_t)(1 * 32 + chb + jj) * 512 + col), pe = *(const float4*)(p.Pend + (size_t)(1 * 32 + chb + jj) * 512 + col);
            cbk[0] = he.x + pe.x * cbk[0]; cbk[1] = he.y + pe.y * cbk[1]; cbk[2] = he.z + pe.z * cbk[2]; cbk[3] = he.w + pe.w * cbk[3];
          }
        }
        uint2 uhf = *(const uint2*)(p.hs + ((size_t)0 * NTOK + t) * 512 + col), upf = *(const uint2*)(p.Pc + ((size_t)0 * NTOK + t) * 512 + col);
        uint2 uhb = *(const uint2*)(p.hs + ((size_t)1 * NTOK + t) * 512 + col), upb = *(const uint2*)(p.Pc + ((size_t)1 * NTOK + t) * 512 + col);
        float4 hf_ = make_float4(bf_lo(uhf.x), bf_hi(uhf.x), bf_lo(uhf.y), bf_hi(uhf.y)), pf_ = make_float4(bf_lo(upf.x), bf_hi(upf.x), bf_lo(upf.y), bf_hi(upf.y));
        float4 hb_ = make_float4(bf_lo(uhb.x), bf_hi(uhb.x), bf_lo(uhb.y), bf_hi(uhb.y)), pb_ = make_float4(bf_lo(upb.x), bf_hi(upb.x), bf_lo(upb.y), bf_hi(upb.y));
        float4 zg = *(const float4*)(p.z + (size_t)t * INW + OFF_ZG + col);
        float y0 = hf_.x + pf_.x * cf[0] + hb_.x + pb_.x * cbk[0];
        float y1 = hf_.y + pf_.y * cf[1] + hb_.y + pb_.y * cbk[1];
        float y2 = hf_.z + pf_.z * cf[2] + hb_.z + pb_.z * cbk[2];
        float y3 = hf_.w + pf_.w * cf[3] + hb_.w + pb_.w * cbk[3];
        y0 *= gelu_tanh(zg.x); y1 *= gelu_tanh(zg.y); y2 *= gelu_tanh(zg.z); y3 *= gelu_tanh(zg.w);
        val[j * 4] = y0; val[j * 4 + 1] = y1; val[j * 4 + 2] = y2; val[j * 4 + 3] = y3;
        ss += y0 * y0 + y1 * y1 + y2 * y2 + y3 * y3;
      }
      ss = wave_sum(ss);
      float rinv = rsqrtf(ss * (1.f / 512.f) + 1e-6f);
#pragma unroll
      for (int j = 0; j < 2; j++) {
        int col = j * 256 + lane * 4; float4 g = *(const float4*)(gg + 1024 + col);
        uint2 o; o.x = pack_bf16(val[j * 4] * rinv * g.x, val[j * 4 + 1] * rinv * g.y); o.y = pack_bf16(val[j * 4 + 2] * rinv * g.z, val[j * 4 + 3] * rinv * g.w);
        *(uint2*)(p.mixed + (size_t)t * DM + 1024 + col) = o;
      }
    }
  }
}

#define TOPK_INS(TV, TI, XV, XI) { float xv_ = (XV); int xi_ = (XI); _Pragma("unroll") for (int i_ = 0; i_ < 16; i_++) { bool c_ = xv_ > TV[i_]; float nv_ = c_ ? xv_ : TV[i_]; float ov_ = c_ ? TV[i_] : xv_; int ni_ = c_ ? xi_ : TI[i_]; int oi_ = c_ ? TI[i_] : xi_; TV[i_] = nv_; TI[i_] = ni_; xv_ = ov_; xi_ = oi_; } }
DI void peer_phase(const Params& p, int l, char* smem) {
  const int tid = opaque(threadIdx.x), wave = tid >> 6, lane = tid & 63;
  float* wsm = (float*)(smem + wave * 12288);
  float* lv = wsm;
  int* lidx = (int*)(wsm + 1024);
  int* pki = (int*)(wsm + 2048);
  float* pkg = wsm + 2560;
  const float* scores = p.z;
  const unsigned char* Ub = p.Ub + (size_t)l * NEXP * DM;
  const unsigned char* Vb = p.Vb + (size_t)l * NEXP * DM;
  const float* Us = p.Us + l * NEXP;
  const float* Vs = p.Vs + l * NEXP;
  float* dst = l == 0 ? p.xA : p.out;
  for (int tb = blockIdx.x; tb < NTOK / 16; tb += gridDim.x) {
    const int tg = tb * 4 + wave;
    {
      const GAS f32x4* sp = (const GAS f32x4*)(scores + (size_t)(tg * 4 + (lane >> 4)) * 2048 + (lane & 15) * 128);
      float tv[16]; int ti[16];
#pragma unroll
      for (int i = 0; i < 16; i++) { tv[i] = -INFINITY; ti[i] = 0; }
      for (int k = 0; k < 128; k += 8) {
        float x[8];
        { f32x4 xa_ = sp[k >> 2], xb_ = sp[(k >> 2) + 1]; x[0] = xa_[0]; x[1] = xa_[1]; x[2] = xa_[2]; x[3] = xa_[3]; x[4] = xb_[0]; x[5] = xb_[1]; x[6] = xb_[2]; x[7] = xb_[3]; }
#pragma unroll
        for (int u = 0; u < 8; u++) TOPK_INS(tv, ti, x[u], k + u);
      }
#pragma unroll
      for (int i = 0; i < 16; i++) { lv[i * 64 + lane] = tv[i]; lidx[i * 64 + lane] = ti[i]; }
    }
    __syncthreads();
    if (lane < 32) {
      const int tt = lane >> 3, hh = lane & 7;
      const int la = tt * 16 + 2 * hh, lb = la + 1;
      float s1[16], s2[16];
#pragma unroll
      for (int i = 0; i < 16; i++) { s1[i] = lv[i * 64 + la]; s2[i] = lv[i * 64 + lb]; }
      float cv[16]; int cf[16];
#pragma unroll
      for (int i = 0; i < 16; i++) { cv[i] = -INFINITY; cf[i] = 0; }
#pragma unroll
      for (int i = 0; i < 16; i++) {
#pragma unroll
        for (int j = 0; j < 16; j++) {
          if ((i + 1) * (j + 1) <= 16) TOPK_INS(cv, cf, s1[i] + s2[j], i * 16 + j);
        }
      }
      float e[16]; float sum = 0.f;
#pragma unroll
      for (int r = 0; r < 16; r++) { e[r] = __expf(cv[r] - cv[0]); sum += e[r]; }
      const float inv = 1.f / sum;
#pragma unroll
      for (int r = 0; r < 16; r++) {
        int id = lidx[(cf[r] >> 4) * 64 + la] * 128 + lidx[(cf[r] & 15) * 64 + lb];
        pki[tt * 128 + hh * 16 + r] = id; pkg[tt * 128 + hh * 16 + r] = e[r] * inv;
      }
    }
    __syncthreads();
    for (int tt = 0; tt < 4; tt++) {
    const int t = tg * 4 + tt;
    const int idx0 = pki[tt * 128 + lane], idx1 = pki[tt * 128 + 64 + lane];
    const float g0 = pkg[tt * 128 + lane], g1 = pkg[tt * 128 + 64 + lane];
    float xs[32];
#pragma unroll
    for (int j = 0; j < 2; j++) {
      const uint4* xp = (const uint4*)(p.hn + (size_t)t * DM + (j * 64 + lane) * 16);
      uint4 xa = xp[0], xb = xp[1];
      xs[j * 16 + 0] = bf_lo(xa.x); xs[j * 16 + 1] = bf_hi(xa.x); xs[j * 16 + 2] = bf_lo(xa.y); xs[j * 16 + 3] = bf_hi(xa.y);
      xs[j * 16 + 4] = bf_lo(xa.z); xs[j * 16 + 5] = bf_hi(xa.z); xs[j * 16 + 6] = bf_lo(xa.w); xs[j * 16 + 7] = bf_hi(xa.w);
      xs[j * 16 + 8] = bf_lo(xb.x); xs[j * 16 + 9] = bf_hi(xb.x); xs[j * 16 + 10] = bf_lo(xb.y); xs[j * 16 + 11] = bf_hi(xb.y);
      xs[j * 16 + 12] = bf_lo(xb.z); xs[j * 16 + 13] = bf_hi(xb.z); xs[j * 16 + 14] = bf_lo(xb.w); xs[j * 16 + 15] = bf_hi(xb.w);
    }
    const float us0 = Us[idx0], us1 = Us[idx1], vs0 = Vs[idx0], vs1 = Vs[idx1];
    float a0 = 0.f, a1 = 0.f;
    {
      u32x4 ld[8][2];
#pragma unroll
      for (int rr = 0; rr < 8; rr++) {
        int idx = __builtin_amdgcn_readlane(idx0, rr);
        const unsigned char* row = Ub + (size_t)idx * DM;
#pragma unroll
        for (int j = 0; j < 2; j++) ld[rr][j] = GLD16(row + (j * 64 + lane) * 16);
      }
      for (int k0 = 0; k0 < 128; k0 += 8) {
        int nsrc = (k0 + 8 < 64) ? idx0 : idx1;
        float part[8];
#pragma unroll
        for (int rr = 0; rr < 8; rr++) {
          float s = 0.f;
#pragma unroll
          for (int j = 0; j < 2; j++)
#pragma unroll
            for (int q = 0; q < 4; q++) {
              f32x2_t lo = __builtin_amdgcn_cvt_pk_f32_fp8((int)ld[rr][j][q], false);
              f32x2_t hi = __builtin_amdgcn_cvt_pk_f32_fp8((int)ld[rr][j][q], true);
              s += lo[0] * xs[j * 16 + q * 4] + lo[1] * xs[j * 16 + q * 4 + 1] + hi[0] * xs[j * 16 + q * 4 + 2] + hi[1] * xs[j * 16 + q * 4 + 3];
            }
          part[rr] = s;
          if (k0 + 8 < 128) {
            int idx = __builtin_amdgcn_readlane(nsrc, (k0 + 8 + rr) & 63);
            const unsigned char* row = Ub + (size_t)idx * DM;
#pragma unroll
            for (int j = 0; j < 2; j++) ld[rr][j] = GLD16(row + (j * 64 + lane) * 16);
          }
        }
#pragma unroll
        for (int o = 32; o; o >>= 1) {
#pragma unroll
          for (int rr = 0; rr < 8; rr++) part[rr] += __shfl_xor(part[rr], o);
        }
#pragma unroll
        for (int rr = 0; rr < 8; rr++) {
          if (lane == ((k0 + rr) & 63)) { if (k0 < 64) a0 = part[rr]; else a1 = part[rr]; }
        }
      }
    }
    float w0 = g0 * gelu_tanh(a0 * us0) * vs0, w1 = g1 * gelu_tanh(a1 * us1) * vs1;
    float acc[32];
#pragma unroll
    for (int e = 0; e < 32; e++) acc[e] = 0.f;
    {
      u32x4 ld[8][2];
#pragma unroll
      for (int rr = 0; rr < 8; rr++) {
        int idx = __builtin_amdgcn_readlane(idx0, rr);
        const unsigned char* row = Vb + (size_t)idx * DM;
#pragma unroll
        for (int j = 0; j < 2; j++) ld[rr][j] = GLD16(row + (j * 64 + lane) * 16);
      }
      for (int k0 = 0; k0 < 128; k0 += 8) {
        float wsrc = (k0 < 64) ? w0 : w1;
        int nsrc = (k0 + 8 < 64) ? idx0 : idx1;
#pragma unroll
        for (int rr = 0; rr < 8; rr++) {
          float w = rdlane_f(wsrc, (k0 + rr) & 63);
#pragma unroll
          for (int j = 0; j < 2; j++)
#pragma unroll
            for (int q = 0; q < 4; q++) {
              f32x2_t lo = __builtin_amdgcn_cvt_pk_f32_fp8((int)ld[rr][j][q], false);
              f32x2_t hi = __builtin_amdgcn_cvt_pk_f32_fp8((int)ld[rr][j][q], true);
              acc[j * 16 + q * 4 + 0] += w * lo[0]; acc[j * 16 + q * 4 + 1] += w * lo[1];
              acc[j * 16 + q * 4 + 2] += w * hi[0]; acc[j * 16 + q * 4 + 3] += w * hi[1];
            }
          if (k0 + 8 < 128) {
            int idx = __builtin_amdgcn_readlane(nsrc, (k0 + 8 + rr) & 63);
            const unsigned char* row = Vb + (size_t)idx * DM;
#pragma unroll
            for (int j = 0; j < 2; j++) ld[rr][j] = GLD16(row + (j * 64 + lane) * 16);
          }
        }
      }
    }
    const float* md = p.mod + (size_t)(l * 5 + cvidx(t)) * 12288 + 10240;
    float ssq = 0.f;
#pragma unroll
    for (int j = 0; j < 2; j++)
#pragma unroll
      for (int q = 0; q < 4; q++) {
        int col = (j * 64 + lane) * 16 + q * 4;
        float4 xa = *(const float4*)(p.x1 + (size_t)t * DM + col);
        float4 ga = *(const float4*)(md + col);
        float4 oa = make_float4(xa.x + ga.x * acc[j * 16 + q * 4], xa.y + ga.y * acc[j * 16 + q * 4 + 1], xa.z + ga.z * acc[j * 16 + q * 4 + 2], xa.w + ga.w * acc[j * 16 + q * 4 + 3]);
        *(float4*)(dst + (size_t)t * DM + col) = oa;
        acc[j * 16 + q * 4] = oa.x; acc[j * 16 + q * 4 + 1] = oa.y; acc[j * 16 + q * 4 + 2] = oa.z; acc[j * 16 + q * 4 + 3] = oa.w;
        ssq += oa.x * oa.x + oa.y * oa.y + oa.z * oa.z + oa.w * oa.w;
      }
    if (l == 0) {
      ssq = wave_sum(ssq);
      const float rinv = rsqrtf(ssq * (1.f / DM) + 1e-6f);
      const float* g = p.norm_mix_g + DM;
      const float* md1 = p.mod + (size_t)(5 + cvidx(t)) * 12288;
#pragma unroll
      for (int j = 0; j < 2; j++)
#pragma unroll
        for (int q = 0; q < 4; q++) {
          int col = (j * 64 + lane) * 16 + q * 4;
          float4 gg = *(const float4*)(g + col), sc = *(const float4*)(md1 + 2048 + col), sh = *(const float4*)(md1 + col);
          float y0 = acc[j * 16 + q * 4] * rinv * gg.x * (1.f + sc.x) + sh.x;
          float y1 = acc[j * 16 + q * 4 + 1] * rinv * gg.y * (1.f + sc.y) + sh.y;
          float y2 = acc[j * 16 + q * 4 + 2] * rinv * gg.z * (1.f + sc.z) + sh.z;
          float y3 = acc[j * 16 + q * 4 + 3] * rinv * gg.w * (1.f + sc.w) + sh.w;
          uint2 o; o.x = pack_bf16(y0, y1); o.y = pack_bf16(y2, y3);
          *(uint2*)(p.hn + (size_t)t * DM + col) = o;
        }
    }
    }
    __syncthreads();
  }
}

DI void gsync(unsigned* bar, unsigned& gen) {
  asm volatile("s_waitcnt vmcnt(0) lgkmcnt(0)" ::: "memory");
  __syncthreads();
  if (threadIdx.x == 0) {
    __builtin_amdgcn_fence(__ATOMIC_RELEASE, "agent");
    asm volatile("s_waitcnt vmcnt(0)" ::: "memory");
    gen++;
    const unsigned target = gen * gridDim.x;
    __hip_atomic_fetch_add(bar, 1u, __ATOMIC_RELAXED, __HIP_MEMORY_SCOPE_AGENT);
    while (__hip_atomic_load(bar, __ATOMIC_RELAXED, __HIP_MEMORY_SCOPE_AGENT) < target) __builtin_amdgcn_s_sleep(4);
    __builtin_amdgcn_fence(__ATOMIC_ACQUIRE, "agent");
    asm volatile("s_waitcnt vmcnt(0)" ::: "memory");
  }
  __syncthreads();
}

DI void dump_bf16(const Params& p, const ushort_t* src) {
  size_t n = (size_t)NTOK * DM; size_t tot = n + 16 * 2 * 256 * 256 + 16 * 2 * 256 * 64 + 16 * 2 * 2 * 512;
  for (size_t i = (size_t)blockIdx.x * 256 + threadIdx.x; i < tot; i += (size_t)gridDim.x * 256)
    p.out[i] = i < n ? __uint_as_float(((unsigned)src[i]) << 16) : (i < n + 2 * 5 * 12288 ? p.mod[i - n] : 0.f);
}


DI void dump_f32(const Params& p, const float* src, size_t n) {
  size_t tot = (size_t)NTOK * DM + 16 * 2 * 256 * 256 + 16 * 2 * 256 * 64 + 16 * 2 * 2 * 512;
  for (size_t i = (size_t)blockIdx.x * 256 + threadIdx.x; i < tot; i += (size_t)gridDim.x * 256)
    p.out[i] = i < n ? src[i] : 0.f;
}

__global__ void __launch_bounds__(256, 2) fwd_megakernel(Params pk) {
  __shared__ __attribute__((aligned(16))) char smem[SMEM_BYTES];
  __shared__ __attribute__((aligned(16))) unsigned long long spw[(sizeof(Params) + 7) / 8];
  {
    const unsigned long long* ka = (const unsigned long long*)__builtin_amdgcn_kernarg_segment_ptr();
    if (threadIdx.x < (sizeof(Params) + 7) / 8) spw[threadIdx.x] = ka[threadIdx.x];
    __syncthreads();
  }
#define PP (*(const Params*)((const char*)spw + opaque(0)))
  unsigned gen = 0; unsigned* bar = PP.bar;
  const int nb = gridDim.x, bid = blockIdx.x;
  const int wave = threadIdx.x >> 6, lane = threadIdx.x & 63;

  for (int rep = 0; rep < REP_A; rep++) {
  { const Params& p = PP; prep_phase(p, smem); }
  gsync(bar, gen);
  }

  for (int l = 0; l < 2; l++) {
    for (int rep = 0; rep < REP_D; rep++) {
    if (l == 0) { { const Params& p = PP; norm_phase(p, l, 0); } gsync(bar, gen); }
    }
    for (int rep = 0; rep < REP_B; rep++) {
    {
      const Params& p = PP;
      const ushort_t* Bt = p.WinT + (size_t)l * INW * DM;
      float* z = p.z;
      for (int j = bid >> 3; j < 192; j += nb >> 3) {
        int mt = (bid & 7) * 8 + ((j & 63) >> 3), nt = (j >> 6) * 8 + (j & 7);
        if (nt >= 23) continue;
        gemm_tile(p.hn, DM, Bt, DM, DM, INW, mt * 128, nt * 128, smem, [&](int row, int col, float v) { z[(size_t)row * INW + col] = v; });
      }
    }
    gsync(bar, gen);
    }
    for (int rep = 0; rep < REP_D; rep++) {
    {
      const Params& p = PP;
      for (int it = bid; it < 512 + NTOK / CMT; it += nb) {
        if (it < 512) lru_item(p, l, it, smem); else cm_item(p, l, it - 512, smem);
      }
    }
    { const Params& p = PP; post_inproj_tokens(p, l); }
    gsync(bar, gen);
    }
    for (int rep = 0; rep < REP_B; rep++) {
    {
      const Params& p = PP;
      const ushort_t* Bq = p.WqbT + (size_t)l * 1536 * 512;
      const ushort_t* Bkv = p.WkvbT + (size_t)l * 2048 * 256;
      ushort_t* qraw = p.qraw; ushort_t* kvraw = p.kvraw;
      for (int j = bid >> 3; j < 256; j += nb >> 3) {
        if (j < 160) {
          int rem = j % 80; int mt = (bid & 7) * 10 + (rem >> 3), nt = (j / 80) * 8 + (rem & 7);
          gemm_tile(p.ckv, 256, Bkv, 256, 256, 2048, mt * 128, nt * 128, smem, [&](int row, int col, float v) { kvraw[(size_t)row * 2048 + col] = f2bf(v); });
        } else {
          int j2 = j - 160; int rem = j2 % 48; int mt = (bid & 7) * 8 + rem / 6, nt = (j2 / 48) * 6 + rem % 6;
          gemm_tile(p.qa, 512, Bq, 512, 512, 1536, mt * 128, nt * 128, smem, [&](int row, int col, float v) { qraw[(size_t)row * 1536 + col] = f2bf(v); });
        }
      }
    }
    gsync(bar, gen);
    }
    for (int rep = 0; rep < REP_D; rep++) {
    { const Params& p = PP; for (int it = bid; it < 160 * 8; it += nb) kv_item(p, l, it, smem); }
    { const Params& p = PP; qnorm_tokens(p, l); }
    gsync(bar, gen);
    }
    for (int rep = 0; rep < REP_D; rep++) {
    { const Params& p = PP; for (int it = bid; it < 1024; it += nb) attn_item(p, it, smem); }
    gsync(bar, gen);
    }
    for (int rep = 0; rep < REP_D; rep++) {
    { const Params& p = PP; merge_tokens(p, l); }
    gsync(bar, gen);
    }
    for (int rep = 0; rep < REP_B; rep++) {
    {
      const Params& p = PP;
      const ushort_t* Bt = p.WoutT + (size_t)l * DM * DM;
      float* x1 = p.x1;
      for (int j = bid >> 3; j < 128; j += nb >> 3) {
        int mt = (bid & 7) * 8 + ((j & 63) >> 3), nt = (j >> 6) * 8 + (j & 7);
        gemm_tile(p.mixed, DM, Bt, DM, DM, DM, mt * 128, nt * 128, smem, [&](int row, int col, float v) {
          const float* xr = xrow_in(p, l, row);
          float g1 = p.mod[(size_t)(l * 5 + cvidx(row)) * 12288 + 4096 + col];
          x1[(size_t)row * DM + col] = xr[col] + g1 * v;
        });
      }
    }
    gsync(bar, gen);
    }
    for (int rep = 0; rep < REP_D; rep++) {
    { const Params& p = PP; norm_phase(p, l, 1); }
    gsync(bar, gen);
    }
    for (int rep = 0; rep < REP_B; rep++) {
    {
      const Params& p = PP;
      const ushort_t* Bt = p.WpqT + (size_t)l * DM * DM;
      ushort_t* pq = p.mixed;
      for (int j = bid >> 3; j < 128; j += nb >> 3) {
        int mt = (bid & 7) * 8 + ((j & 63) >> 3), nt = (j >> 6) * 8 + (j & 7);
        gemm_tile(p.hn, DM, Bt, DM, DM, DM, mt * 128, nt * 128, smem, [&](int row, int col, float v) { pq[(size_t)row * DM + col] = f2bf(v); });
      }
    }
    gsync(bar, gen);
    }
    for (int rep = 0; rep < REP_B; rep++) {
    {
      const Params& p = PP;
      const ushort_t* Kb = p.KeysB + (size_t)l * 2048 * 128;
      float* sc = p.z;
      for (int j = bid >> 3; j < 128; j += nb >> 3) {
        int mt = (bid & 7) * 8 + ((j & 63) >> 3), nt = (j >> 6) * 8 + (j & 7);
        gemm_tile(p.mixed + nt * 128, DM, Kb + (size_t)nt * 128 * 128, 128, 128, 128, mt * 128, 0, smem, [&](int row, int col, float v) { sc[(size_t)row * 2048 + nt * 128 + col] = v; });
      }
    }
    gsync(bar, gen);
    }
    for (int rep = 0; rep < REP_C; rep++) {
    { const Params& p = PP; peer_phase(p, l, smem); }
    gsync(bar, gen);
    }
  }
}

extern "C" void kernel_launch(void* const* d_in, const int* in_sizes, int n_in, void* d_out, int out_size, void* d_ws, size_t ws_size, hipStream_t stream) {
  static int grid_blocks = 0;
  if (!grid_blocks) {
    int dev = 0, cus = 0, per_cu = 0;
    hipGetDevice(&dev);
    hipDeviceGetAttribute(&cus, hipDeviceAttributeMultiprocessorCount, dev);
    hipOccupancyMaxActiveBlocksPerMultiprocessor(&per_cu, fwd_megakernel, 256, 0);
    if (per_cu > 2) per_cu = 2;
    if (per_cu < 1) per_cu = 1;
    grid_blocks = cus * per_cu;
  }
  Params p{};
  const float** pin = (const float**)&p;
  for (int i = 0; i < 35; i++) pin[i] = (const float*)d_in[i];
  p.out = (float*)d_out;
  char* w = (char*)d_ws; size_t off = 0;
  auto take = [&](size_t bytes) { char* r = w + off; off += (bytes + 255) & ~(size_t)255; return r; };
  p.bar = (unsigned*)take(256);
  p.WinT = (ushort_t*)take((size_t)2 * INW * DM * 2);
  p.WqbT = (ushort_t*)take((size_t)2 * 1536 * 512 * 2);
  p.WkvbT = (ushort_t*)take((size_t)2 * 2048 * 256 * 2);
  p.WoutT = (ushort_t*)take((size_t)2 * DM * DM * 2);
  p.WpqT = (ushort_t*)take((size_t)2 * DM * DM * 2);
  p.KeysB = (ushort_t*)take((size_t)2 * 2048 * 128 * 2);
  p.LruW = (ushort_t*)take((size_t)2 * 16 * 2 * 4096 * 2);
  p.Ub = (unsigned char*)take((size_t)2 * NEXP * DM);
  p.Vb = (unsigned char*)take((size_t)2 * NEXP * DM);
  p.Us = (float*)take((size_t)2 * NEXP * 4);
  p.Vs = (float*)take((size_t)2 * NEXP * 4);
  p.hn = (ushort_t*)take((size_t)NTOK * DM * 2);
  p.qa = (ushort_t*)take((size_t)NTOK * 512 * 2);
  p.ckv = (ushort_t*)take((size_t)NKV * 256 * 2);
  p.Q = (ushort_t*)take((size_t)NTOK * 1536 * 2);
  p.K = (ushort_t*)take((size_t)NKV * 1536 * 2);
  p.Vt = (ushort_t*)take((size_t)NKV * 1024 * 2);
  p.mixed = (ushort_t*)take((size_t)NTOK * DM * 2);
  p.z = (float*)take((size_t)NTOK * INW * 4);
  p.qraw = (ushort_t*)take((size_t)NTOK * 1536 * 2);
  p.kvraw = (ushort_t*)take((size_t)NKV * 2048 * 2);
  p.attn = (ushort_t*)take((size_t)NTOK * 1024 * 2);
  p.hs = (ushort_t*)take((size_t)2 * NTOK * 512 * 2);
  p.Pc = (ushort_t*)take((size_t)2 * NTOK * 512 * 2);
  p.hend = (float*)take((size_t)2 * 32 * 512 * 4);
  p.Pend = (float*)take((size_t)2 * 32 * 512 * 4);
  p.x1 = (float*)take((size_t)NTOK * DM * 4);
  p.xA = (float*)take((size_t)NTOK * DM * 4);
  p.mod = (float*)take((size_t)2 * 5 * 12288 * 4);
  p.rope = (float*)take((size_t)1024 * 64 * 4);
  if (off > ws_size) { fprintf(stderr, "workspace too small: need %zu have %zu\n", off, ws_size); return; }
  if (hipMemsetAsync(p.bar, 0, 256, stream) != hipSuccess) { fprintf(stderr, "memset failed\n"); return; }
  hipLaunchKernelGGL(fwd_megakernel, dim3(grid_blocks), dim3(256), 0, stream, p);
}
```

```cpp
#include <hip/hip_runtime.h>
#include <hip/hip_cooperative_groups.h>
#include <cstdio>
#include <cstdint>
namespace cg = cooperative_groups;

typedef unsigned short ushort_t;
typedef __attribute__((ext_vector_type(8))) short bf16x8;
typedef __attribute__((ext_vector_type(16))) float f32x16;
typedef __attribute__((ext_vector_type(4))) unsigned u32x4;
typedef __attribute__((ext_vector_type(4))) float f32x4;
typedef __attribute__((ext_vector_type(2))) float f32x2_t;
typedef __attribute__((ext_vector_type(2))) __bf16 bf16x2_t;
#define DI __device__ __forceinline__
#define GAS __attribute__((address_space(1)))
#define GLD16(ptr) (*(const GAS u32x4*)(ptr))
#define MFMA32(a, b, c) __builtin_amdgcn_mfma_f32_32x32x16_bf16((a), (b), (c), 0, 0, 0)

#define DM 2048
#define NTOK 8192
#define NCTX 4096
#define INW 2880
#define NKV 10240
#define OFF_ZKV 512
#define OFF_ZKR 768
#define OFF_ZX 832
#define OFF_ZG 1344
#define OFF_ZC 1856
#define NEXP 16384
#define SMEM_BYTES 78848
#ifndef REP_A
#define REP_A 1
#define REP_B 1
#define REP_C 1
#define REP_D 1
#endif

struct Params {
  const float *x_prompt, *x_sample, *cache_ckv, *cache_krope, *state_lru, *c, *c_ctx;
  const float *ada_w, *ada_b, *norm_mix_g, *w_in, *mla_qa_g, *mla_w_qb, *mla_q_g, *mla_kva_g, *mla_w_kvb, *mla_k_g;
  const float *lru_conv_w, *lru_conv_b, *lru_w_a, *lru_b_a, *lru_w_i, *lru_b_i, *lru_lam;
  const float *cm_dw_w, *cm_dw_b, *cm_ln_g, *cm_ln_b, *grp_g, *w_out, *norm_ffn_g;
  const float *peer_w_q, *peer_keys, *peer_u, *peer_v;
  float* out;
  unsigned* bar;
  ushort_t *WinT, *WqbT, *WkvbT, *WoutT, *WpqT, *KeysB, *LruW;
  unsigned char *Ub, *Vb;
  float *Us, *Vs;
  ushort_t *hn, *qa, *ckv, *Q, *K, *Vt, *mixed;
  ushort_t *qraw, *kvraw, *attn, *hs, *Pc;
  float *z, *hend, *Pend, *x1, *xA, *mod, *rope;
};

DI unsigned pack_bf16(float lo, float hi) { f32x2_t v = {lo, hi}; bf16x2_t b = __builtin_convertvector(v, bf16x2_t); return __builtin_bit_cast(unsigned, b); }
DI ushort_t f2bf(float x) { return (ushort_t)(pack_bf16(x, 0.f) & 0xffffu); }
DI float bf_lo(unsigned u) { return __uint_as_float(u << 16); }
DI float bf_hi(unsigned u) { return __uint_as_float(u & 0xffff0000u); }
DI float wave_sum(float v) { for (int o = 32; o; o >>= 1) v += __shfl_xor(v, o); return v; }
DI float sigmoidf_(float x) { return 1.f / (1.f + __expf(-x)); }
DI float gelu_tanh(float x) { return 0.5f * x * (1.f + tanhf(0.7978845608028654f * (x + 0.044715f * x * x * x))); }
DI int crow(int reg, int h) { return (reg & 3) + 8 * (reg >> 2) + 4 * h; }
DI int cvidx(int t) { return t < NCTX ? 0 : 1 + ((t - NCTX) >> 10); }
DI int kvrow_of_token(int t) { if (t < NCTX) return t; int tl = t - NCTX; return NCTX + (tl >> 10) * 1536 + 512 + (tl & 1023); }
DI const float* xrow_in(const Params& p, int l, int t) {
  if (l == 0) return t < NCTX ? p.x_prompt + (size_t)t * DM : p.x_sample + (size_t)(t - NCTX) * DM;
  return p.xA + (size_t)t * DM;
}
DI float dot2bf(unsigned a, unsigned b, float acc) { return __builtin_amdgcn_fdot2_f32_bf16(__builtin_bit_cast(bf16x2_t, a), __builtin_bit_cast(bf16x2_t, b), acc, false); }
DI int opaque(int x) { asm volatile("" : "+v"(x)); return x; }
DI float rdlane_f(float v, int l) { return __int_as_float(__builtin_amdgcn_readlane(__float_as_int(v), l)); }

#define GLD 72
template <class Epi>
DI void gemm_tile(const ushort_t* A, int lda, const ushort_t* Bt, int ldb, int K, int N, int m0, int n0, char* smem, Epi epi) {
  ushort_t* sA = (ushort_t*)smem;
  ushort_t* sB = sA + 128 * GLD;
  const int tid = opaque(threadIdx.x), wave = tid >> 6, lane = tid & 63, wm = wave & 1, wn = wave >> 1;
  const int r = lane & 31, h = lane >> 5;
  f32x16 acc[2][2];
#pragma unroll
  for (int i = 0; i < 2; i++)
#pragma unroll
    for (int j = 0; j < 2; j++)
#pragma unroll
      for (int e = 0; e < 16; e++) acc[i][j][e] = 0.f;
  u32x4 ra0[4], rb0[4], ra1[4], rb1[4];
  const int lrow = tid >> 3, lkc = (tid & 7) * 8;
  const ushort_t* Ap = A + (size_t)(m0 + lrow) * lda + lkc;
  const ushort_t* Bp[4];
#pragma unroll
  for (int i = 0; i < 4; i++) { int br = n0 + lrow + 32 * i; br = br < N ? br : N - 1; Bp[i] = Bt + (size_t)br * ldb + lkc; }
  auto gload = [&](u32x4* ra, u32x4* rb, int k0) {
#pragma unroll
    for (int i = 0; i < 4; i++) {
      ra[i] = GLD16(Ap + (size_t)(32 * i) * lda + k0);
      rb[i] = GLD16(Bp[i] + k0);
    }
  };
  auto lstore = [&](const u32x4* ra, const u32x4* rb, int buf) {
    ushort_t* dA = sA + buf * (2 * 128 * GLD) + lrow * GLD + lkc;
    ushort_t* dB = sB + buf * (2 * 128 * GLD) + lrow * GLD + lkc;
#pragma unroll
    for (int i = 0; i < 4; i++) { *(u32x4*)(dA + 32 * i * GLD) = ra[i]; *(u32x4*)(dB + 32 * i * GLD) = rb[i]; }
  };
  auto compute = [&](int buf) {
    const ushort_t* cA = sA + buf * (2 * 128 * GLD);
    const ushort_t* cB = sB + buf * (2 * 128 * GLD);
    bf16x8 a[2][2], b[2][2];
#pragma unroll
    for (int i = 0; i < 2; i++) {
      a[0][i] = *(const bf16x8*)(cA + (wm * 64 + i * 32 + r) * GLD + h * 8);
      b[0][i] = *(const bf16x8*)(cB + (wn * 64 + i * 32 + r) * GLD + h * 8);
    }
#pragma unroll
    for (int ks = 0; ks < 4; ks++) {
      if (ks < 3) {
#pragma unroll
        for (int i = 0; i < 2; i++) {
          a[(ks + 1) & 1][i] = *(const bf16x8*)(cA + (wm * 64 + i * 32 + r) * GLD + (ks + 1) * 16 + h * 8);
          b[(ks + 1) & 1][i] = *(const bf16x8*)(cB + (wn * 64 + i * 32 + r) * GLD + (ks + 1) * 16 + h * 8);
        }
      }
#pragma unroll
      for (int i = 0; i < 2; i++)
#pragma unroll
        for (int j = 0; j < 2; j++) acc[i][j] = MFMA32(a[ks & 1][i], b[ks & 1][j], acc[i][j]);
    }
  };
  gload(ra0, rb0, 0);
  gload(ra1, rb1, 64);
  lstore(ra0, rb0, 0);
  __syncthreads();
  const int klast = K - 64;
  gload(ra0, rb0, 128 < K ? 128 : klast);
  for (int k0 = 0; k0 < K; k0 += 128) {
    compute(0);
    lstore(ra1, rb1, 1);
    __syncthreads();
    gload(ra1, rb1, k0 + 192 < K ? k0 + 192 : klast);
    compute(1);
    lstore(ra0, rb0, 0);
    __syncthreads();
    gload(ra0, rb0, k0 + 256 < K ? k0 + 256 : klast);
  }
#pragma unroll
  for (int i = 0; i < 2; i++)
#pragma unroll
    for (int j = 0; j < 2; j++)
#pragma unroll
      for (int e = 0; e < 16; e++) {
        int row = m0 + wm * 64 + i * 32 + crow(e, h);
        int col = n0 + wn * 64 + j * 32 + r;
        if (col < N) epi(row, col, acc[i][j][e]);
      }
  __syncthreads();
}

DI void transpose_item(const float* src, int lds_, ushort_t* dst, int ldd, int kt, int nt, float* tile) {
  int tid = opaque(threadIdx.x); int c = tid & 63, r0 = tid >> 6;
#pragma unroll 4
  for (int i = 0; i < 16; i++) { int r = r0 + 4 * i; tile[r * 65 + c] = src[(size_t)(kt * 64 + r) * lds_ + nt * 64 + c]; }
  __syncthreads();
#pragma unroll 4
  for (int i = 0; i < 16; i++) { int r = r0 + 4 * i; dst[(size_t)(nt * 64 + r) * ldd + kt * 64 + c] = f2bf(tile[c * 65 + r]); }
  __syncthreads();
}

DI void convert_chunk(const float* src, ushort_t* dst, size_t base) {
  int tid = opaque(threadIdx.x);
#pragma unroll
  for (int it = 0; it < 4; it++) {
    size_t e = base + it * 2048 + tid * 8;
    float4 a = *(const float4*)(src + e), b = *(const float4*)(src + e + 4);
    uint4 o; o.x = pack_bf16(a.x, a.y); o.y = pack_bf16(a.z, a.w); o.z = pack_bf16(b.x, b.y); o.w = pack_bf16(b.z, b.w);
    *(uint4*)(dst + e) = o;
  }
}


DI void quant_rows(const float* src, unsigned char* dst, float* scl, size_t row0) {
  int tid = opaque(threadIdx.x); int wave = tid >> 6, lane = tid & 63;
  size_t row = row0 + wave;
  const float* r = src + row * DM;
  float4 v[8]; float am = 0.f;
#pragma unroll
  for (int j = 0; j < 8; j++) { v[j] = *(const float4*)(r + (j * 64 + lane) * 4); am = fmaxf(am, fmaxf(fmaxf(fabsf(v[j].x), fabsf(v[j].y)), fmaxf(fabsf(v[j].z), fabsf(v[j].w)))); }
  for (int o = 32; o; o >>= 1) am = fmaxf(am, __shfl_xor(am, o));
  float sc = am > 0.f ? 224.f / am : 1.f;
  if (lane == 0) scl[row] = am > 0.f ? am * (1.f / 224.f) : 1.f;
#pragma unroll
  for (int j = 0; j < 8; j++) {
    int w = 0;
    w = __builtin_amdgcn_cvt_pk_fp8_f32(v[j].x * sc, v[j].y * sc, w, false);
    w = __builtin_amdgcn_cvt_pk_fp8_f32(v[j].z * sc, v[j].w * sc, w, true);
    *(int*)(dst + row * DM + (j * 64 + lane) * 4) = w;
  }
}

DI void mod_item(const Params& p, int item, char* smem) {
  int l = item / 48, cgp = item % 48;
  float* s = (float*)smem;
  float* red = s + 5 * 2048;
  int tid = opaque(threadIdx.x), wave = tid >> 6, lane = tid & 63;
  for (int i = tid; i < 5 * 2048; i += 256) {
    int cv = i >> 11, k = i & 2047;
    float v = cv == 0 ? p.c_ctx[k] : p.c[(cv - 1) * DM + k];
    s[i] = v * sigmoidf_(v);
  }
  __syncthreads();
  const float* W = p.ada_w + (size_t)l * DM * 12288 + cgp * 256 + lane * 4;
  float4 acc[5];
#pragma unroll
  for (int cv = 0; cv < 5; cv++) acc[cv] = make_float4(0, 0, 0, 0);
  int kb = wave * 512;
#pragma unroll 8
  for (int k = kb; k < kb + 512; k++) {
    float4 w = *(const float4*)(W + (size_t)k * 12288);
#pragma unroll
    for (int cv = 0; cv < 5; cv++) {
      float sv = s[cv * 2048 + k];
      acc[cv].x += sv * w.x; acc[cv].y += sv * w.y; acc[cv].z += sv * w.z; acc[cv].w += sv * w.w;
    }
  }
#pragma unroll
  for (int cv = 0; cv < 5; cv++) *(float4*)(red + (wave * 5 + cv) * 256 + lane * 4) = acc[cv];
  __syncthreads();
  for (int i = tid; i < 5 * 256; i += 256) {
    int cv = i >> 8, col = i & 255;
    float v = red[(0 * 5 + cv) * 256 + col] + red[(1 * 5 + cv) * 256 + col] + red[(2 * 5 + cv) * 256 + col] + red[(3 * 5 + cv) * 256 + col];
    int gc = cgp * 256 + col;
    p.mod[(size_t)(l * 5 + cv) * 12288 + gc] = v + p.ada_b[l * 12288 + gc];
  }
  __syncthreads();
}

#define N_MOD 96
#define N_TR_LAYER 3840
#define N_TR (2 * N_TR_LAYER)
#define N_CV_KEYS 64
#define N_CV_U 8192
#define N_PREP (N_MOD + N_TR + N_CV_KEYS + 2 * N_CV_U + 1)

DI void prep_phase(const Params& p, char* smem) {
  for (int it = blockIdx.x; it < N_PREP; it += gridDim.x) {
    if (it < N_MOD) { mod_item(p, it, smem); continue; }
    int i = it - N_MOD;
    if (i < N_TR) {
      int l = i / N_TR_LAYER, j = i % N_TR_LAYER;
      float* tile = (float*)smem;
      if (j < 1440) { transpose_item(p.w_in + (size_t)l * DM * INW, INW, p.WinT + (size_t)l * INW * DM, DM, j / 45, j % 45, tile); continue; }
      j -= 1440;
      if (j < 192) { transpose_item(p.mla_w_qb + (size_t)l * 512 * 1536, 1536, p.WqbT + (size_t)l * 1536 * 512, 512, j / 24, j % 24, tile); continue; }
      j -= 192;
      if (j < 128) { transpose_item(p.mla_w_kvb + (size_t)l * 256 * 2048, 2048, p.WkvbT + (size_t)l * 2048 * 256, 256, j / 32, j % 32, tile); continue; }
      j -= 128;
      if (j < 1024) { transpose_item(p.w_out + (size_t)l * DM * DM, DM, p.WoutT + (size_t)l * DM * DM, DM, j / 32, j % 32, tile); continue; }
      j -= 1024;
      if (j < 1024) { transpose_item(p.peer_w_q + (size_t)l * DM * DM, DM, p.WpqT + (size_t)l * DM * DM, DM, j / 32, j % 32, tile); continue; }
      j -= 1024;
      {
        int mat = j >> 4, dh = j & 15;
        const float* src = (mat ? p.lru_w_i : p.lru_w_a) + (size_t)(l * 16 + dh) * 4096;
        ushort_t* dst = p.LruW + ((size_t)(l * 16 + dh) * 2 + mat) * 4096;
        transpose_item(src, 64, dst, 64, 0, 0, tile);
      }
      continue;
    }
    i -= N_TR;
    if (i < N_CV_KEYS) { convert_chunk(p.peer_keys, p.KeysB, (size_t)i * 8192); continue; }
    i -= N_CV_KEYS;
    if (i < N_CV_U) { quant_rows(p.peer_u, p.Ub, p.Us, (size_t)i * 4); continue; }
    i -= N_CV_U;
    if (i < N_CV_U) { quant_rows(p.peer_v, p.Vb, p.Vs, (size_t)i * 4); continue; }
    for (int e = threadIdx.x; e < 1024 * 32; e += 256) {
      int pos = e >> 5, f = e & 31;
      int fi = f & 15;
      float inv = 1.0f / powf(10000.0f, (float)fi / 16.0f);
      float base = (f < 16) ? (float)(pos >> 6) : (float)(pos & 63);
      float ang = base * inv;
      float sn, cs; sincosf(ang, &sn, &cs);
      p.rope[pos * 64 + f] = cs; p.rope[pos * 64 + 32 + f] = sn;
    }
  }
}

DI void norm_phase(const Params& p, int l, int which) {
  int tidq = opaque(threadIdx.x); int lane = tidq & 63, gw = blockIdx.x * 4 + (tidq >> 6), nw = gridDim.x * 4;
  const float* g = (which ? p.norm_ffn_g : p.norm_mix_g) + l * DM;
  int sh_off = which ? 6144 : 0, sc_off = which ? 8192 : 2048;
  for (int t = gw; t < NTOK; t += nw) {
    const float* xr = which ? p.x1 + (size_t)t * DM : xrow_in(p, l, t);
    const float* md = p.mod + (size_t)(l * 5 + cvidx(t)) * 12288;
    float4 v[8]; float ss = 0.f;
#pragma unroll
    for (int j = 0; j < 8; j++) { v[j] = *(const float4*)(xr + j * 256 + lane * 4); ss += v[j].x * v[j].x + v[j].y * v[j].y + v[j].z * v[j].z + v[j].w * v[j].w; }
    ss = wave_sum(ss);
    float rinv = rsqrtf(ss * (1.f / DM) + 1e-6f);
#pragma unroll
    for (int j = 0; j < 8; j++) {
      int col = j * 256 + lane * 4;
      float4 gg = *(const float4*)(g + col), sc = *(const float4*)(md + sc_off + col), sh = *(const float4*)(md + sh_off + col);
      float y0 = v[j].x * rinv * gg.x * (1.f + sc.x) + sh.x;
      float y1 = v[j].y * rinv * gg.y * (1.f + sc.y) + sh.y;
      float y2 = v[j].z * rinv * gg.z * (1.f + sc.z) + sh.z;
      float y3 = v[j].w * rinv * gg.w * (1.f + sc.w) + sh.w;
      uint2 o; o.x = pack_bf16(y0, y1); o.y = pack_bf16(y2, y3);
      *(uint2*)(p.hn + (size_t)t * DM + col) = o;
    }
  }
}

DI void lru_item(const Params& p, int l, int item, char* smem) {
  int ch = item >> 4, hd = (item >> 1) & 7, d = item & 1;
  int t0 = ch * 256, seq_t0, T, p0;
  if (ch < 16) { seq_t0 = ch * 256; T = 256; p0 = 0; }
  else { int b = (ch - 16) >> 2, cc = (ch - 16) & 3; seq_t0 = NCTX + b * 1024; T = 1024; p0 = cc * 256; }
  ushort_t* sBt = (ushort_t*)smem;
  ushort_t* sA = sBt + 128 * GLD;
  float* sXc = (float*)(sA + 64 * GLD);
  float* sG = sXc + 64 * 64;
  const int tid = opaque(threadIdx.x), wave = tid >> 6, lane = tid & 63;
  const int c = tid & 63, tg = tid >> 6;
  const ushort_t* Bt = p.LruW + ((size_t)((l * 2 + d) * 8 + hd) * 2) * 4096;
#pragma unroll
  for (int i = 0; i < 4; i++) { int cidx = tid + i * 256; int row = cidx >> 3, kc = (cidx & 7) * 8; *(uint4*)(sBt + row * GLD + kc) = *(const uint4*)(Bt + row * 64 + kc); }
  const int chn = hd * 64 + c;
  float cw[4];
#pragma unroll
  for (int j = 0; j < 4; j++) cw[j] = p.lru_conv_w[(l * 4 + j) * 512 + chn];
  const float cb = p.lru_conv_b[l * 512 + chn];
  const float ba = p.lru_b_a[(l * 2 + d) * 512 + chn], bi = p.lru_b_i[(l * 2 + d) * 512 + chn];
  const float lam = p.lru_lam[(l * 2 + d) * 512 + chn];
  const float sp = log1pf(expf(-lam));
  float hst = 0.f, Pp = 1.f;
  const int r = lane & 31, h8 = lane >> 5;
  for (int si = 0; si < 4; si++) {
    int sub = d ? 3 - si : si;
#pragma unroll 4
    for (int i = 0; i < 16; i++) {
      int lt = tg * 16 + i; int pos = p0 + sub * 64 + lt;
      float xc = cb;
#pragma unroll
      for (int j = 0; j < 4; j++) {
        int q = pos - 2 + j;
        float zv = (q >= 0 && q < T) ? p.z[(size_t)(seq_t0 + q) * INW + OFF_ZX + chn] : 0.f;
        xc += cw[j] * zv;
      }
      sXc[lt * 64 + c] = xc; sA[lt * GLD + c] = f2bf(xc);
    }
    __syncthreads();
    {
      int mt = wave & 1, nh = wave >> 1;
      f32x16 acc[2];
#pragma unroll
      for (int i = 0; i < 2; i++)
#pragma unroll
        for (int e = 0; e < 16; e++) acc[i][e] = 0.f;
#pragma unroll
      for (int ks = 0; ks < 4; ks++) {
        bf16x8 a = *(const bf16x8*)(sA + (mt * 32 + r) * GLD + ks * 16 + h8 * 8);
#pragma unroll
        for (int ni = 0; ni < 2; ni++) {
          bf16x8 b = *(const bf16x8*)(sBt + (nh * 64 + ni * 32 + r) * GLD + ks * 16 + h8 * 8);
          acc[ni] = MFMA32(a, b, acc[ni]);
        }
      }
#pragma unroll
      for (int ni = 0; ni < 2; ni++)
#pragma unroll
        for (int e = 0; e < 16; e++) sG[(mt * 32 + crow(e, h8)) * 132 + nh * 64 + ni * 32 + r] = acc[ni][e];
    }
    __syncthreads();
#pragma unroll 4
    for (int i = 0; i < 16; i++) {
      int lt = tg * 16 + i;
      float ga = sG[lt * 132 + c] + ba, gi = sG[lt * 132 + 64 + c] + bi;
      float rr = 1.f / (1.f + expf(-ga)), ii = 1.f / (1.f + expf(-gi));
      float la = -8.0f * rr * sp;
      float a = expf(la);
      float u = sqrtf(-expm1f(2.f * la)) * ii * sXc[lt * 64 + c];
      sG[lt * 132 + c] = a; sG[lt * 132 + 64 + c] = u;
    }
    __syncthreads();
    if (tid < 64) {
      for (int s = 0; s < 64; s++) {
        int lt = d ? 63 - s : s;
        float a = sG[lt * 132 + c], u = sG[lt * 132 + 64 + c];
        hst = a * hst + u; Pp *= a;
        size_t o = ((size_t)d * NTOK + t0 + sub * 64 + lt) * 512 + chn;
        p.hs[o] = f2bf(hst); p.Pc[o] = f2bf(Pp);
      }
    }
    __syncthreads();
  }
  if (tid < 64) {
    p.hend[(d * 32 + ch) * 512 + chn] = hst; p.Pend[(d * 32 + ch) * 512 + chn] = Pp;
    if (ch < 16) p.out[(size_t)NTOK * DM + 16 * 2 * 256 * 256 + 16 * 2 * 256 * 64 + ((ch * 2 + l) * 2 + d) * 512 + chn] = hst;
  }
}

#define CMT 16
DI void cm_item(const Params& p, int l, int item, char* smem) {
  int t0 = item * CMT, seq_t0, T;
  if (t0 < NCTX) { seq_t0 = (t0 >> 8) << 8; T = 256; } else { seq_t0 = NCTX + (((t0 - NCTX) >> 10) << 10); T = 1024; }
  int p0 = t0 - seq_t0;
  unsigned* sGlu = (unsigned*)smem;
  float* red = (float*)(sGlu + (CMT + 30) * 256);
  float* red2 = red + 256;
  const int tid = opaque(threadIdx.x), wave = tid >> 6, lane = tid & 63;
#pragma unroll 8
  for (int rr = 0; rr < CMT + 30; rr++) {
    int pos = p0 - 15 + rr;
    unsigned v = 0;
    if (pos >= 0 && pos < T) {
      const float* zr = p.z + (size_t)(seq_t0 + pos) * INW + OFF_ZC;
      float2 a = *(const float2*)(zr + 2 * tid), b = *(const float2*)(zr + 512 + 2 * tid);
      v = pack_bf16(a.x * sigmoidf_(b.x), a.y * sigmoidf_(b.y));
    }
    sGlu[rr * 256 + tid] = v;
  }
  __syncthreads();
  float acc0[CMT], acc1[CMT];
  {
    float2 bb = *(const float2*)(p.cm_dw_b + l * 512 + 2 * tid);
#pragma unroll
    for (int t = 0; t < CMT; t++) { acc0[t] = bb.x; acc1[t] = bb.y; }
  }
  for (int j = 0; j < 31; j++) {
    float2 w = *(const float2*)(p.cm_dw_w + (size_t)(l * 31 + j) * 512 + 2 * tid);
#pragma unroll
    for (int t = 0; t < CMT; t++) { unsigned u = sGlu[(t + j) * 256 + tid]; acc0[t] += w.x * bf_lo(u); acc1[t] += w.y * bf_hi(u); }
  }
  {
    float ks = 0.f, kss = 0.f;
#pragma unroll
    for (int t = 0; t < CMT; t++) {
      float s = wave_sum(acc0[t] + acc1[t]);
      float ss = wave_sum(acc0[t] * acc0[t] + acc1[t] * acc1[t]);
      if (lane == t) { ks = s; kss = ss; }
    }
    if (lane < CMT) { red[(wave * CMT + lane) * 2] = ks; red[(wave * CMT + lane) * 2 + 1] = kss; }
  }
  __syncthreads();
  {
    float2 lg = *(const float2*)(p.cm_ln_g + l * 512 + 2 * tid), lb = *(const float2*)(p.cm_ln_b + l * 512 + 2 * tid);
    float k2 = 0.f;
#pragma unroll
    for (int t = 0; t < CMT; t++) {
      float s = red[(0 * CMT + t) * 2] + red[(1 * CMT + t) * 2] + red[(2 * CMT + t) * 2] + red[(3 * CMT + t) * 2];
      float ss = red[(0 * CMT + t) * 2 + 1] + red[(1 * CMT + t) * 2 + 1] + red[(2 * CMT + t) * 2 + 1] + red[(3 * CMT + t) * 2 + 1];
      float mu = s * (1.f / 512.f); float var = ss * (1.f / 512.f) - mu * mu; float rstd = rsqrtf(var + 1e-5f);
      float y0 = (acc0[t] - mu) * rstd * lg.x + lb.x, y1 = (acc1[t] - mu) * rstd * lg.y + lb.y;
      y0 = y0 * sigmoidf_(y0); y1 = y1 * sigmoidf_(y1);
      acc0[t] = y0; acc1[t] = y1;
      float s2 = wave_sum(y0 * y0 + y1 * y1);
      if (lane == t) k2 = s2;
    }
    if (lane < CMT) red2[wave * CMT + lane] = k2;
  }
  __syncthreads();
  {
    float2 gg = *(const float2*)(p.grp_g + l * DM + 1536 + 2 * tid);
#pragma unroll
    for (int t = 0; t < CMT; t++) {
      float tot = red2[t] + red2[CMT + t] + red2[2 * CMT + t] + red2[3 * CMT + t];
      float rinv = rsqrtf(tot * (1.f / 512.f) + 1e-6f);
      *(unsigned*)(p.mixed + (size_t)(t0 + t) * DM + 1536 + 2 * tid) = pack_bf16(acc0[t] * rinv * gg.x, acc1[t] * rinv * gg.y);
    }
  }
  __syncthreads();
}

DI void post_inproj_tokens(const Params& p, int l) {
  int tidq = opaque(threadIdx.x); int lane = tidq & 63, gw = blockIdx.x * 4 + (tidq >> 6), nw = gridDim.x * 4;
  float* new_ckv = p.out + (size_t)NTOK * DM;
  float* new_krope = new_ckv + 16 * 2 * 256 * 256;
  for (int t = gw; t < NTOK + 2048; t += nw) {
    if (t >= NTOK) {
      int rr = t - NTOK; int b = rr >> 9, j = rr & 511;
      float4 v = *(const float4*)(p.cache_ckv + ((size_t)(b * 2 + l) * 512 + j) * 256 + lane * 4);
      uint2 o; o.x = pack_bf16(v.x, v.y); o.y = pack_bf16(v.z, v.w);
      *(uint2*)(p.ckv + (size_t)(NCTX + b * 1536 + j) * 256 + lane * 4) = o;
      continue;
    }
    const float* zr = p.z + (size_t)t * INW;
    {
      float4 a = *(const float4*)(zr + lane * 4), b = *(const float4*)(zr + 256 + lane * 4);
      float ss = a.x * a.x + a.y * a.y + a.z * a.z + a.w * a.w + b.x * b.x + b.y * b.y + b.z * b.z + b.w * b.w;
      ss = wave_sum(ss);
      float rinv = rsqrtf(ss * (1.f / 512.f) + 1e-6f);
      float4 g0 = *(const float4*)(p.mla_qa_g + l * 512 + lane * 4), g1 = *(const float4*)(p.mla_qa_g + l * 512 + 256 + lane * 4);
      uint2 o0, o1;
      o0.x = pack_bf16(a.x * rinv * g0.x, a.y * rinv * g0.y); o0.y = pack_bf16(a.z * rinv * g0.z, a.w * rinv * g0.w);
      o1.x = pack_bf16(b.x * rinv * g1.x, b.y * rinv * g1.y); o1.y = pack_bf16(b.z * rinv * g1.z, b.w * rinv * g1.w);
      *(uint2*)(p.qa + (size_t)t * 512 + lane * 4) = o0;
      *(uint2*)(p.qa + (size_t)t * 512 + 256 + lane * 4) = o1;
    }
    {
      float4 a = *(const float4*)(zr + OFF_ZKV + lane * 4);
      float ss = wave_sum(a.x * a.x + a.y * a.y + a.z * a.z + a.w * a.w);
      float rinv = rsqrtf(ss * (1.f / 256.f) + 1e-6f);
      float4 g = *(const float4*)(p.mla_kva_g + l * 256 + lane * 4);
      float4 o = make_float4(a.x * rinv * g.x, a.y * rinv * g.y, a.z * rinv * g.z, a.w * rinv * g.w);
      uint2 ob; ob.x = pack_bf16(o.x, o.y); ob.y = pack_bf16(o.z, o.w);
      *(uint2*)(p.ckv + (size_t)kvrow_of_token(t) * 256 + lane * 4) = ob;
      if (t < NCTX) {
        int b = t >> 8, pos = t & 255;
        *(float4*)(new_ckv + ((size_t)(b * 2 + l) * 256 + pos) * 256 + lane * 4) = o;
        new_krope[((size_t)(b * 2 + l) * 256 + pos) * 64 + lane] = zr[OFF_ZKR + lane];
      }
    }
  }
}

DI void qnorm_tokens(const Params& p, int l) {
  int tidq = opaque(threadIdx.x); int lane = tidq & 63, gw = blockIdx.x * 4 + (tidq >> 6), nw = gridDim.x * 4;
  const float qscale = 0.07216878364870322f * 1.4426950408889634f;
  const float* g = p.mla_q_g + l * 192;
  float g0 = g[lane], g1 = g[64 + lane], g2 = g[128 + lane];
  for (int t = gw; t < NTOK; t += nw) {
    const ushort_t* qr = p.qraw + (size_t)t * 1536;
    bool lat = t >= NCTX; int pos = (t - NCTX) & 1023;
    float cs = 1.f, sn = 0.f;
    if (lat) { cs = p.rope[pos * 64 + (lane & 31)]; sn = p.rope[pos * 64 + 32 + (lane & 31)]; }
#pragma unroll
    for (int hh = 0; hh < 8; hh++) {
      float a = __uint_as_float((unsigned)qr[hh * 192 + lane] << 16), b = __uint_as_float((unsigned)qr[hh * 192 + 64 + lane] << 16), c = __uint_as_float((unsigned)qr[hh * 192 + 128 + lane] << 16);
      float ss = wave_sum(a * a + b * b + c * c);
      float rinv = rsqrtf(ss * (1.f / 192.f) + 1e-6f);
      a *= rinv * g0; b *= rinv * g1; c *= rinv * g2;
      if (lat) {
        float o = __shfl_xor(c, 32);
        c = (lane < 32) ? (c * cs - o * sn) : (o * sn + c * cs);
      }
      ushort_t* qo = p.Q + (size_t)t * 1536 + hh * 192;
      qo[lane] = f2bf(a * qscale); qo[64 + lane] = f2bf(b * qscale); qo[128 + lane] = f2bf(c * qscale);
    }
  }
}

DI void kv_item(const Params& p, int l, int item, char* smem) {
  int rt = item >> 3, hh = item & 7;
  int row0 = rt * 64;
  const int tid = opaque(threadIdx.x), wave = tid >> 6, lane = tid & 63;
  float* tile = (float*)smem;
  const float* g = p.mla_k_g + l * 192;
  float g0 = g[lane], g1 = g[64 + lane], g2 = g[128 + lane];
#pragma unroll 4
  for (int i = 0; i < 16; i++) {
    int lr = wave * 16 + i; int row = row0 + lr;
    const float* kr_src; bool rot = false; int pos = 0;
    if (row < NCTX) { kr_src = p.z + (size_t)row * INW + OFF_ZKR; }
    else {
      int rr = row - NCTX; int b = rr / 1536, j = rr % 1536;
      if (j < 512) kr_src = p.cache_krope + ((size_t)(b * 2 + l) * 512 + j) * 64;
      else { pos = j - 512; kr_src = p.z + (size_t)(NCTX + b * 1024 + pos) * INW + OFF_ZKR; rot = true; }
    }
    const ushort_t* kv = p.kvraw + (size_t)row * 2048 + hh * 256;
    float a = __uint_as_float((unsigned)kv[lane] << 16), b2 = __uint_as_float((unsigned)kv[64 + lane] << 16), c = kr_src[lane];
    float ss = wave_sum(a * a + b2 * b2 + c * c);
    float rinv = rsqrtf(ss * (1.f / 192.f) + 1e-6f);
    a *= rinv * g0; b2 *= rinv * g1; c *= rinv * g2;
    if (rot) {
      float cs = p.rope[pos * 64 + (lane & 31)], sn = p.rope[pos * 64 + 32 + (lane & 31)];
      float o = __shfl_xor(c, 32);
      c = (lane < 32) ? (c * cs - o * sn) : (o * sn + c * cs);
    }
    ushort_t* ko = p.K + (size_t)row * 1536 + hh * 192;
    ko[lane] = f2bf(a); ko[64 + lane] = f2bf(b2); ko[128 + lane] = f2bf(c);
    tile[lr * 129 + lane] = __uint_as_float((unsigned)kv[128 + lane] << 16); tile[lr * 129 + 64 + lane] = __uint_as_float((unsigned)kv[192 + lane] << 16);
  }
  __syncthreads();
  size_t vbase; int T, krow0;
  if (row0 < NCTX) { int sid = row0 >> 8; vbase = (size_t)(sid * 8 + hh) * 128 * 256; T = 256; krow0 = row0 & 255; }
  else { int rr = row0 - NCTX; int b = rr / 1536; vbase = (size_t)16 * 8 * 128 * 256 + (size_t)(b * 8 + hh) * 128 * 1536; T = 1536; krow0 = rr % 1536; }
#pragma unroll
  for (int i = 0; i < 4; i++) {
    int cidx = tid + i * 256; int dv = cidx >> 3, kg = cidx & 7;
    int G = kg >> 1, hhalf = kg & 1;
    float v[8];
#pragma unroll
    for (int s = 0; s < 8; s++) { int key = 16 * G + 8 * (s >> 2) + 4 * hhalf + (s & 3); v[s] = tile[key * 129 + dv]; }
    uint4 o; o.x = pack_bf16(v[0], v[1]); o.y = pack_bf16(v[2], v[3]); o.z = pack_bf16(v[4], v[5]); o.w = pack_bf16(v[6], v[7]);
    *(uint4*)(p.Vt + vbase + (size_t)dv * T + krow0 + kg * 8) = o;
  }
  __syncthreads();
}

#define KLD 200
#define VLD 72
DI void attn_item(const Params& p, int item, char* smem) {
  const int tid = opaque(threadIdx.x), wave = tid >> 6, lane = tid & 63;
  const int qs = wave & 1, kh = wave >> 1;
  int hh, Tk, tq0, kvbase; size_t vbase;
  if (item < 512) {
    int b = item >> 7; hh = (item >> 4) & 7; int qb = item & 15;
    Tk = 1536; tq0 = NCTX + b * 1024 + qb * 64; kvbase = NCTX + b * 1536;
    vbase = (size_t)16 * 8 * 128 * 256 + (size_t)(b * 8 + hh) * 128 * 1536;
  } else {
    int i2 = item - 512; int s = i2 >> 5; hh = (i2 >> 2) & 7; int qb = i2 & 3;
    Tk = 256; tq0 = s * 256 + qb * 64; kvbase = s * 256;
    vbase = (size_t)(s * 8 + hh) * 128 * 256;
  }
  ushort_t* sK = (ushort_t*)smem;
  ushort_t* sV = sK + 64 * KLD;
  const int r = lane & 31, h = lane >> 5;
  bf16x8 qf[12];
  {
    const ushort_t* qp = p.Q + (size_t)(tq0 + qs * 32 + r) * 1536 + hh * 192 + h * 8;
#pragma unroll
    for (int s = 0; s < 12; s++) qf[s] = *(const bf16x8*)(qp + s * 16);
  }
  f32x16 O[4];
#pragma unroll
  for (int i = 0; i < 4; i++)
#pragma unroll
    for (int e = 0; e < 16; e++) O[i][e] = 0.f;
  float m = -INFINITY, lsum = 0.f;
  const int nkt = Tk >> 6;
  const ushort_t* Kg = p.K + (size_t)kvbase * 1536 + hh * 192;
  const ushort_t* Vg = p.Vt + vbase;
  u32x4 rk[6], rv[4];
#pragma unroll
  for (int i = 0; i < 6; i++) { int c = tid + i * 256; int row = c / 24, kc = (c % 24) * 8; rk[i] = GLD16(Kg + (size_t)row * 1536 + kc); }
#pragma unroll
  for (int i = 0; i < 4; i++) { int c = tid + i * 256; int dv = c >> 3, kc = (c & 7) * 8; rv[i] = GLD16(Vg + (size_t)dv * Tk + kc); }
  for (int kt = 0; kt < nkt; kt++) {
    __syncthreads();
#pragma unroll
    for (int i = 0; i < 6; i++) { int c = tid + i * 256; int row = c / 24, kc = (c % 24) * 8; *(u32x4*)(sK + row * KLD + kc) = rk[i]; }
#pragma unroll
    for (int i = 0; i < 4; i++) { int c = tid + i * 256; int dv = c >> 3, kc = (c & 7) * 8; *(u32x4*)(sV + dv * VLD + kc) = rv[i]; }
    __syncthreads();
    if (kt + 1 < nkt) {
#pragma unroll
      for (int i = 0; i < 6; i++) { int c = tid + i * 256; int row = c / 24, kc = (c % 24) * 8; rk[i] = GLD16(Kg + (size_t)((kt + 1) * 64 + row) * 1536 + kc); }
#pragma unroll
      for (int i = 0; i < 4; i++) { int c = tid + i * 256; int dv = c >> 3, kc = (c & 7) * 8; rv[i] = GLD16(Vg + (size_t)dv * Tk + (kt + 1) * 64 + kc); }
    }
    f32x16 S;
#pragma unroll
    for (int e = 0; e < 16; e++) S[e] = 0.f;
    const ushort_t* kp = sK + (kh * 32 + r) * KLD + h * 8;
#pragma unroll
    for (int s = 0; s < 12; s++) { bf16x8 kf = *(const bf16x8*)(kp + s * 16); S = MFMA32(kf, qf[s], S); }
    float mx = S[0];
#pragma unroll
    for (int e = 1; e < 16; e++) mx = fmaxf(mx, S[e]);
    mx = fmaxf(mx, __shfl_xor(mx, 32));
    float mn = fmaxf(m, mx);
    float alpha = exp2f(m - mn);
    float rs = 0.f;
#pragma unroll
    for (int e = 0; e < 16; e++) { S[e] = exp2f(S[e] - mn); rs += S[e]; }
    rs += __shfl_xor(rs, 32);
    lsum = lsum * alpha + rs; m = mn;
#pragma unroll
    for (int i = 0; i < 4; i++)
#pragma unroll
      for (int e = 0; e < 16; e++) O[i][e] *= alpha;
    bf16x8 pf[2];
#pragma unroll
    for (int s2 = 0; s2 < 2; s2++) {
      u32x4 u; u.x = pack_bf16(S[8 * s2], S[8 * s2 + 1]); u.y = pack_bf16(S[8 * s2 + 2], S[8 * s2 + 3]);
      u.z = pack_bf16(S[8 * s2 + 4], S[8 * s2 + 5]); u.w = pack_bf16(S[8 * s2 + 6], S[8 * s2 + 7]);
      pf[s2] = __builtin_bit_cast(bf16x8, u);
    }
    const ushort_t* vp = sV + r * VLD + kh * 32 + h * 8;
#pragma unroll
    for (int dt = 0; dt < 4; dt++)
#pragma unroll
      for (int s2 = 0; s2 < 2; s2++) {
        bf16x8 vf = *(const bf16x8*)(vp + dt * 32 * VLD + s2 * 16);
        O[dt] = MFMA32(vf, pf[s2], O[dt]);
      }
  }
  __syncthreads();
  float* cO = (float*)smem;
  float* cML = cO + 2 * 64 * 64;
  if (kh == 1) {
#pragma unroll
    for (int dt = 0; dt < 4; dt++)
#pragma unroll
      for (int e = 0; e < 16; e++) cO[(qs * 64 + dt * 16 + e) * 64 + lane] = O[dt][e];
    cML[(qs * 2 + 0) * 64 + lane] = m; cML[(qs * 2 + 1) * 64 + lane] = lsum;
  }
  __syncthreads();
  if (kh == 0) {
    float m1 = cML[(qs * 2 + 0) * 64 + lane], l1 = cML[(qs * 2 + 1) * 64 + lane];
    float mf = fmaxf(m, m1);
    float a0 = exp2f(m - mf), a1 = exp2f(m1 - mf);
    float inv = 1.f / (lsum * a0 + l1 * a1);
    a0 *= inv; a1 *= inv;
    ushort_t* op = p.attn + (size_t)(tq0 + qs * 32 + r) * 1024 + hh * 128;
#pragma unroll
    for (int dt = 0; dt < 4; dt++)
#pragma unroll
      for (int gq = 0; gq < 4; gq++) {
        float o0 = O[dt][4 * gq] * a0 + cO[(qs * 64 + dt * 16 + 4 * gq) * 64 + lane] * a1;
        float o1 = O[dt][4 * gq + 1] * a0 + cO[(qs * 64 + dt * 16 + 4 * gq + 1) * 64 + lane] * a1;
        float o2 = O[dt][4 * gq + 2] * a0 + cO[(qs * 64 + dt * 16 + 4 * gq + 2) * 64 + lane] * a1;
        float o3 = O[dt][4 * gq + 3] * a0 + cO[(qs * 64 + dt * 16 + 4 * gq + 3) * 64 + lane] * a1;
        uint2 ov; ov.x = pack_bf16(o0, o1); ov.y = pack_bf16(o2, o3); *(uint2*)(op + dt * 32 + 8 * gq + 4 * h) = ov;
      }
  }
  __syncthreads();
}

DI void merge_tokens(const Params& p, int l) {
  int tidq = opaque(threadIdx.x); int lane = tidq & 63, gw = blockIdx.x * 4 + (tidq >> 6), nw = gridDim.x * 4;
  const float* gg = p.grp_g + l * DM;
  for (int t = gw; t < NTOK; t += nw) {
    {
      const ushort_t* ar = p.attn + (size_t)t * 1024;
      float4 v[4]; float ss = 0.f;
#pragma unroll
      for (int j = 0; j < 4; j++) { uint2 u_ = *(const uint2*)(ar + j * 256 + lane * 4); v[j] = make_float4(bf_lo(u_.x), bf_hi(u_.x), bf_lo(u_.y), bf_hi(u_.y)); ss += v[j].x * v[j].x + v[j].y * v[j].y + v[j].z * v[j].z + v[j].w * v[j].w; }
      ss = wave_sum(ss);
      float rinv = rsqrtf(ss * (1.f / 1024.f) + 1e-6f);
#pragma unroll
      for (int j = 0; j < 4; j++) {
        int col = j * 256 + lane * 4; float4 g = *(const float4*)(gg + col);
        uint2 o; o.x = pack_bf16(v[j].x * rinv * g.x, v[j].y * rinv * g.y); o.y = pack_bf16(v[j].z * rinv * g.z, v[j].w * rinv * g.w);
        *(uint2*)(p.mixed + (size_t)t * DM + col) = o;
      }
    }
    {
      float val[8]; float ss = 0.f;
      int ch = t >> 8;
#pragma unroll
      for (int j = 0; j < 2; j++) {
        int col = j * 256 + lane * 4;
        float cf[4] = {0, 0, 0, 0}, cbk[4] = {0, 0, 0, 0};
        if (t >= NCTX) {
          int b = (t - NCTX) >> 10, cc = (ch - 16) & 3, chb = 16 + b * 4;
          float4 h0f = *(const float4*)(p.state_lru + ((size_t)(b * 2 + l) * 2 + 0) * 512 + col);
          float4 h0b = *(const float4*)(p.state_lru + ((size_t)(b * 2 + l) * 2 + 1) * 512 + col);
          cf[0] = h0f.x; cf[1] = h0f.y; cf[2] = h0f.z; cf[3] = h0f.w;
          cbk[0] = h0b.x; cbk[1] = h0b.y; cbk[2] = h0b.z; cbk[3] = h0b.w;
          for (int jj = 0; jj < cc; jj++) {
            float4 he = *(const float4*)(p.hend + (size_t)(0 * 32 + chb + jj) * 512 + col), pe = *(const float4*)(p.Pend + (size_t)(0 * 32 + chb + jj) * 512 + col);
            cf[0] = he.x + pe.x * cf[0]; cf[1] = he.y + pe.y * cf[1]; cf[2] = he.z + pe.z * cf[2]; cf[3] = he.w + pe.w * cf[3];
          }
          for (int jj = 3; jj > cc; jj--) {
            float4 he = *(const float4*)(p.hend + (size_t)(1 * 32 + chb + jj) * 512 + col), pe = *(const float4*)(p.Pend + (size_t)(1 * 32 + chb + jj) * 512 + col);
            cbk[0] = he.x + pe.x * cbk[0]; cbk[1] = he.y + pe.y * cbk[1]; cbk[2] = he.z + pe.z * cbk[2]; cbk[3] = he.w + pe.w * cbk[3];
          }
        }
        uint2 uhf = *(const uint2*)(p.hs + ((size_t)0 * NTOK + t) * 512 + col), upf = *(const uint2*)(p.Pc + ((size_t)0 * NTOK + t) * 512 + col);
        uint2 uhb = *(const uint2*)(p.hs + ((size_t)1 * NTOK + t) * 512 + col), upb = *(const uint2*)(p.Pc + ((size_t)1 * NTOK + t) * 512 + col);
        float4 hf_ = make_float4(bf_lo(uhf.x), bf_hi(uhf.x), bf_lo(uhf.y), bf_hi(uhf.y)), pf_ = make_float4(bf_lo(upf.x), bf_hi(upf.x), bf_lo(upf.y), bf_hi(upf.y));
        float4 hb_ = make_float4(bf_lo(uhb.x), bf_hi(uhb.x), bf_lo(uhb.y), bf_hi(uhb.y)), pb_ = make_float4(bf_lo(upb.x), bf_hi(upb.x), bf_lo(upb.y), bf_hi(upb.y));
        float4 zg = *(const float4*)(p.z + (size_t)t * INW + OFF_ZG + col);
        float y0 = hf_.x + pf_.x * cf[0] + hb_.x + pb_.x * cbk[0];
        float y1 = hf_.y + pf_.y * cf[1] + hb_.y + pb_.y * cbk[1];
        float y2 = hf_.z + pf_.z * cf[2] + hb_.z + pb_.z * cbk[2];
        float y3 = hf_.w + pf_.w * cf[3] + hb_.w + pb_.w * cbk[3];
        y0 *= gelu_tanh(zg.x); y1 *= gelu_tanh(zg.y); y2 *= gelu_tanh(zg.z); y3 *= gelu_tanh(zg.w);
        val[j * 4] = y0; val[j * 4 + 1] = y1; val[j * 4 + 2] = y2; val[j * 4 + 3] = y3;
        ss += y0 * y0 + y1 * y1 + y2 * y2 + y3 * y3;
      }
      ss = wave_sum(ss);
      float rinv = rsqrtf(ss * (1.f / 512.f) + 1e-6f);
#pragma unroll
      for (int j = 0; j < 2; j++) {
        int col = j * 256 + lane * 4; float4 g = *(const float4*)(gg + 1024 + col);
        uint2 o; o.x = pack_bf16(val[j * 4] * rinv * g.x, val[j * 4 + 1] * rinv * g.y); o.y = pack_bf16(val[j * 4 + 2] * rinv * g.z, val[j * 4 + 3] * rinv * g.w);
        *(uint2*)(p.mixed + (size_t)t * DM + 1024 + col) = o;
      }
    }
  }
}

#define TOPK_INS(TV, TI, XV, XI) { float xv_ = (XV); int xi_ = (XI); _Pragma("unroll") for (int i_ = 0; i_ < 16; i_++) { bool c_ = xv_ > TV[i_]; float nv_ = c_ ? xv_ : TV[i_]; float ov_ = c_ ? TV[i_] : xv_; int ni_ = c_ ? xi_ : TI[i_]; int oi_ = c_ ? TI[i_] : xi_; TV[i_] = nv_; TI[i_] = ni_; xv_ = ov_; xi_ = oi_; } }
DI void peer_phase(const Params& p, int l, char* smem) {
  const int tid = opaque(threadIdx.x), wave = tid >> 6, lane = tid & 63;
  float* wsm = (float*)(smem + wave * 12288);
  float* lv = wsm;
  int* lidx = (int*)(wsm + 1024);
  int* pki = (int*)(wsm + 2048);
  float* pkg = wsm + 2560;
  const float* scores = p.z;
  const unsigned char* Ub = p.Ub + (size_t)l * NEXP * DM;
  const unsigned char* Vb = p.Vb + (size_t)l * NEXP * DM;
  const float* Us = p.Us + l * NEXP;
  const float* Vs = p.Vs + l * NEXP;
  float* dst = l == 0 ? p.xA : p.out;
  for (int tb = blockIdx.x; tb < NTOK / 16; tb += gridDim.x) {
    const int tg = tb * 4 + wave;
    {
      const GAS f32x4* sp = (const GAS f32x4*)(scores + (size_t)(tg * 4 + (lane >> 4)) * 2048 + (lane & 15) * 128);
      float tv[16]; int ti[16];
#pragma unroll
      for (int i = 0; i < 16; i++) { tv[i] = -INFINITY; ti[i] = 0; }
      for (int k = 0; k < 128; k += 8) {
        float x[8];
        { f32x4 xa_ = sp[k >> 2], xb_ = sp[(k >> 2) + 1]; x[0] = xa_[0]; x[1] = xa_[1]; x[2] = xa_[2]; x[3] = xa_[3]; x[4] = xb_[0]; x[5] = xb_[1]; x[6] = xb_[2]; x[7] = xb_[3]; }
#pragma unroll
        for (int u = 0; u < 8; u++) TOPK_INS(tv, ti, x[u], k + u);
      }
#pragma unroll
      for (int i = 0; i < 16; i++) { lv[i * 64 + lane] = tv[i]; lidx[i * 64 + lane] = ti[i]; }
    }
    __syncthreads();
    if (lane < 32) {
      const int tt = lane >> 3, hh = lane & 7;
      const int la = tt * 16 + 2 * hh, lb = la + 1;
      float s1[16], s2[16];
#pragma unroll
      for (int i = 0; i < 16; i++) { s1[i] = lv[i * 64 + la]; s2[i] = lv[i * 64 + lb]; }
      float cv[16]; int cf[16];
#pragma unroll
      for (int i = 0; i < 16; i++) { cv[i] = -INFINITY; cf[i] = 0; }
#pragma unroll
      for (int i = 0; i < 16; i++) {
#pragma unroll
        for (int j = 0; j < 16; j++) {
          if ((i + 1) * (j + 1) <= 16) TOPK_INS(cv, cf, s1[i] + s2[j], i * 16 + j);
        }
      }
      float e[16]; float sum = 0.f;
#pragma unroll
      for (int r = 0; r < 16; r++) { e[r] = __expf(cv[r] - cv[0]); sum += e[r]; }
      const float inv = 1.f / sum;
#pragma unroll
      for (int r = 0; r < 16; r++) {
        int id = lidx[(cf[r] >> 4) * 64 + la] * 128 + lidx[(cf[r] & 15) * 64 + lb];
        pki[tt * 128 + hh * 16 + r] = id; pkg[tt * 128 + hh * 16 + r] = e[r] * inv;
      }
    }
    __syncthreads();
    for (int tt = 0; tt < 4; tt++) {
    const int t = tg * 4 + tt;
    const int idx0 = pki[tt * 128 + lane], idx1 = pki[tt * 128 + 64 + lane];
    const float g0 = pkg[tt * 128 + lane], g1 = pkg[tt * 128 + 64 + lane];
    float xs[32];
#pragma unroll
    for (int j = 0; j < 2; j++) {
      const uint4* xp = (const uint4*)(p.hn + (size_t)t * DM + (j * 64 + lane) * 16);
      uint4 xa = xp[0], xb = xp[1];
      xs[j * 16 + 0] = bf_lo(xa.x); xs[j * 16 + 1] = bf_hi(xa.x); xs[j * 16 + 2] = bf_lo(xa.y); xs[j * 16 + 3] = bf_hi(xa.y);
      xs[j * 16 + 4] = bf_lo(xa.z); xs[j * 16 + 5] = bf_hi(xa.z); xs[j * 16 + 6] = bf_lo(xa.w); xs[j * 16 + 7] = bf_hi(xa.w);
      xs[j * 16 + 8] = bf_lo(xb.x); xs[j * 16 + 9] = bf_hi(xb.x); xs[j * 16 + 10] = bf_lo(xb.y); xs[j * 16 + 11] = bf_hi(xb.y);
      xs[j * 16 + 12] = bf_lo(xb.z); xs[j * 16 + 13] = bf_hi(xb.z); xs[j * 16 + 14] = bf_lo(xb.w); xs[j * 16 + 15] = bf_hi(xb.w);
    }
    const float us0 = Us[idx0], us1 = Us[idx1], vs0 = Vs[idx0], vs1 = Vs[idx1];
    float a0 = 0.f, a1 = 0.f;
    {
      u32x4 ld[8][2];
#pragma unroll
      for (int rr = 0; rr < 8; rr++) {
        int idx = __builtin_amdgcn_readlane(idx0, rr);
        const unsigned char* row = Ub + (size_t)idx * DM;
#pragma unroll
        for (int j = 0; j < 2; j++) ld[rr][j] = GLD16(row + (j * 64 + lane) * 16);
      }
      for (int k0 = 0; k0 < 128; k0 += 8) {
        int nsrc = (k0 + 8 < 64) ? idx0 : idx1;
        float part[8];
#pragma unroll
        for (int rr = 0; rr < 8; rr++) {
          float s = 0.f;
#pragma unroll
          for (int j = 0; j < 2; j++)
#pragma unroll
            for (int q = 0; q < 4; q++) {
              f32x2_t lo = __builtin_amdgcn_cvt_pk_f32_fp8((int)ld[rr][j][q], false);
              f32x2_t hi = __builtin_amdgcn_cvt_pk_f32_fp8((int)ld[rr][j][q], true);
              s += lo[0] * xs[j * 16 + q * 4] + lo[1] * xs[j * 16 + q * 4 + 1] + hi[0] * xs[j * 16 + q * 4 + 2] + hi[1] * xs[j * 16 + q * 4 + 3];
            }
          part[rr] = s;
          if (k0 + 8 < 128) {
            int idx = __builtin_amdgcn_readlane(nsrc, (k0 + 8 + rr) & 63);
            const unsigned char* row = Ub + (size_t)idx * DM;
#pragma unroll
            for (int j = 0; j < 2; j++) ld[rr][j] = GLD16(row + (j * 64 + lane) * 16);
          }
        }
#pragma unroll
        for (int o = 32; o; o >>= 1) {
#pragma unroll
          for (int rr = 0; rr < 8; rr++) part[rr] += __shfl_xor(part[rr], o);
        }
#pragma unroll
        for (int rr = 0; rr < 8; rr++) {
          if (lane == ((k0 + rr) & 63)) { if (k0 < 64) a0 = part[rr]; else a1 = part[rr]; }
        }
      }
    }
    float w0 = g0 * gelu_tanh(a0 * us0) * vs0, w1 = g1 * gelu_tanh(a1 * us1) * vs1;
    float acc[32];
#pragma unroll
    for (int e = 0; e < 32; e++) acc[e] = 0.f;
    {
      u32x4 ld[4][2];
#pragma unroll
      for (int rr = 0; rr < 4; rr++) {
        int idx = __builtin_amdgcn_readlane(idx0, rr);
        const unsigned char* row = Vb + (size_t)idx * DM;
#pragma unroll
        for (int j = 0; j < 2; j++) ld[rr][j] = GLD16(row + (j * 64 + lane) * 16);
      }
      for (int k0 = 0; k0 < 128; k0 += 4) {
        float wsrc = (k0 < 64) ? w0 : w1;
        int nsrc = (k0 + 4 < 64) ? idx0 : idx1;
#pragma unroll
        for (int rr = 0; rr < 4; rr++) {
          float w = rdlane_f(wsrc, (k0 + rr) & 63);
#pragma unroll
          for (int j = 0; j < 2; j++)
#pragma unroll
            for (int q = 0; q < 4; q++) {
              f32x2_t lo = __builtin_amdgcn_cvt_pk_f32_fp8((int)ld[rr][j][q], false);
              f32x2_t hi = __builtin_amdgcn_cvt_pk_f32_fp8((int)ld[rr][j][q], true);
              acc[j * 16 + q * 4 + 0] += w * lo[0]; acc[j * 16 + q * 4 + 1] += w * lo[1];
              acc[j * 16 + q * 4 + 2] += w * hi[0]; acc[j * 16 + q * 4 + 3] += w * hi[1];
            }
          if (k0 + 4 < 128) {
            int idx = __builtin_amdgcn_readlane(nsrc, (k0 + 4 + rr) & 63);
            const unsigned char* row = Vb + (size_t)idx * DM;
#pragma unroll
            for (int j = 0; j < 2; j++) ld[rr][j] = GLD16(row + (j * 64 + lane) * 16);
          }
        }
      }
    }
    const float* md = p.mod + (size_t)(l * 5 + cvidx(t)) * 12288 + 10240;
    float ssq = 0.f;
#pragma unroll
    for (int j = 0; j < 2; j++)
#pragma unroll
      for (int q = 0; q < 4; q++) {
        int col = (j * 64 + lane) * 16 + q * 4;
        float4 xa = *(const float4*)(p.x1 + (size_t)t * DM + col);
        float4 ga = *(const float4*)(md + col);
        float4 oa = make_float4(xa.x + ga.x * acc[j * 16 + q * 4], xa.y + ga.y * acc[j * 16 + q * 4 + 1], xa.z + ga.z * acc[j * 16 + q * 4 + 2], xa.w + ga.w * acc[j * 16 + q * 4 + 3]);
        *(float4*)(dst + (size_t)t * DM + col) = oa;
        acc[j * 16 + q * 4] = oa.x; acc[j * 16 + q * 4 + 1] = oa.y; acc[j * 16 + q * 4 + 2] = oa.z; acc[j * 16 + q * 4 + 3] = oa.w;
        ssq += oa.x * oa.x + oa.y * oa.y + oa.z * oa.z + oa.w * oa.w;
      }
    if (l == 0) {
      ssq = wave_sum(ssq);
      const float rinv = rsqrtf(ssq * (1.f / DM) + 1e-6f);
      const float* g = p.norm_mix_g + DM;
      const float* md1 = p.mod + (size_t)(5 + cvidx(t)) * 12288;
#pragma unroll
      for (int j = 0; j < 2; j++)
#pragma unroll
        for (int q = 0; q < 4; q++) {
          int col = (j * 64 + lane) * 16 + q * 4;
          float4 gg = *(const float4*)(g + col), sc = *(const float4*)(md1 + 2048 + col), sh = *(const float4*)(md1 + col);
          float y0 = acc[j * 16 + q * 4] * rinv * gg.x * (1.f + sc.x) + sh.x;
          float y1 = acc[j * 16 + q * 4 + 1] * rinv * gg.y * (1.f + sc.y) + sh.y;
          float y2 = acc[j * 16 + q * 4 + 2] * rinv * gg.z * (1.f + sc.z) + sh.z;
          float y3 = acc[j * 16 + q * 4 + 3] * rinv * gg.w * (1.f + sc.w) + sh.w;
          uint2 o; o.x = pack_bf16(y0, y1); o.y = pack_bf16(y2, y3);
          *(uint2*)(p.hn + (size_t)t * DM + col) = o;
        }
    }
    }
    __syncthreads();
  }
}

DI void gsync(unsigned* bar, unsigned& gen) {
  asm volatile("s_waitcnt vmcnt(0) lgkmcnt(0)" ::: "memory");
  __syncthreads();
  if (threadIdx.x == 0) {
    __builtin_amdgcn_fence(__ATOMIC_RELEASE, "agent");
    asm volatile("s_waitcnt vmcnt(0)" ::: "memory");
    gen++;
    const unsigned ng = gridDim.x >> 3;
    unsigned* gc = bar + 32 * (1 + (blockIdx.x & 7));
    (void)__hip_atomic_fetch_add(gc, 1u, __ATOMIC_RELAXED, __HIP_MEMORY_SCOPE_AGENT);
    if (blockIdx.x < 8) {
      const unsigned gt = gen * ng;
      while (__hip_atomic_load(gc, __ATOMIC_RELAXED, __HIP_MEMORY_SCOPE_AGENT) < gt) __builtin_amdgcn_s_sleep(1);
      (void)__hip_atomic_fetch_add(bar, 1u, __ATOMIC_RELAXED, __HIP_MEMORY_SCOPE_AGENT);
    }
    const unsigned target = gen * 8u;
    while (__hip_atomic_load(bar, __ATOMIC_RELAXED, __HIP_MEMORY_SCOPE_AGENT) < target) __builtin_amdgcn_s_sleep(4);
    __builtin_amdgcn_fence(__ATOMIC_ACQUIRE, "agent");
    asm volatile("s_waitcnt vmcnt(0)" ::: "memory");
  }
  __syncthreads();
}

DI void dump_bf16(const Params& p, const ushort_t* src) {
  size_t n = (size_t)NTOK * DM; size_t tot = n + 16 * 2 * 256 * 256 + 16 * 2 * 256 * 64 + 16 * 2 * 2 * 512;
  for (size_t i = (size_t)blockIdx.x * 256 + threadIdx.x; i < tot; i += (size_t)gridDim.x * 256)
    p.out[i] = i < n ? __uint_as_float(((unsigned)src[i]) << 16) : (i < n + 2 * 5 * 12288 ? p.mod[i - n] : 0.f);
}


DI void dump_f32(const Params& p, const float* src, size_t n) {
  size_t tot = (size_t)NTOK * DM + 16 * 2 * 256 * 256 + 16 * 2 * 256 * 64 + 16 * 2 * 2 * 512;
  for (size_t i = (size_t)blockIdx.x * 256 + threadIdx.x; i < tot; i += (size_t)gridDim.x * 256)
    p.out[i] = i < n ? src[i] : 0.f;
}

__global__ void __launch_bounds__(256, 2) fwd_megakernel(Params pk) {
  __shared__ __attribute__((aligned(16))) char smem[SMEM_BYTES];
  __shared__ __attribute__((aligned(16))) unsigned long long spw[(sizeof(Params) + 7) / 8];
  {
    const unsigned long long* ka = (const unsigned long long*)__builtin_amdgcn_kernarg_segment_ptr();
    if (threadIdx.x < (sizeof(Params) + 7) / 8) spw[threadIdx.x] = ka[threadIdx.x];
    __syncthreads();
  }
#define PP (*(const Params*)((const char*)spw + opaque(0)))
  unsigned gen = 0; unsigned* bar = PP.bar;
  const int nb = gridDim.x, bid = blockIdx.x;
  const int wave = threadIdx.x >> 6, lane = threadIdx.x & 63;

  for (int rep = 0; rep < REP_A; rep++) {
  { const Params& p = PP; prep_phase(p, smem); }
  gsync(bar, gen);
  }

  for (int l = 0; l < 2; l++) {
    for (int rep = 0; rep < REP_D; rep++) {
    if (l == 0) { { const Params& p = PP; norm_phase(p, l, 0); } gsync(bar, gen); }
    }
    for (int rep = 0; rep < REP_B; rep++) {
    {
      const Params& p = PP;
      const ushort_t* Bt = p.WinT + (size_t)l * INW * DM;
      float* z = p.z;
      for (int j = bid >> 3; j < 192; j += nb >> 3) {
        int mt = (bid & 7) * 8 + ((j & 63) >> 3), nt = (j >> 6) * 8 + (j & 7);
        if (nt >= 23) continue;
        gemm_tile(p.hn, DM, Bt, DM, DM, INW, mt * 128, nt * 128, smem, [&](int row, int col, float v) { z[(size_t)row * INW + col] = v; });
      }
    }
    gsync(bar, gen);
    }
    for (int rep = 0; rep < REP_D; rep++) {
    {
      const Params& p = PP;
      for (int it = bid; it < 512 + NTOK / CMT; it += nb) {
        if (it < 512) lru_item(p, l, it, smem); else cm_item(p, l, it - 512, smem);
      }
    }
    { const Params& p = PP; post_inproj_tokens(p, l); }
    gsync(bar, gen);
    }
    for (int rep = 0; rep < REP_B; rep++) {
    {
      const Params& p = PP;
      const ushort_t* Bq = p.WqbT + (size_t)l * 1536 * 512;
      const ushort_t* Bkv = p.WkvbT + (size_t)l * 2048 * 256;
      ushort_t* qraw = p.qraw; ushort_t* kvraw = p.kvraw;
      for (int j = bid >> 3; j < 256; j += nb >> 3) {
        if (j < 160) {
          int rem = j % 80; int mt = (bid & 7) * 10 + (rem >> 3), nt = (j / 80) * 8 + (rem & 7);
          gemm_tile(p.ckv, 256, Bkv, 256, 256, 2048, mt * 128, nt * 128, smem, [&](int row, int col, float v) { kvraw[(size_t)row * 2048 + col] = f2bf(v); });
        } else {
          int j2 = j - 160; int rem = j2 % 48; int mt = (bid & 7) * 8 + rem / 6, nt = (j2 / 48) * 6 + rem % 6;
          gemm_tile(p.qa, 512, Bq, 512, 512, 1536, mt * 128, nt * 128, smem, [&](int row, int col, float v) { qraw[(size_t)row * 1536 + col] = f2bf(v); });
        }
      }
    }
    gsync(bar, gen);
    }
    for (int rep = 0; rep < REP_D; rep++) {
    { const Params& p = PP; for (int it = bid; it < 160 * 8; it += nb) kv_item(p, l, it, smem); }
    { const Params& p = PP; qnorm_tokens(p, l); }
    gsync(bar, gen);
    }
    for (int rep = 0; rep < REP_D; rep++) {
    { const Params& p = PP; for (int it = bid; it < 1024; it += nb) attn_item(p, it, smem); }
    gsync(bar, gen);
    }
    for (int rep = 0; rep < REP_D; rep++) {
    { const Params& p = PP; merge_tokens(p, l); }
    gsync(bar, gen);
    }
    for (int rep = 0; rep < REP_B; rep++) {
    {
      const Params& p = PP;
      const ushort_t* Bt = p.WoutT + (size_t)l * DM * DM;
      float* x1 = p.x1;
      for (int j = bid >> 3; j < 128; j += nb >> 3) {
        int mt = (bid & 7) * 8 + ((j & 63) >> 3), nt = (j >> 6) * 8 + (j & 7);
        gemm_tile(p.mixed, DM, Bt, DM, DM, DM, mt * 128, nt * 128, smem, [&](int row, int col, float v) {
          const float* xr = xrow_in(p, l, row);
          float g1 = p.mod[(size_t)(l * 5 + cvidx(row)) * 12288 + 4096 + col];
          x1[(size_t)row * DM + col] = xr[col] + g1 * v;
        });
      }
    }
    gsync(bar, gen);
    }
    for (int rep = 0; rep < REP_D; rep++) {
    { const Params& p = PP; norm_phase(p, l, 1); }
    gsync(bar, gen);
    }
    for (int rep = 0; rep < REP_B; rep++) {
    {
      const Params& p = PP;
      const ushort_t* Bt = p.WpqT + (size_t)l * DM * DM;
      ushort_t* pq = p.mixed;
      for (int j = bid >> 3; j < 128; j += nb >> 3) {
        int mt = (bid & 7) * 8 + ((j & 63) >> 3), nt = (j >> 6) * 8 + (j & 7);
        gemm_tile(p.hn, DM, Bt, DM, DM, DM, mt * 128, nt * 128, smem, [&](int row, int col, float v) { pq[(size_t)row * DM + col] = f2bf(v); });
      }
    }
    gsync(bar, gen);
    }
    for (int rep = 0; rep < REP_B; rep++) {
    {
      const Params& p = PP;
      const ushort_t* Kb = p.KeysB + (size_t)l * 2048 * 128;
      float* sc = p.z;
      for (int j = bid >> 3; j < 128; j += nb >> 3) {
        int mt = (bid & 7) * 8 + ((j & 63) >> 3), nt = (j >> 6) * 8 + (j & 7);
        gemm_tile(p.mixed + nt * 128, DM, Kb + (size_t)nt * 128 * 128, 128, 128, 128, mt * 128, 0, smem, [&](int row, int col, float v) { sc[(size_t)row * 2048 + nt * 128 + col] = v; });
      }
    }
    gsync(bar, gen);
    }
    for (int rep = 0; rep < REP_C; rep++) {
    { const Params& p = PP; peer_phase(p, l, smem); }
    gsync(bar, gen);
    }
  }
}

extern "C" void kernel_launch(void* const* d_in, const int* in_sizes, int n_in, void* d_out, int out_size, void* d_ws, size_t ws_size, hipStream_t stream) {
  static int grid_blocks = 0;
  if (!grid_blocks) {
    int dev = 0, cus = 0, per_cu = 0;
    hipGetDevice(&dev);
    hipDeviceGetAttribute(&cus, hipDeviceAttributeMultiprocessorCount, dev);
    hipOccupancyMaxActiveBlocksPerMultiprocessor(&per_cu, fwd_megakernel, 256, 0);
    if (per_cu > 2) per_cu = 2;
    if (per_cu < 1) per_cu = 1;
    grid_blocks = (cus * per_cu) & ~7;
  }
  Params p{};
  const float** pin = (const float**)&p;
  for (int i = 0; i < 35; i++) pin[i] = (const float*)d_in[i];
  p.out = (float*)d_out;
  char* w = (char*)d_ws; size_t off = 0;
  auto take = [&](size_t bytes) { char* r = w + off; off += (bytes + 255) & ~(size_t)255; return r; };
  p.bar = (unsigned*)take(2048);
  p.WinT = (ushort_t*)take((size_t)2 * INW * DM * 2);
  p.WqbT = (ushort_t*)take((size_t)2 * 1536 * 512 * 2);
  p.WkvbT = (ushort_t*)take((size_t)2 * 2048 * 256 * 2);
  p.WoutT = (ushort_t*)take((size_t)2 * DM * DM * 2);
  p.WpqT = (ushort_t*)take((size_t)2 * DM * DM * 2);
  p.KeysB = (ushort_t*)take((size_t)2 * 2048 * 128 * 2);
  p.LruW = (ushort_t*)take((size_t)2 * 16 * 2 * 4096 * 2);
  p.Ub = (unsigned char*)take((size_t)2 * NEXP * DM);
  p.Vb = (unsigned char*)take((size_t)2 * NEXP * DM);
  p.Us = (float*)take((size_t)2 * NEXP * 4);
  p.Vs = (float*)take((size_t)2 * NEXP * 4);
  p.hn = (ushort_t*)take((size_t)NTOK * DM * 2);
  p.qa = (ushort_t*)take((size_t)NTOK * 512 * 2);
  p.ckv = (ushort_t*)take((size_t)NKV * 256 * 2);
  p.Q = (ushort_t*)take((size_t)NTOK * 1536 * 2);
  p.K = (ushort_t*)take((size_t)NKV * 1536 * 2);
  p.Vt = (ushort_t*)take((size_t)NKV * 1024 * 2);
  p.mixed = (ushort_t*)take((size_t)NTOK * DM * 2);
  p.z = (float*)take((size_t)NTOK * INW * 4);
  p.qraw = (ushort_t*)take((size_t)NTOK * 1536 * 2);
  p.kvraw = (ushort_t*)take((size_t)NKV * 2048 * 2);
  p.attn = (ushort_t*)take((size_t)NTOK * 1024 * 2);
  p.hs = (ushort_t*)take((size_t)2 * NTOK * 512 * 2);
  p.Pc = (ushort_t*)take((size_t)2 * NTOK * 512 * 2);
  p.hend = (float*)take((size_t)2 * 32 * 512 * 4);
  p.Pend = (float*)take((size_t)2 * 32 * 512 * 4);
  p.x1 = (float*)take((size_t)NTOK * DM * 4);
  p.xA = (float*)take((size_t)NTOK * DM * 4);
  p.mod = (float*)take((size_t)2 * 5 * 12288 * 4);
  p.rope = (float*)take((size_t)1024 * 64 * 4);
  if (off > ws_size) { fprintf(stderr, "workspace too small: need %zu have %zu\n", off, ws_size); return; }
  if (hipMemsetAsync(p.bar, 0, 2048, stream) != hipSuccess) { fprintf(stderr, "memset failed\n"); return; }
  hipLaunchKernelGGL(fwd_megakernel, dim3(grid_blocks), dim3(256), 0, stream, p);
}
```

```cpp
#include <hip/hip_runtime.h>
#include <hip/hip_cooperative_groups.h>
#include <cstdio>
#include <cstdint>
namespace cg = cooperative_groups;

typedef unsigned short ushort_t;
typedef __attribute__((ext_vector_type(8))) short bf16x8;
typedef __attribute__((ext_vector_type(16))) float f32x16;
typedef __attribute__((ext_vector_type(4))) unsigned u32x4;
typedef __attribute__((ext_vector_type(4))) float f32x4;
typedef __attribute__((ext_vector_type(2))) float f32x2_t;
typedef __attribute__((ext_vector_type(2))) __bf16 bf16x2_t;
#define DI __device__ __forceinline__
#define GAS __attribute__((address_space(1)))
#define GLD16(ptr) (*(const GAS u32x4*)(ptr))
#define MFMA32(a, b, c) __builtin_amdgcn_mfma_f32_32x32x16_bf16((a), (b), (c), 0, 0, 0)

#define DM 2048
#define NTOK 8192
#define NCTX 4096
#define INW 2880
#define NKV 10240
#define OFF_ZKV 512
#define OFF_ZKR 768
#define OFF_ZX 832
#define OFF_ZG 1344
#define OFF_ZC 1856
#define NEXP 16384
#define SMEM_BYTES 78848
#ifndef REP_A
#define REP_A 1
#define REP_B 1
#define REP_C 1
#define REP_D 1
#endif

struct Params {
  const float *x_prompt, *x_sample, *cache_ckv, *cache_krope, *state_lru, *c, *c_ctx;
  const float *ada_w, *ada_b, *norm_mix_g, *w_in, *mla_qa_g, *mla_w_qb, *mla_q_g, *mla_kva_g, *mla_w_kvb, *mla_k_g;
  const float *lru_conv_w, *lru_conv_b, *lru_w_a, *lru_b_a, *lru_w_i, *lru_b_i, *lru_lam;
  const float *cm_dw_w, *cm_dw_b, *cm_ln_g, *cm_ln_b, *grp_g, *w_out, *norm_ffn_g;
  const float *peer_w_q, *peer_keys, *peer_u, *peer_v;
  float* out;
  unsigned* bar;
  ushort_t *WinT, *WqbT, *WkvbT, *WoutT, *WpqT, *KeysB, *LruW;
  unsigned char *Ub, *Vb;
  float *Us, *Vs;
  ushort_t *hn, *qa, *ckv, *Q, *K, *Vt, *mixed;
  ushort_t *qraw, *kvraw, *attn, *hs, *Pc;
  float *z, *hend, *Pend, *x1, *xA, *mod, *rope;
};

DI unsigned pack_bf16(float lo, float hi) { f32x2_t v = {lo, hi}; bf16x2_t b = __builtin_convertvector(v, bf16x2_t); return __builtin_bit_cast(unsigned, b); }
DI ushort_t f2bf(float x) { return (ushort_t)(pack_bf16(x, 0.f) & 0xffffu); }
DI float bf_lo(unsigned u) { return __uint_as_float(u << 16); }
DI float bf_hi(unsigned u) { return __uint_as_float(u & 0xffff0000u); }
DI float wave_sum(float v) { for (int o = 32; o; o >>= 1) v += __shfl_xor(v, o); return v; }
DI float sigmoidf_(float x) { return 1.f / (1.f + __expf(-x)); }
DI float gelu_tanh(float x) { return 0.5f * x * (1.f + tanhf(0.7978845608028654f * (x + 0.044715f * x * x * x))); }
DI int crow(int reg, int h) { return (reg & 3) + 8 * (reg >> 2) + 4 * h; }
DI int cvidx(int t) { return t < NCTX ? 0 : 1 + ((t - NCTX) >> 10); }
DI int kvrow_of_token(int t) { if (t < NCTX) return t; int tl = t - NCTX; return NCTX + (tl >> 10) * 1536 + 512 + (tl & 1023); }
DI const float* xrow_in(const Params& p, int l, int t) {
  if (l == 0) return t < NCTX ? p.x_prompt + (size_t)t * DM : p.x_sample + (size_t)(t - NCTX) * DM;
  return p.xA + (size_t)t * DM;
}
DI float dot2bf(unsigned a, unsigned b, float acc) { return __builtin_amdgcn_fdot2_f32_bf16(__builtin_bit_cast(bf16x2_t, a), __builtin_bit_cast(bf16x2_t, b), acc, false); }
DI int opaque(int x) { asm volatile("" : "+v"(x)); return x; }
DI float rdlane_f(float v, int l) { return __int_as_float(__builtin_amdgcn_readlane(__float_as_int(v), l)); }

#define GLD 72
template <class Epi>
DI void gemm_tile(const ushort_t* A, int lda, const ushort_t* Bt, int ldb, int K, int N, int m0, int n0, char* smem, Epi epi) {
  ushort_t* sA = (ushort_t*)smem;
  ushort_t* sB = sA + 128 * GLD;
  const int tid = opaque(threadIdx.x), wave = tid >> 6, lane = tid & 63, wm = wave & 1, wn = wave >> 1;
  const int r = lane & 31, h = lane >> 5;
  f32x16 acc[2][2];
#pragma unroll
  for (int i = 0; i < 2; i++)
#pragma unroll
    for (int j = 0; j < 2; j++)
#pragma unroll
      for (int e = 0; e < 16; e++) acc[i][j][e] = 0.f;
  u32x4 ra0[4], rb0[4], ra1[4], rb1[4];
  const int lrow = tid >> 3, lkc = (tid & 7) * 8;
  const ushort_t* Ap = A + (size_t)(m0 + lrow) * lda + lkc;
  const ushort_t* Bp[4];
#pragma unroll
  for (int i = 0; i < 4; i++) { int br = n0 + lrow + 32 * i; br = br < N ? br : N - 1; Bp[i] = Bt + (size_t)br * ldb + lkc; }
  auto gload = [&](u32x4* ra, u32x4* rb, int k0) {
#pragma unroll
    for (int i = 0; i < 4; i++) {
      ra[i] = GLD16(Ap + (size_t)(32 * i) * lda + k0);
      rb[i] = GLD16(Bp[i] + k0);
    }
  };
  auto lstore = [&](const u32x4* ra, const u32x4* rb, int buf) {
    ushort_t* dA = sA + buf * (2 * 128 * GLD) + lrow * GLD + lkc;
    ushort_t* dB = sB + buf * (2 * 128 * GLD) + lrow * GLD + lkc;
#pragma unroll
    for (int i = 0; i < 4; i++) { *(u32x4*)(dA + 32 * i * GLD) = ra[i]; *(u32x4*)(dB + 32 * i * GLD) = rb[i]; }
  };
  auto compute = [&](int buf) {
    const ushort_t* cA = sA + buf * (2 * 128 * GLD);
    const ushort_t* cB = sB + buf * (2 * 128 * GLD);
    bf16x8 a[2][2], b[2][2];
#pragma unroll
    for (int i = 0; i < 2; i++) {
      a[0][i] = *(const bf16x8*)(cA + (wm * 64 + i * 32 + r) * GLD + h * 8);
      b[0][i] = *(const bf16x8*)(cB + (wn * 64 + i * 32 + r) * GLD + h * 8);
    }
#pragma unroll
    for (int ks = 0; ks < 4; ks++) {
      if (ks < 3) {
#pragma unroll
        for (int i = 0; i < 2; i++) {
          a[(ks + 1) & 1][i] = *(const bf16x8*)(cA + (wm * 64 + i * 32 + r) * GLD + (ks + 1) * 16 + h * 8);
          b[(ks + 1) & 1][i] = *(const bf16x8*)(cB + (wn * 64 + i * 32 + r) * GLD + (ks + 1) * 16 + h * 8);
        }
      }
#pragma unroll
      for (int i = 0; i < 2; i++)
#pragma unroll
        for (int j = 0; j < 2; j++) acc[i][j] = MFMA32(a[ks & 1][i], b[ks & 1][j], acc[i][j]);
    }
  };
  gload(ra0, rb0, 0);
  gload(ra1, rb1, 64);
  lstore(ra0, rb0, 0);
  __syncthreads();
  const int klast = K - 64;
  gload(ra0, rb0, 128 < K ? 128 : klast);
  for (int k0 = 0; k0 < K; k0 += 128) {
    compute(0);
    lstore(ra1, rb1, 1);
    __syncthreads();
    gload(ra1, rb1, k0 + 192 < K ? k0 + 192 : klast);
    compute(1);
    lstore(ra0, rb0, 0);
    __syncthreads();
    gload(ra0, rb0, k0 + 256 < K ? k0 + 256 : klast);
  }
#pragma unroll
  for (int i = 0; i < 2; i++)
#pragma unroll
    for (int j = 0; j < 2; j++)
#pragma unroll
      for (int e = 0; e < 16; e++) {
        int row = m0 + wm * 64 + i * 32 + crow(e, h);
        int col = n0 + wn * 64 + j * 32 + r;
        if (col < N) epi(row, col, acc[i][j][e]);
      }
  __syncthreads();
}

#define PLD 136
DI void scores_tile(const ushort_t* Kt, float* sc, int mt, int nt, char* smem) {
  ushort_t* sP = (ushort_t*)smem;
  ushort_t* sK2 = sP + 128 * PLD;
  const int tid = opaque(threadIdx.x), wave = tid >> 6, lane = tid & 63, wm = wave & 1, wn = wave >> 1;
  const int r = lane & 31, h = lane >> 5;
#pragma unroll
  for (int i = 0; i < 8; i++) { int c = tid + i * 256; int row = c >> 4, kc = (c & 15) * 8; *(u32x4*)(sK2 + row * PLD + kc) = GLD16(Kt + row * 128 + kc); }
  __syncthreads();
  f32x16 acc[2][2];
#pragma unroll
  for (int i = 0; i < 2; i++)
#pragma unroll
    for (int j = 0; j < 2; j++)
#pragma unroll
      for (int e = 0; e < 16; e++) acc[i][j][e] = 0.f;
#pragma unroll
  for (int ks = 0; ks < 8; ks++) {
    bf16x8 a[2], b[2];
#pragma unroll
    for (int i = 0; i < 2; i++) {
      a[i] = *(const bf16x8*)(sP + (wm * 64 + i * 32 + r) * PLD + ks * 16 + h * 8);
      b[i] = *(const bf16x8*)(sK2 + (wn * 64 + i * 32 + r) * PLD + ks * 16 + h * 8);
    }
#pragma unroll
    for (int i = 0; i < 2; i++)
#pragma unroll
      for (int j = 0; j < 2; j++) acc[i][j] = MFMA32(a[i], b[j], acc[i][j]);
  }
#pragma unroll
  for (int i = 0; i < 2; i++)
#pragma unroll
    for (int j = 0; j < 2; j++)
#pragma unroll
      for (int e = 0; e < 16; e++) {
        int row = mt * 128 + wm * 64 + i * 32 + crow(e, h);
        int col = wn * 64 + j * 32 + r;
        sc[(size_t)row * 2048 + nt * 128 + col] = acc[i][j][e];
      }
  __syncthreads();
}

DI void transpose_item(const float* src, int lds_, ushort_t* dst, int ldd, int kt, int nt, float* tile) {
  int tid = opaque(threadIdx.x); int c = tid & 63, r0 = tid >> 6;
#pragma unroll 4
  for (int i = 0; i < 16; i++) { int r = r0 + 4 * i; tile[r * 65 + c] = src[(size_t)(kt * 64 + r) * lds_ + nt * 64 + c]; }
  __syncthreads();
#pragma unroll 4
  for (int i = 0; i < 16; i++) { int r = r0 + 4 * i; dst[(size_t)(nt * 64 + r) * ldd + kt * 64 + c] = f2bf(tile[c * 65 + r]); }
  __syncthreads();
}

DI void convert_chunk(const float* src, ushort_t* dst, size_t base) {
  int tid = opaque(threadIdx.x);
#pragma unroll
  for (int it = 0; it < 4; it++) {
    size_t e = base + it * 2048 + tid * 8;
    float4 a = *(const float4*)(src + e), b = *(const float4*)(src + e + 4);
    uint4 o; o.x = pack_bf16(a.x, a.y); o.y = pack_bf16(a.z, a.w); o.z = pack_bf16(b.x, b.y); o.w = pack_bf16(b.z, b.w);
    *(uint4*)(dst + e) = o;
  }
}


DI void quant_rows(const float* src, unsigned char* dst, float* scl, size_t row0) {
  int tid = opaque(threadIdx.x); int wave = tid >> 6, lane = tid & 63;
  size_t row = row0 + wave;
  const float* r = src + row * DM;
  float4 v[8]; float am = 0.f;
#pragma unroll
  for (int j = 0; j < 8; j++) { v[j] = *(const float4*)(r + (j * 64 + lane) * 4); am = fmaxf(am, fmaxf(fmaxf(fabsf(v[j].x), fabsf(v[j].y)), fmaxf(fabsf(v[j].z), fabsf(v[j].w)))); }
  for (int o = 32; o; o >>= 1) am = fmaxf(am, __shfl_xor(am, o));
  float sc = am > 0.f ? 224.f / am : 1.f;
  if (lane == 0) scl[row] = am > 0.f ? am * (1.f / 224.f) : 1.f;
#pragma unroll
  for (int j = 0; j < 8; j++) {
    int w = 0;
    w = __builtin_amdgcn_cvt_pk_fp8_f32(v[j].x * sc, v[j].y * sc, w, false);
    w = __builtin_amdgcn_cvt_pk_fp8_f32(v[j].z * sc, v[j].w * sc, w, true);
    *(int*)(dst + row * DM + (j * 64 + lane) * 4) = w;
  }
}

DI void mod_item(const Params& p, int item, char* smem) {
  int l = item / 48, cgp = item % 48;
  float* s = (float*)smem;
  float* red = s + 5 * 2048;
  int tid = opaque(threadIdx.x), wave = tid >> 6, lane = tid & 63;
  for (int i = tid; i < 5 * 2048; i += 256) {
    int cv = i >> 11, k = i & 2047;
    float v = cv == 0 ? p.c_ctx[k] : p.c[(cv - 1) * DM + k];
    s[i] = v * sigmoidf_(v);
  }
  __syncthreads();
  const float* W = p.ada_w + (size_t)l * DM * 12288 + cgp * 256 + lane * 4;
  float4 acc[5];
#pragma unroll
  for (int cv = 0; cv < 5; cv++) acc[cv] = make_float4(0, 0, 0, 0);
  int kb = wave * 512;
#pragma unroll 8
  for (int k = kb; k < kb + 512; k++) {
    float4 w = *(const float4*)(W + (size_t)k * 12288);
#pragma unroll
    for (int cv = 0; cv < 5; cv++) {
      float sv = s[cv * 2048 + k];
      acc[cv].x += sv * w.x; acc[cv].y += sv * w.y; acc[cv].z += sv * w.z; acc[cv].w += sv * w.w;
    }
  }
#pragma unroll
  for (int cv = 0; cv < 5; cv++) *(float4*)(red + (wave * 5 + cv) * 256 + lane * 4) = acc[cv];
  __syncthreads();
  for (int i = tid; i < 5 * 256; i += 256) {
    int cv = i >> 8, col = i & 255;
    float v = red[(0 * 5 + cv) * 256 + col] + red[(1 * 5 + cv) * 256 + col] + red[(2 * 5 + cv) * 256 + col] + red[(3 * 5 + cv) * 256 + col];
    int gc = cgp * 256 + col;
    p.mod[(size_t)(l * 5 + cv) * 12288 + gc] = v + p.ada_b[l * 12288 + gc];
  }
  __syncthreads();
}

#define N_MOD 96
#define N_TR_LAYER 3840
#define N_TR (2 * N_TR_LAYER)
#define N_CV_KEYS 64
#define N_CV_U 8192
#define N_PREP (N_MOD + N_TR + N_CV_KEYS + 2 * N_CV_U + 1)

DI void prep_phase(const Params& p, char* smem) {
  for (int it = blockIdx.x; it < N_PREP; it += gridDim.x) {
    if (it < N_MOD) { mod_item(p, it, smem); continue; }
    int i = it - N_MOD;
    if (i < N_TR) {
      int l = i / N_TR_LAYER, j = i % N_TR_LAYER;
      float* tile = (float*)smem;
      if (j < 1440) { transpose_item(p.w_in + (size_t)l * DM * INW, INW, p.WinT + (size_t)l * INW * DM, DM, j / 45, j % 45, tile); continue; }
      j -= 1440;
      if (j < 192) { transpose_item(p.mla_w_qb + (size_t)l * 512 * 1536, 1536, p.WqbT + (size_t)l * 1536 * 512, 512, j / 24, j % 24, tile); continue; }
      j -= 192;
      if (j < 128) { transpose_item(p.mla_w_kvb + (size_t)l * 256 * 2048, 2048, p.WkvbT + (size_t)l * 2048 * 256, 256, j / 32, j % 32, tile); continue; }
      j -= 128;
      if (j < 1024) { transpose_item(p.w_out + (size_t)l * DM * DM, DM, p.WoutT + (size_t)l * DM * DM, DM, j / 32, j % 32, tile); continue; }
      j -= 1024;
      if (j < 1024) { transpose_item(p.peer_w_q + (size_t)l * DM * DM, DM, p.WpqT + (size_t)l * DM * DM, DM, j / 32, j % 32, tile); continue; }
      j -= 1024;
      {
        int mat = j >> 4, dh = j & 15;
        const float* src = (mat ? p.lru_w_i : p.lru_w_a) + (size_t)(l * 16 + dh) * 4096;
        ushort_t* dst = p.LruW + ((size_t)(l * 16 + dh) * 2 + mat) * 4096;
        transpose_item(src, 64, dst, 64, 0, 0, tile);
      }
      continue;
    }
    i -= N_TR;
    if (i < N_CV_KEYS) { convert_chunk(p.peer_keys, p.KeysB, (size_t)i * 8192); continue; }
    i -= N_CV_KEYS;
    if (i < N_CV_U) { quant_rows(p.peer_u, p.Ub, p.Us, (size_t)i * 4); continue; }
    i -= N_CV_U;
    if (i < N_CV_U) { quant_rows(p.peer_v, p.Vb, p.Vs, (size_t)i * 4); continue; }
    for (int e = threadIdx.x; e < 1024 * 32; e += 256) {
      int pos = e >> 5, f = e & 31;
      int fi = f & 15;
      float inv = 1.0f / powf(10000.0f, (float)fi / 16.0f);
      float base = (f < 16) ? (float)(pos >> 6) : (float)(pos & 63);
      float ang = base * inv;
      float sn, cs; sincosf(ang, &sn, &cs);
      p.rope[pos * 64 + f] = cs; p.rope[pos * 64 + 32 + f] = sn;
    }
  }
}

DI void norm_phase(const Params& p, int l, int which) {
  int tidq = opaque(threadIdx.x); int lane = tidq & 63, gw = blockIdx.x * 4 + (tidq >> 6), nw = gridDim.x * 4;
  const float* g = (which ? p.norm_ffn_g : p.norm_mix_g) + l * DM;
  int sh_off = which ? 6144 : 0, sc_off = which ? 8192 : 2048;
  for (int t = gw; t < NTOK; t += nw) {
    const float* xr = which ? p.x1 + (size_t)t * DM : xrow_in(p, l, t);
    const float* md = p.mod + (size_t)(l * 5 + cvidx(t)) * 12288;
    float4 v[8]; float ss = 0.f;
#pragma unroll
    for (int j = 0; j < 8; j++) { v[j] = *(const float4*)(xr + j * 256 + lane * 4); ss += v[j].x * v[j].x + v[j].y * v[j].y + v[j].z * v[j].z + v[j].w * v[j].w; }
    ss = wave_sum(ss);
    float rinv = rsqrtf(ss * (1.f / DM) + 1e-6f);
#pragma unroll
    for (int j = 0; j < 8; j++) {
      int col = j * 256 + lane * 4;
      float4 gg = *(const float4*)(g + col), sc = *(const float4*)(md + sc_off + col), sh = *(const float4*)(md + sh_off + col);
      float y0 = v[j].x * rinv * gg.x * (1.f + sc.x) + sh.x;
      float y1 = v[j].y * rinv * gg.y * (1.f + sc.y) + sh.y;
      float y2 = v[j].z * rinv * gg.z * (1.f + sc.z) + sh.z;
      float y3 = v[j].w * rinv * gg.w * (1.f + sc.w) + sh.w;
      uint2 o; o.x = pack_bf16(y0, y1); o.y = pack_bf16(y2, y3);
      *(uint2*)(p.hn + (size_t)t * DM + col) = o;
    }
  }
}

DI void lru_item(const Params& p, int l, int item, char* smem) {
  int ch = item >> 4, hd = (item >> 1) & 7, d = item & 1;
  int t0 = ch * 256, seq_t0, T, p0;
  if (ch < 16) { seq_t0 = ch * 256; T = 256; p0 = 0; }
  else { int b = (ch - 16) >> 2, cc = (ch - 16) & 3; seq_t0 = NCTX + b * 1024; T = 1024; p0 = cc * 256; }
  ushort_t* sBt = (ushort_t*)smem;
  ushort_t* sA = sBt + 128 * GLD;
  float* sXc = (float*)(sA + 64 * GLD);
  float* sG = sXc + 64 * 64;
  const int tid = opaque(threadIdx.x), wave = tid >> 6, lane = tid & 63;
  const int c = tid & 63, tg = tid >> 6;
  const ushort_t* Bt = p.LruW + ((size_t)((l * 2 + d) * 8 + hd) * 2) * 4096;
#pragma unroll
  for (int i = 0; i < 4; i++) { int cidx = tid + i * 256; int row = cidx >> 3, kc = (cidx & 7) * 8; *(uint4*)(sBt + row * GLD + kc) = *(const uint4*)(Bt + row * 64 + kc); }
  const int chn = hd * 64 + c;
  float cw[4];
#pragma unroll
  for (int j = 0; j < 4; j++) cw[j] = p.lru_conv_w[(l * 4 + j) * 512 + chn];
  const float cb = p.lru_conv_b[l * 512 + chn];
  const float ba = p.lru_b_a[(l * 2 + d) * 512 + chn], bi = p.lru_b_i[(l * 2 + d) * 512 + chn];
  const float lam = p.lru_lam[(l * 2 + d) * 512 + chn];
  const float sp = log1pf(expf(-lam));
  float hst = 0.f, Pp = 1.f;
  const int r = lane & 31, h8 = lane >> 5;
  for (int si = 0; si < 4; si++) {
    int sub = d ? 3 - si : si;
#pragma unroll 4
    for (int i = 0; i < 16; i++) {
      int lt = tg * 16 + i; int pos = p0 + sub * 64 + lt;
      float xc = cb;
#pragma unroll
      for (int j = 0; j < 4; j++) {
        int q = pos - 2 + j;
        float zv = (q >= 0 && q < T) ? p.z[(size_t)(seq_t0 + q) * INW + OFF_ZX + chn] : 0.f;
        xc += cw[j] * zv;
      }
      sXc[lt * 64 + c] = xc; sA[lt * GLD + c] = f2bf(xc);
    }
    __syncthreads();
    {
      int mt = wave & 1, nh = wave >> 1;
      f32x16 acc[2];
#pragma unroll
      for (int i = 0; i < 2; i++)
#pragma unroll
        for (int e = 0; e < 16; e++) acc[i][e] = 0.f;
#pragma unroll
      for (int ks = 0; ks < 4; ks++) {
        bf16x8 a = *(const bf16x8*)(sA + (mt * 32 + r) * GLD + ks * 16 + h8 * 8);
#pragma unroll
        for (int ni = 0; ni < 2; ni++) {
          bf16x8 b = *(const bf16x8*)(sBt + (nh * 64 + ni * 32 + r) * GLD + ks * 16 + h8 * 8);
          acc[ni] = MFMA32(a, b, acc[ni]);
        }
      }
#pragma unroll
      for (int ni = 0; ni < 2; ni++)
#pragma unroll
        for (int e = 0; e < 16; e++) sG[(mt * 32 + crow(e, h8)) * 132 + nh * 64 + ni * 32 + r] = acc[ni][e];
    }
    __syncthreads();
#pragma unroll 4
    for (int i = 0; i < 16; i++) {
      int lt = tg * 16 + i;
      float ga = sG[lt * 132 + c] + ba, gi = sG[lt * 132 + 64 + c] + bi;
      float rr = 1.f / (1.f + expf(-ga)), ii = 1.f / (1.f + expf(-gi));
      float la = -8.0f * rr * sp;
      float a = expf(la);
      float u = sqrtf(-expm1f(2.f * la)) * ii * sXc[lt * 64 + c];
      sG[lt * 132 + c] = a; sG[lt * 132 + 64 + c] = u;
    }
    __syncthreads();
    if (tid < 64) {
      for (int s = 0; s < 64; s++) {
        int lt = d ? 63 - s : s;
        float a = sG[lt * 132 + c], u = sG[lt * 132 + 64 + c];
        hst = a * hst + u; Pp *= a;
        size_t o = ((size_t)d * NTOK + t0 + sub * 64 + lt) * 512 + chn;
        p.hs[o] = f2bf(hst); p.Pc[o] = f2bf(Pp);
      }
    }
    __syncthreads();
  }
  if (tid < 64) {
    p.hend[(d * 32 + ch) * 512 + chn] = hst; p.Pend[(d * 32 + ch) * 512 + chn] = Pp;
    if (ch < 16) p.out[(size_t)NTOK * DM + 16 * 2 * 256 * 256 + 16 * 2 * 256 * 64 + ((ch * 2 + l) * 2 + d) * 512 + chn] = hst;
  }
}

#define CMT 16
DI void cm_item(const Params& p, int l, int item, char* smem) {
  int t0 = item * CMT, seq_t0, T;
  if (t0 < NCTX) { seq_t0 = (t0 >> 8) << 8; T = 256; } else { seq_t0 = NCTX + (((t0 - NCTX) >> 10) << 10); T = 1024; }
  int p0 = t0 - seq_t0;
  unsigned* sGlu = (unsigned*)smem;
  float* red = (float*)(sGlu + (CMT + 30) * 256);
  float* red2 = red + 256;
  const int tid = opaque(threadIdx.x), wave = tid >> 6, lane = tid & 63;
#pragma unroll 8
  for (int rr = 0; rr < CMT + 30; rr++) {
    int pos = p0 - 15 + rr;
    unsigned v = 0;
    if (pos >= 0 && pos < T) {
      const float* zr = p.z + (size_t)(seq_t0 + pos) * INW + OFF_ZC;
      float2 a = *(const float2*)(zr + 2 * tid), b = *(const float2*)(zr + 512 + 2 * tid);
      v = pack_bf16(a.x * sigmoidf_(b.x), a.y * sigmoidf_(b.y));
    }
    sGlu[rr * 256 + tid] = v;
  }
  __syncthreads();
  float acc0[CMT], acc1[CMT];
  {
    float2 bb = *(const float2*)(p.cm_dw_b + l * 512 + 2 * tid);
#pragma unroll
    for (int t = 0; t < CMT; t++) { acc0[t] = bb.x; acc1[t] = bb.y; }
  }
  for (int j = 0; j < 31; j++) {
    float2 w = *(const float2*)(p.cm_dw_w + (size_t)(l * 31 + j) * 512 + 2 * tid);
#pragma unroll
    for (int t = 0; t < CMT; t++) { unsigned u = sGlu[(t + j) * 256 + tid]; acc0[t] += w.x * bf_lo(u); acc1[t] += w.y * bf_hi(u); }
  }
  {
    float ks = 0.f, kss = 0.f;
#pragma unroll
    for (int t = 0; t < CMT; t++) {
      float s = wave_sum(acc0[t] + acc1[t]);
      float ss = wave_sum(acc0[t] * acc0[t] + acc1[t] * acc1[t]);
      if (lane == t) { ks = s; kss = ss; }
    }
    if (lane < CMT) { red[(wave * CMT + lane) * 2] = ks; red[(wave * CMT + lane) * 2 + 1] = kss; }
  }
  __syncthreads();
  {
    float2 lg = *(const float2*)(p.cm_ln_g + l * 512 + 2 * tid), lb = *(const float2*)(p.cm_ln_b + l * 512 + 2 * tid);
    float k2 = 0.f;
#pragma unroll
    for (int t = 0; t < CMT; t++) {
      float s = red[(0 * CMT + t) * 2] + red[(1 * CMT + t) * 2] + red[(2 * CMT + t) * 2] + red[(3 * CMT + t) * 2];
      float ss = red[(0 * CMT + t) * 2 + 1] + red[(1 * CMT + t) * 2 + 1] + red[(2 * CMT + t) * 2 + 1] + red[(3 * CMT + t) * 2 + 1];
      float mu = s * (1.f / 512.f); float var = ss * (1.f / 512.f) - mu * mu; float rstd = rsqrtf(var + 1e-5f);
      float y0 = (acc0[t] - mu) * rstd * lg.x + lb.x, y1 = (acc1[t] - mu) * rstd * lg.y + lb.y;
      y0 = y0 * sigmoidf_(y0); y1 = y1 * sigmoidf_(y1);
      acc0[t] = y0; acc1[t] = y1;
      float s2 = wave_sum(y0 * y0 + y1 * y1);
      if (lane == t) k2 = s2;
    }
    if (lane < CMT) red2[wave * CMT + lane] = k2;
  }
  __syncthreads();
  {
    float2 gg = *(const float2*)(p.grp_g + l * DM + 1536 + 2 * tid);
#pragma unroll
    for (int t = 0; t < CMT; t++) {
      float tot = red2[t] + red2[CMT + t] + red2[2 * CMT + t] + red2[3 * CMT + t];
      float rinv = rsqrtf(tot * (1.f / 512.f) + 1e-6f);
      *(unsigned*)(p.mixed + (size_t)(t0 + t) * DM + 1536 + 2 * tid) = pack_bf16(acc0[t] * rinv * gg.x, acc1[t] * rinv * gg.y);
    }
  }
  __syncthreads();
}

DI void post_inproj_tokens(const Params& p, int l) {
  int tidq = opaque(threadIdx.x); int lane = tidq & 63, gw = blockIdx.x * 4 + (tidq >> 6), nw = gridDim.x * 4;
  float* new_ckv = p.out + (size_t)NTOK * DM;
  float* new_krope = new_ckv + 16 * 2 * 256 * 256;
  for (int t = gw; t < NTOK + 2048; t += nw) {
    if (t >= NTOK) {
      int rr = t - NTOK; int b = rr >> 9, j = rr & 511;
      float4 v = *(const float4*)(p.cache_ckv + ((size_t)(b * 2 + l) * 512 + j) * 256 + lane * 4);
      uint2 o; o.x = pack_bf16(v.x, v.y); o.y = pack_bf16(v.z, v.w);
      *(uint2*)(p.ckv + (size_t)(NCTX + b * 1536 + j) * 256 + lane * 4) = o;
      continue;
    }
    const float* zr = p.z + (size_t)t * INW;
    {
      float4 a = *(const float4*)(zr + lane * 4), b = *(const float4*)(zr + 256 + lane * 4);
      float ss = a.x * a.x + a.y * a.y + a.z * a.z + a.w * a.w + b.x * b.x + b.y * b.y + b.z * b.z + b.w * b.w;
      ss = wave_sum(ss);
      float rinv = rsqrtf(ss * (1.f / 512.f) + 1e-6f);
      float4 g0 = *(const float4*)(p.mla_qa_g + l * 512 + lane * 4), g1 = *(const float4*)(p.mla_qa_g + l * 512 + 256 + lane * 4);
      uint2 o0, o1;
      o0.x = pack_bf16(a.x * rinv * g0.x, a.y * rinv * g0.y); o0.y = pack_bf16(a.z * rinv * g0.z, a.w * rinv * g0.w);
      o1.x = pack_bf16(b.x * rinv * g1.x, b.y * rinv * g1.y); o1.y = pack_bf16(b.z * rinv * g1.z, b.w * rinv * g1.w);
      *(uint2*)(p.qa + (size_t)t * 512 + lane * 4) = o0;
      *(uint2*)(p.qa + (size_t)t * 512 + 256 + lane * 4) = o1;
    }
    {
      float4 a = *(const float4*)(zr + OFF_ZKV + lane * 4);
      float ss = wave_sum(a.x * a.x + a.y * a.y + a.z * a.z + a.w * a.w);
      float rinv = rsqrtf(ss * (1.f / 256.f) + 1e-6f);
      float4 g = *(const float4*)(p.mla_kva_g + l * 256 + lane * 4);
      float4 o = make_float4(a.x * rinv * g.x, a.y * rinv * g.y, a.z * rinv * g.z, a.w * rinv * g.w);
      uint2 ob; ob.x = pack_bf16(o.x, o.y); ob.y = pack_bf16(o.z, o.w);
      *(uint2*)(p.ckv + (size_t)kvrow_of_token(t) * 256 + lane * 4) = ob;
      if (t < NCTX) {
        int b = t >> 8, pos = t & 255;
        *(float4*)(new_ckv + ((size_t)(b * 2 + l) * 256 + pos) * 256 + lane * 4) = o;
        new_krope[((size_t)(b * 2 + l) * 256 + pos) * 64 + lane] = zr[OFF_ZKR + lane];
      }
    }
  }
}

DI void qnorm_tokens(const Params& p, int l) {
  int tidq = opaque(threadIdx.x); int lane = tidq & 63, gw = blockIdx.x * 4 + (tidq >> 6), nw = gridDim.x * 4;
  const float qscale = 0.07216878364870322f * 1.4426950408889634f;
  const float* g = p.mla_q_g + l * 192;
  float g0 = g[lane], g1 = g[64 + lane], g2 = g[128 + lane];
  for (int t = gw; t < NTOK; t += nw) {
    const ushort_t* qr = p.qraw + (size_t)t * 1536;
    bool lat = t >= NCTX; int pos = (t - NCTX) & 1023;
    float cs = 1.f, sn = 0.f;
    if (lat) { cs = p.rope[pos * 64 + (lane & 31)]; sn = p.rope[pos * 64 + 32 + (lane & 31)]; }
#pragma unroll
    for (int hh = 0; hh < 8; hh++) {
      float a = __uint_as_float((unsigned)qr[hh * 192 + lane] << 16), b = __uint_as_float((unsigned)qr[hh * 192 + 64 + lane] << 16), c = __uint_as_float((unsigned)qr[hh * 192 + 128 + lane] << 16);
      float ss = wave_sum(a * a + b * b + c * c);
      float rinv = rsqrtf(ss * (1.f / 192.f) + 1e-6f);
      a *= rinv * g0; b *= rinv * g1; c *= rinv * g2;
      if (lat) {
        float o = __shfl_xor(c, 32);
        c = (lane < 32) ? (c * cs - o * sn) : (o * sn + c * cs);
      }
      ushort_t* qo = p.Q + (size_t)t * 1536 + hh * 192;
      qo[lane] = f2bf(a * qscale); qo[64 + lane] = f2bf(b * qscale); qo[128 + lane] = f2bf(c * qscale);
    }
  }
}

DI void kv_item(const Params& p, int l, int item, char* smem) {
  int rt = item >> 3, hh = item & 7;
  int row0 = rt * 64;
  const int tid = opaque(threadIdx.x), wave = tid >> 6, lane = tid & 63;
  float* tile = (float*)smem;
  const float* g = p.mla_k_g + l * 192;
  float g0 = g[lane], g1 = g[64 + lane], g2 = g[128 + lane];
#pragma unroll 4
  for (int i = 0; i < 16; i++) {
    int lr = wave * 16 + i; int row = row0 + lr;
    const float* kr_src; bool rot = false; int pos = 0;
    if (row < NCTX) { kr_src = p.z + (size_t)row * INW + OFF_ZKR; }
    else {
      int rr = row - NCTX; int b = rr / 1536, j = rr % 1536;
      if (j < 512) kr_src = p.cache_krope + ((size_t)(b * 2 + l) * 512 + j) * 64;
      else { pos = j - 512; kr_src = p.z + (size_t)(NCTX + b * 1024 + pos) * INW + OFF_ZKR; rot = true; }
    }
    const ushort_t* kv = p.kvraw + (size_t)row * 2048 + hh * 256;
    float a = __uint_as_float((unsigned)kv[lane] << 16), b2 = __uint_as_float((unsigned)kv[64 + lane] << 16), c = kr_src[lane];
    float ss = wave_sum(a * a + b2 * b2 + c * c);
    float rinv = rsqrtf(ss * (1.f / 192.f) + 1e-6f);
    a *= rinv * g0; b2 *= rinv * g1; c *= rinv * g2;
    if (rot) {
      float cs = p.rope[pos * 64 + (lane & 31)], sn = p.rope[pos * 64 + 32 + (lane & 31)];
      float o = __shfl_xor(c, 32);
      c = (lane < 32) ? (c * cs - o * sn) : (o * sn + c * cs);
    }
    ushort_t* ko = p.K + (size_t)row * 1536 + hh * 192;
    ko[lane] = f2bf(a); ko[64 + lane] = f2bf(b2); ko[128 + lane] = f2bf(c);
    tile[lr * 129 + lane] = __uint_as_float((unsigned)kv[128 + lane] << 16); tile[lr * 129 + 64 + lane] = __uint_as_float((unsigned)kv[192 + lane] << 16);
  }
  __syncthreads();
  size_t vbase; int T, krow0;
  if (row0 < NCTX) { int sid = row0 >> 8; vbase = (size_t)(sid * 8 + hh) * 128 * 256; T = 256; krow0 = row0 & 255; }
  else { int rr = row0 - NCTX; int b = rr / 1536; vbase = (size_t)16 * 8 * 128 * 256 + (size_t)(b * 8 + hh) * 128 * 1536; T = 1536; krow0 = rr % 1536; }
#pragma unroll
  for (int i = 0; i < 4; i++) {
    int cidx = tid + i * 256; int dv = cidx >> 3, kg = cidx & 7;
    int G = kg >> 1, hhalf = kg & 1;
    float v[8];
#pragma unroll
    for (int s = 0; s < 8; s++) { int key = 16 * G + 8 * (s >> 2) + 4 * hhalf + (s & 3); v[s] = tile[key * 129 + dv]; }
    uint4 o; o.x = pack_bf16(v[0], v[1]); o.y = pack_bf16(v[2], v[3]); o.z = pack_bf16(v[4], v[5]); o.w = pack_bf16(v[6], v[7]);
    *(uint4*)(p.Vt + vbase + (size_t)dv * T + krow0 + kg * 8) = o;
  }
  __syncthreads();
}

#define KLD 200
#define VLD 72
DI void attn_item(const Params& p, int item, char* smem) {
  const int tid = opaque(threadIdx.x), wave = tid >> 6, lane = tid & 63;
  const int qs = wave & 1, kh = wave >> 1;
  int hh, Tk, tq0, kvbase; size_t vbase;
  if (item < 512) {
    int b = item >> 7; hh = (item >> 4) & 7; int qb = item & 15;
    Tk = 1536; tq0 = NCTX + b * 1024 + qb * 64; kvbase = NCTX + b * 1536;
    vbase = (size_t)16 * 8 * 128 * 256 + (size_t)(b * 8 + hh) * 128 * 1536;
  } else {
    int i2 = item - 512; int s = i2 >> 5; hh = (i2 >> 2) & 7; int qb = i2 & 3;
    Tk = 256; tq0 = s * 256 + qb * 64; kvbase = s * 256;
    vbase = (size_t)(s * 8 + hh) * 128 * 256;
  }
  ushort_t* sK = (ushort_t*)smem;
  ushort_t* sV = sK + 64 * KLD;
  const int r = lane & 31, h = lane >> 5;
  bf16x8 qf[12];
  {
    const ushort_t* qp = p.Q + (size_t)(tq0 + qs * 32 + r) * 1536 + hh * 192 + h * 8;
#pragma unroll
    for (int s = 0; s < 12; s++) qf[s] = *(const bf16x8*)(qp + s * 16);
  }
  f32x16 O[4];
#pragma unroll
  for (int i = 0; i < 4; i++)
#pragma unroll
    for (int e = 0; e < 16; e++) O[i][e] = 0.f;
  float m = -INFINITY, lsum = 0.f;
  const int nkt = Tk >> 6;
  const ushort_t* Kg = p.K + (size_t)kvbase * 1536 + hh * 192;
  const ushort_t* Vg = p.Vt + vbase;
  u32x4 rk[6], rv[4];
#pragma unroll
  for (int i = 0; i < 6; i++) { int c = tid + i * 256; int row = c / 24, kc = (c % 24) * 8; rk[i] = GLD16(Kg + (size_t)row * 1536 + kc); }
#pragma unroll
  for (int i = 0; i < 4; i++) { int c = tid + i * 256; int dv = c >> 3, kc = (c & 7) * 8; rv[i] = GLD16(Vg + (size_t)dv * Tk + kc); }
  for (int kt = 0; kt < nkt; kt++) {
    __syncthreads();
#pragma unroll
    for (int i = 0; i < 6; i++) { int c = tid + i * 256; int row = c / 24, kc = (c % 24) * 8; *(u32x4*)(sK + row * KLD + kc) = rk[i]; }
#pragma unroll
    for (int i = 0; i < 4; i++) { int c = tid + i * 256; int dv = c >> 3, kc = (c & 7) * 8; *(u32x4*)(sV + dv * VLD + kc) = rv[i]; }
    __syncthreads();
    if (kt + 1 < nkt) {
#pragma unroll
      for (int i = 0; i < 6; i++) { int c = tid + i * 256; int row = c / 24, kc = (c % 24) * 8; rk[i] = GLD16(Kg + (size_t)((kt + 1) * 64 + row) * 1536 + kc); }
#pragma unroll
      for (int i = 0; i < 4; i++) { int c = tid + i * 256; int dv = c >> 3, kc = (c & 7) * 8; rv[i] = GLD16(Vg + (size_t)dv * Tk + (kt + 1) * 64 + kc); }
    }
    f32x16 S;
#pragma unroll
    for (int e = 0; e < 16; e++) S[e] = 0.f;
    const ushort_t* kp = sK + (kh * 32 + r) * KLD + h * 8;
#pragma unroll
    for (int s = 0; s < 12; s++) { bf16x8 kf = *(const bf16x8*)(kp + s * 16); S = MFMA32(kf, qf[s], S); }
    float mx = S[0];
#pragma unroll
    for (int e = 1; e < 16; e++) mx = fmaxf(mx, S[e]);
    mx = fmaxf(mx, __shfl_xor(mx, 32));
    float mn = fmaxf(m, mx);
    float alpha = exp2f(m - mn);
    float rs = 0.f;
#pragma unroll
    for (int e = 0; e < 16; e++) { S[e] = exp2f(S[e] - mn); rs += S[e]; }
    rs += __shfl_xor(rs, 32);
    lsum = lsum * alpha + rs; m = mn;
#pragma unroll
    for (int i = 0; i < 4; i++)
#pragma unroll
      for (int e = 0; e < 16; e++) O[i][e] *= alpha;
    bf16x8 pf[2];
#pragma unroll
    for (int s2 = 0; s2 < 2; s2++) {
      u32x4 u; u.x = pack_bf16(S[8 * s2], S[8 * s2 + 1]); u.y = pack_bf16(S[8 * s2 + 2], S[8 * s2 + 3]);
      u.z = pack_bf16(S[8 * s2 + 4], S[8 * s2 + 5]); u.w = pack_bf16(S[8 * s2 + 6], S[8 * s2 + 7]);
      pf[s2] = __builtin_bit_cast(bf16x8, u);
    }
    const ushort_t* vp = sV + r * VLD + kh * 32 + h * 8;
#pragma unroll
    for (int dt = 0; dt < 4; dt++)
#pragma unroll
      for (int s2 = 0; s2 < 2; s2++) {
        bf16x8 vf = *(const bf16x8*)(vp + dt * 32 * VLD + s2 * 16);
        O[dt] = MFMA32(vf, pf[s2], O[dt]);
      }
  }
  __syncthreads();
  float* cO = (float*)smem;
  float* cML = cO + 2 * 64 * 64;
  if (kh == 1) {
#pragma unroll
    for (int dt = 0; dt < 4; dt++)
#pragma unroll
      for (int e = 0; e < 16; e++) cO[(qs * 64 + dt * 16 + e) * 64 + lane] = O[dt][e];
    cML[(qs * 2 + 0) * 64 + lane] = m; cML[(qs * 2 + 1) * 64 + lane] = lsum;
  }
  __syncthreads();
  if (kh == 0) {
    float m1 = cML[(qs * 2 + 0) * 64 + lane], l1 = cML[(qs * 2 + 1) * 64 + lane];
    float mf = fmaxf(m, m1);
    float a0 = exp2f(m - mf), a1 = exp2f(m1 - mf);
    float inv = 1.f / (lsum * a0 + l1 * a1);
    a0 *= inv; a1 *= inv;
    ushort_t* op = p.attn + (size_t)(tq0 + qs * 32 + r) * 1024 + hh * 128;
#pragma unroll
    for (int dt = 0; dt < 4; dt++)
#pragma unroll
      for (int gq = 0; gq < 4; gq++) {
        float o0 = O[dt][4 * gq] * a0 + cO[(qs * 64 + dt * 16 + 4 * gq) * 64 + lane] * a1;
        float o1 = O[dt][4 * gq + 1] * a0 + cO[(qs * 64 + dt * 16 + 4 * gq + 1) * 64 + lane] * a1;
        float o2 = O[dt][4 * gq + 2] * a0 + cO[(qs * 64 + dt * 16 + 4 * gq + 2) * 64 + lane] * a1;
        float o3 = O[dt][4 * gq + 3] * a0 + cO[(qs * 64 + dt * 16 + 4 * gq + 3) * 64 + lane] * a1;
        uint2 ov; ov.x = pack_bf16(o0, o1); ov.y = pack_bf16(o2, o3); *(uint2*)(op + dt * 32 + 8 * gq + 4 * h) = ov;
      }
  }
  __syncthreads();
}

DI void merge_tokens(const Params& p, int l) {
  int tidq = opaque(threadIdx.x); int lane = tidq & 63, gw = blockIdx.x * 4 + (tidq >> 6), nw = gridDim.x * 4;
  const float* gg = p.grp_g + l * DM;
  for (int t = gw; t < NTOK; t += nw) {
    {
      const ushort_t* ar = p.attn + (size_t)t * 1024;
      float4 v[4]; float ss = 0.f;
#pragma unroll
      for (int j = 0; j < 4; j++) { uint2 u_ = *(const uint2*)(ar + j * 256 + lane * 4); v[j] = make_float4(bf_lo(u_.x), bf_hi(u_.x), bf_lo(u_.y), bf_hi(u_.y)); ss += v[j].x * v[j].x + v[j].y * v[j].y + v[j].z * v[j].z + v[j].w * v[j].w; }
      ss = wave_sum(ss);
      float rinv = rsqrtf(ss * (1.f / 1024.f) + 1e-6f);
#pragma unroll
      for (int j = 0; j < 4; j++) {
        int col = j * 256 + lane * 4; float4 g = *(const float4*)(gg + col);
        uint2 o; o.x = pack_bf16(v[j].x * rinv * g.x, v[j].y * rinv * g.y); o.y = pack_bf16(v[j].z * rinv * g.z, v[j].w * rinv * g.w);
        *(uint2*)(p.mixed + (size_t)t * DM + col) = o;
      }
    }
    {
      float val[8]; float ss = 0.f;
      int ch = t >> 8;
#pragma unroll
      for (int j = 0; j < 2; j++) {
        int col = j * 256 + lane * 4;
        float cf[4] = {0, 0, 0, 0}, cbk[4] = {0, 0, 0, 0};
        if (t >= NCTX) {
          int b = (t - NCTX) >> 10, cc = (ch - 16) & 3, chb = 16 + b * 4;
          float4 h0f = *(const float4*)(p.state_lru + ((size_t)(b * 2 + l) * 2 + 0) * 512 + col);
          float4 h0b = *(const float4*)(p.state_lru + ((size_t)(b * 2 + l) * 2 + 1) * 512 + col);
          cf[0] = h0f.x; cf[1] = h0f.y; cf[2] = h0f.z; cf[3] = h0f.w;
          cbk[0] = h0b.x; cbk[1] = h0b.y; cbk[2] = h0b.z; cbk[3] = h0b.w;
          for (int jj = 0; jj < cc; jj++) {
            float4 he = *(const float4*)(p.hend + (size_t)(0 * 32 + chb + jj) * 512 + col), pe = *(const float4*)(p.Pend + (size_t)(0 * 32 + chb + jj) * 512 + col);
            cf[0] = he.x + pe.x * cf[0]; cf[1] = he.y + pe.y * cf[1]; cf[2] = he.z + pe.z * cf[2]; cf[3] = he.w + pe.w * cf[3];
          }
          for (int jj = 3; jj > cc; jj--) {
            float4 he = *(const float4*)(p.hend + (size_t)(1 * 32 + chb + jj) * 512 + col), pe = *(const float4*)(p.Pend + (size_t)(1 * 32 + chb + jj) * 512 + col);
            cbk[0] = he.x + pe.x * cbk[0]; cbk[1] = he.y + pe.y * cbk[1]; cbk[2] = he.z + pe.z * cbk[2]; cbk[3] = he.w + pe.w * cbk[3];
          }
        }
        uint2 uhf = *(const uint2*)(p.hs + ((size_t)0 * NTOK + t) * 512 + col), upf = *(const uint2*)(p.Pc + ((size_t)0 * NTOK + t) * 512 + col);
        uint2 uhb = *(const uint2*)(p.hs + ((size_t)1 * NTOK + t) * 512 + col), upb = *(const uint2*)(p.Pc + ((size_t)1 * NTOK + t) * 512 + col);
        float4 hf_ = make_float4(bf_lo(uhf.x), bf_hi(uhf.x), bf_lo(uhf.y), bf_hi(uhf.y)), pf_ = make_float4(bf_lo(upf.x), bf_hi(upf.x), bf_lo(upf.y), bf_hi(upf.y));
        float4 hb_ = make_float4(bf_lo(uhb.x), bf_hi(uhb.x), bf_lo(uhb.y), bf_hi(uhb.y)), pb_ = make_float4(bf_lo(upb.x), bf_hi(upb.x), bf_lo(upb.y), bf_hi(upb.y));
        float4 zg = *(const float4*)(p.z + (size_t)t * INW + OFF_ZG + col);
        float y0 = hf_.x + pf_.x * cf[0] + hb_.x + pb_.x * cbk[0];
        float y1 = hf_.y + pf_.y * cf[1] + hb_.y + pb_.y * cbk[1];
        float y2 = hf_.z + pf_.z * cf[2] + hb_.z + pb_.z * cbk[2];
        float y3 = hf_.w + pf_.w * cf[3] + hb_.w + pb_.w * cbk[3];
        y0 *= gelu_tanh(zg.x); y1 *= gelu_tanh(zg.y); y2 *= gelu_tanh(zg.z); y3 *= gelu_tanh(zg.w);
        val[j * 4] = y0; val[j * 4 + 1] = y1; val[j * 4 + 2] = y2; val[j * 4 + 3] = y3;
        ss += y0 * y0 + y1 * y1 + y2 * y2 + y3 * y3;
      }
      ss = wave_sum(ss);
      float rinv = rsqrtf(ss * (1.f / 512.f) + 1e-6f);
#pragma unroll
      for (int j = 0; j < 2; j++) {
        int col = j * 256 + lane * 4; float4 g = *(const float4*)(gg + 1024 + col);
        uint2 o; o.x = pack_bf16(val[j * 4] * rinv * g.x, val[j * 4 + 1] * rinv * g.y); o.y = pack_bf16(val[j * 4 + 2] * rinv * g.z, val[j * 4 + 3] * rinv * g.w);
        *(uint2*)(p.mixed + (size_t)t * DM + 1024 + col) = o;
      }
    }
  }
}

#define TOPK_INS(TV, TI, XV, XI) { float xv_ = (XV); int xi_ = (XI); _Pragma("unroll") for (int i_ = 0; i_ < 16; i_++) { bool c_ = xv_ > TV[i_]; float nv_ = c_ ? xv_ : TV[i_]; float ov_ = c_ ? TV[i_] : xv_; int ni_ = c_ ? xi_ : TI[i_]; int oi_ = c_ ? TI[i_] : xi_; TV[i_] = nv_; TI[i_] = ni_; xv_ = ov_; xi_ = oi_; } }
DI void peer_phase(const Params& p, int l, char* smem) {
  const int tid = opaque(threadIdx.x), wave = tid >> 6, lane = tid & 63;
  float* wsm = (float*)(smem + wave * 12288);
  float* lv = wsm;
  int* lidx = (int*)(wsm + 1024);
  int* pki = (int*)(wsm + 2048);
  float* pkg = wsm + 2560;
  const float* scores = p.z;
  const unsigned char* Ub = p.Ub + (size_t)l * NEXP * DM;
  const unsigned char* Vb = p.Vb + (size_t)l * NEXP * DM;
  const float* Us = p.Us + l * NEXP;
  const float* Vs = p.Vs + l * NEXP;
  float* dst = l == 0 ? p.xA : p.out;
  for (int tb = blockIdx.x; tb < NTOK / 16; tb += gridDim.x) {
    const int tg = tb * 4 + wave;
    {
      const GAS f32x4* sp = (const GAS f32x4*)(scores + (size_t)(tg * 4 + (lane >> 4)) * 2048 + (lane & 15) * 128);
      float tv[16]; int ti[16];
#pragma unroll
      for (int i = 0; i < 16; i++) { tv[i] = -INFINITY; ti[i] = 0; }
      for (int k = 0; k < 128; k += 8) {
        float x[8];
        { f32x4 xa_ = sp[k >> 2], xb_ = sp[(k >> 2) + 1]; x[0] = xa_[0]; x[1] = xa_[1]; x[2] = xa_[2]; x[3] = xa_[3]; x[4] = xb_[0]; x[5] = xb_[1]; x[6] = xb_[2]; x[7] = xb_[3]; }
#pragma unroll
        for (int u = 0; u < 8; u++) TOPK_INS(tv, ti, x[u], k + u);
      }
#pragma unroll
      for (int i = 0; i < 16; i++) { lv[i * 64 + lane] = tv[i]; lidx[i * 64 + lane] = ti[i]; }
    }
    __syncthreads();
    if (lane < 32) {
      const int tt = lane >> 3, hh = lane & 7;
      const int la = tt * 16 + 2 * hh, lb = la + 1;
      float s1[16], s2[16];
#pragma unroll
      for (int i = 0; i < 16; i++) { s1[i] = lv[i * 64 + la]; s2[i] = lv[i * 64 + lb]; }
      float cv[16]; int cf[16];
#pragma unroll
      for (int i = 0; i < 16; i++) { cv[i] = -INFINITY; cf[i] = 0; }
#pragma unroll
      for (int i = 0; i < 16; i++) {
#pragma unroll
        for (int j = 0; j < 16; j++) {
          if ((i + 1) * (j + 1) <= 16) TOPK_INS(cv, cf, s1[i] + s2[j], i * 16 + j);
        }
      }
      float e[16]; float sum = 0.f;
#pragma unroll
      for (int r = 0; r < 16; r++) { e[r] = __expf(cv[r] - cv[0]); sum += e[r]; }
      const float inv = 1.f / sum;
#pragma unroll
      for (int r = 0; r < 16; r++) {
        int id = lidx[(cf[r] >> 4) * 64 + la] * 128 + lidx[(cf[r] & 15) * 64 + lb];
        pki[tt * 128 + hh * 16 + r] = id; pkg[tt * 128 + hh * 16 + r] = e[r] * inv;
      }
    }
    __syncthreads();
    for (int tt = 0; tt < 4; tt++) {
    const int t = tg * 4 + tt;
    const int idx0 = pki[tt * 128 + lane], idx1 = pki[tt * 128 + 64 + lane];
    const float g0 = pkg[tt * 128 + lane], g1 = pkg[tt * 128 + 64 + lane];
    float xs[32];
#pragma unroll
    for (int j = 0; j < 2; j++) {
      const uint4* xp = (const uint4*)(p.hn + (size_t)t * DM + (j * 64 + lane) * 16);
      uint4 xa = xp[0], xb = xp[1];
      xs[j * 16 + 0] = bf_lo(xa.x); xs[j * 16 + 1] = bf_hi(xa.x); xs[j * 16 + 2] = bf_lo(xa.y); xs[j * 16 + 3] = bf_hi(xa.y);
      xs[j * 16 + 4] = bf_lo(xa.z); xs[j * 16 + 5] = bf_hi(xa.z); xs[j * 16 + 6] = bf_lo(xa.w); xs[j * 16 + 7] = bf_hi(xa.w);
      xs[j * 16 + 8] = bf_lo(xb.x); xs[j * 16 + 9] = bf_hi(xb.x); xs[j * 16 + 10] = bf_lo(xb.y); xs[j * 16 + 11] = bf_hi(xb.y);
      xs[j * 16 + 12] = bf_lo(xb.z); xs[j * 16 + 13] = bf_hi(xb.z); xs[j * 16 + 14] = bf_lo(xb.w); xs[j * 16 + 15] = bf_hi(xb.w);
    }
    const float us0 = Us[idx0], us1 = Us[idx1], vs0 = Vs[idx0], vs1 = Vs[idx1];
    float a0 = 0.f, a1 = 0.f;
    {
      u32x4 ld[8][2];
#pragma unroll
      for (int rr = 0; rr < 8; rr++) {
        int idx = __builtin_amdgcn_readlane(idx0, rr);
        const unsigned char* row = Ub + (size_t)idx * DM;
#pragma unroll
        for (int j = 0; j < 2; j++) ld[rr][j] = GLD16(row + (j * 64 + lane) * 16);
      }
      for (int k0 = 0; k0 < 128; k0 += 8) {
        int nsrc = (k0 + 8 < 64) ? idx0 : idx1;
        float part[8];
#pragma unroll
        for (int rr = 0; rr < 8; rr++) {
          float s = 0.f;
#pragma unroll
          for (int j = 0; j < 2; j++)
#pragma unroll
            for (int q = 0; q < 4; q++) {
              f32x2_t lo = __builtin_amdgcn_cvt_pk_f32_fp8((int)ld[rr][j][q], false);
              f32x2_t hi = __builtin_amdgcn_cvt_pk_f32_fp8((int)ld[rr][j][q], true);
              s += lo[0] * xs[j * 16 + q * 4] + lo[1] * xs[j * 16 + q * 4 + 1] + hi[0] * xs[j * 16 + q * 4 + 2] + hi[1] * xs[j * 16 + q * 4 + 3];
            }
          part[rr] = s;
          if (k0 + 8 < 128) {
            int idx = __builtin_amdgcn_readlane(nsrc, (k0 + 8 + rr) & 63);
            const unsigned char* row = Ub + (size_t)idx * DM;
#pragma unroll
            for (int j = 0; j < 2; j++) ld[rr][j] = GLD16(row + (j * 64 + lane) * 16);
          }
        }
#pragma unroll
        for (int o = 32; o; o >>= 1) {
#pragma unroll
          for (int rr = 0; rr < 8; rr++) part[rr] += __shfl_xor(part[rr], o);
        }
#pragma unroll
        for (int rr = 0; rr < 8; rr++) {
          if (lane == ((k0 + rr) & 63)) { if (k0 < 64) a0 = part[rr]; else a1 = part[rr]; }
        }
      }
    }
    float w0 = g0 * gelu_tanh(a0 * us0) * vs0, w1 = g1 * gelu_tanh(a1 * us1) * vs1;
    float acc[32];
#pragma unroll
    for (int e = 0; e < 32; e++) acc[e] = 0.f;
    {
      u32x4 ld[4][2];
#pragma unroll
      for (int rr = 0; rr < 4; rr++) {
        int idx = __builtin_amdgcn_readlane(idx0, rr);
        const unsigned char* row = Vb + (size_t)idx * DM;
#pragma unroll
        for (int j = 0; j < 2; j++) ld[rr][j] = GLD16(row + (j * 64 + lane) * 16);
      }
      for (int k0 = 0; k0 < 128; k0 += 4) {
        float wsrc = (k0 < 64) ? w0 : w1;
        int nsrc = (k0 + 4 < 64) ? idx0 : idx1;
#pragma unroll
        for (int rr = 0; rr < 4; rr++) {
          float w = rdlane_f(wsrc, (k0 + rr) & 63);
#pragma unroll
          for (int j = 0; j < 2; j++)
#pragma unroll
            for (int q = 0; q < 4; q++) {
              f32x2_t lo = __builtin_amdgcn_cvt_pk_f32_fp8((int)ld[rr][j][q], false);
              f32x2_t hi = __builtin_amdgcn_cvt_pk_f32_fp8((int)ld[rr][j][q], true);
              acc[j * 16 + q * 4 + 0] += w * lo[0]; acc[j * 16 + q * 4 + 1] += w * lo[1];
              acc[j * 16 + q * 4 + 2] += w * hi[0]; acc[j * 16 + q * 4 + 3] += w * hi[1];
            }
          if (k0 + 4 < 128) {
            int idx = __builtin_amdgcn_readlane(nsrc, (k0 + 4 + rr) & 63);
            const unsigned char* row = Vb + (size_t)idx * DM;
#pragma unroll
            for (int j = 0; j < 2; j++) ld[rr][j] = GLD16(row + (j * 64 + lane) * 16);
          }
        }
      }
    }
    const float* md = p.mod + (size_t)(l * 5 + cvidx(t)) * 12288 + 10240;
    float ssq = 0.f;
#pragma unroll
    for (int j = 0; j < 2; j++)
#pragma unroll
      for (int q = 0; q < 4; q++) {
        int col = (j * 64 + lane) * 16 + q * 4;
        float4 xa = *(const float4*)(p.x1 + (size_t)t * DM + col);
        float4 ga = *(const float4*)(md + col);
        float4 oa = make_float4(xa.x + ga.x * acc[j * 16 + q * 4], xa.y + ga.y * acc[j * 16 + q * 4 + 1], xa.z + ga.z * acc[j * 16 + q * 4 + 2], xa.w + ga.w * acc[j * 16 + q * 4 + 3]);
        *(float4*)(dst + (size_t)t * DM + col) = oa;
        acc[j * 16 + q * 4] = oa.x; acc[j * 16 + q * 4 + 1] = oa.y; acc[j * 16 + q * 4 + 2] = oa.z; acc[j * 16 + q * 4 + 3] = oa.w;
        ssq += oa.x * oa.x + oa.y * oa.y + oa.z * oa.z + oa.w * oa.w;
      }
    if (l == 0) {
      ssq = wave_sum(ssq);
      const float rinv = rsqrtf(ssq * (1.f / DM) + 1e-6f);
      const float* g = p.norm_mix_g + DM;
      const float* md1 = p.mod + (size_t)(5 + cvidx(t)) * 12288;
#pragma unroll
      for (int j = 0; j < 2; j++)
#pragma unroll
        for (int q = 0; q < 4; q++) {
          int col = (j * 64 + lane) * 16 + q * 4;
          float4 gg = *(const float4*)(g + col), sc = *(const float4*)(md1 + 2048 + col), sh = *(const float4*)(md1 + col);
          float y0 = acc[j * 16 + q * 4] * rinv * gg.x * (1.f + sc.x) + sh.x;
          float y1 = acc[j * 16 + q * 4 + 1] * rinv * gg.y * (1.f + sc.y) + sh.y;
          float y2 = acc[j * 16 + q * 4 + 2] * rinv * gg.z * (1.f + sc.z) + sh.z;
          float y3 = acc[j * 16 + q * 4 + 3] * rinv * gg.w * (1.f + sc.w) + sh.w;
          uint2 o; o.x = pack_bf16(y0, y1); o.y = pack_bf16(y2, y3);
          *(uint2*)(p.hn + (size_t)t * DM + col) = o;
        }
    }
    }
    __syncthreads();
  }
}

DI void gsync(unsigned* bar, unsigned& gen) {
  asm volatile("s_waitcnt vmcnt(0) lgkmcnt(0)" ::: "memory");
  __syncthreads();
  if (threadIdx.x == 0) {
    __builtin_amdgcn_fence(__ATOMIC_RELEASE, "agent");
    asm volatile("s_waitcnt vmcnt(0)" ::: "memory");
    gen++;
    const unsigned ng = gridDim.x >> 3;
    unsigned* gc = bar + 32 * (1 + (blockIdx.x & 7));
    (void)__hip_atomic_fetch_add(gc, 1u, __ATOMIC_RELAXED, __HIP_MEMORY_SCOPE_AGENT);
    if (blockIdx.x < 8) {
      const unsigned gt = gen * ng;
      while (__hip_atomic_load(gc, __ATOMIC_RELAXED, __HIP_MEMORY_SCOPE_AGENT) < gt) __builtin_amdgcn_s_sleep(1);
      (void)__hip_atomic_fetch_add(bar, 1u, __ATOMIC_RELAXED, __HIP_MEMORY_SCOPE_AGENT);
    }
    const unsigned target = gen * 8u;
    while (__hip_atomic_load(bar, __ATOMIC_RELAXED, __HIP_MEMORY_SCOPE_AGENT) < target) __builtin_amdgcn_s_sleep(4);
    __builtin_amdgcn_fence(__ATOMIC_ACQUIRE, "agent");
    asm volatile("s_waitcnt vmcnt(0)" ::: "memory");
  }
  __syncthreads();
}

DI void dump_bf16(const Params& p, const ushort_t* src) {
  size_t n = (size_t)NTOK * DM; size_t tot = n + 16 * 2 * 256 * 256 + 16 * 2 * 256 * 64 + 16 * 2 * 2 * 512;
  for (size_t i = (size_t)blockIdx.x * 256 + threadIdx.x; i < tot; i += (size_t)gridDim.x * 256)
    p.out[i] = i < n ? __uint_as_float(((unsigned)src[i]) << 16) : (i < n + 2 * 5 * 12288 ? p.mod[i - n] : 0.f);
}


DI void dump_f32(const Params& p, const float* src, size_t n) {
  size_t tot = (size_t)NTOK * DM + 16 * 2 * 256 * 256 + 16 * 2 * 256 * 64 + 16 * 2 * 2 * 512;
  for (size_t i = (size_t)blockIdx.x * 256 + threadIdx.x; i < tot; i += (size_t)gridDim.x * 256)
    p.out[i] = i < n ? src[i] : 0.f;
}

__global__ void __launch_bounds__(256, 2) fwd_megakernel(Params pk) {
  __shared__ __attribute__((aligned(16))) char smem[SMEM_BYTES];
  __shared__ __attribute__((aligned(16))) unsigned long long spw[(sizeof(Params) + 7) / 8];
  {
    const unsigned long long* ka = (const unsigned long long*)__builtin_amdgcn_kernarg_segment_ptr();
    if (threadIdx.x < (sizeof(Params) + 7) / 8) spw[threadIdx.x] = ka[threadIdx.x];
    __syncthreads();
  }
#define PP (*(const Params*)((const char*)spw + opaque(0)))
  unsigned gen = 0; unsigned* bar = PP.bar;
  const int nb = gridDim.x, bid = blockIdx.x;
  const int wave = threadIdx.x >> 6, lane = threadIdx.x & 63;

  for (int rep = 0; rep < REP_A; rep++) {
  { const Params& p = PP; prep_phase(p, smem); }
  gsync(bar, gen);
  }

  for (int l = 0; l < 2; l++) {
    for (int rep = 0; rep < REP_D; rep++) {
    if (l == 0) { { const Params& p = PP; norm_phase(p, l, 0); } gsync(bar, gen); }
    }
    for (int rep = 0; rep < REP_B; rep++) {
    {
      const Params& p = PP;
      const ushort_t* Bt = p.WinT + (size_t)l * INW * DM;
      float* z = p.z;
      for (int j = bid >> 3; j < 192; j += nb >> 3) {
        int mt = (bid & 7) * 8 + ((j & 63) >> 3), nt = (j >> 6) * 8 + (j & 7);
        if (nt >= 23) continue;
        gemm_tile(p.hn, DM, Bt, DM, DM, INW, mt * 128, nt * 128, smem, [&](int row, int col, float v) { z[(size_t)row * INW + col] = v; });
      }
    }
    gsync(bar, gen);
    }
    for (int rep = 0; rep < REP_D; rep++) {
    {
      const Params& p = PP;
      for (int it = bid; it < 512 + NTOK / CMT; it += nb) {
        if (it < 512) lru_item(p, l, it, smem); else cm_item(p, l, it - 512, smem);
      }
    }
    { const Params& p = PP; post_inproj_tokens(p, l); }
    gsync(bar, gen);
    }
    for (int rep = 0; rep < REP_B; rep++) {
    {
      const Params& p = PP;
      const ushort_t* Bq = p.WqbT + (size_t)l * 1536 * 512;
      const ushort_t* Bkv = p.WkvbT + (size_t)l * 2048 * 256;
      ushort_t* qraw = p.qraw; ushort_t* kvraw = p.kvraw;
      for (int j = bid >> 3; j < 256; j += nb >> 3) {
        if (j < 160) {
          int rem = j % 80; int mt = (bid & 7) * 10 + (rem >> 3), nt = (j / 80) * 8 + (rem & 7);
          gemm_tile(p.ckv, 256, Bkv, 256, 256, 2048, mt * 128, nt * 128, smem, [&](int row, int col, float v) { kvraw[(size_t)row * 2048 + col] = f2bf(v); });
        } else {
          int j2 = j - 160; int rem = j2 % 48; int mt = (bid & 7) * 8 + rem / 6, nt = (j2 / 48) * 6 + rem % 6;
          gemm_tile(p.qa, 512, Bq, 512, 512, 1536, mt * 128, nt * 128, smem, [&](int row, int col, float v) { qraw[(size_t)row * 1536 + col] = f2bf(v); });
        }
      }
    }
    gsync(bar, gen);
    }
    for (int rep = 0; rep < REP_D; rep++) {
    { const Params& p = PP; for (int it = bid; it < 160 * 8; it += nb) kv_item(p, l, it, smem); }
    { const Params& p = PP; qnorm_tokens(p, l); }
    gsync(bar, gen);
    }
    for (int rep = 0; rep < REP_D; rep++) {
    { const Params& p = PP; for (int it = bid; it < 1024; it += nb) attn_item(p, it, smem); }
    gsync(bar, gen);
    }
    for (int rep = 0; rep < REP_D; rep++) {
    { const Params& p = PP; merge_tokens(p, l); }
    gsync(bar, gen);
    }
    for (int rep = 0; rep < REP_B; rep++) {
    {
      const Params& p = PP;
      const ushort_t* Bt = p.WoutT + (size_t)l * DM * DM;
      float* x1 = p.x1;
      for (int j = bid >> 3; j < 128; j += nb >> 3) {
        int mt = (bid & 7) * 8 + ((j & 63) >> 3), nt = (j >> 6) * 8 + (j & 7);
        gemm_tile(p.mixed, DM, Bt, DM, DM, DM, mt * 128, nt * 128, smem, [&](int row, int col, float v) {
          const float* xr = xrow_in(p, l, row);
          float g1 = p.mod[(size_t)(l * 5 + cvidx(row)) * 12288 + 4096 + col];
          x1[(size_t)row * DM + col] = xr[col] + g1 * v;
        });
      }
    }
    gsync(bar, gen);
    }
    for (int rep = 0; rep < REP_D; rep++) {
    { const Params& p = PP; norm_phase(p, l, 1); }
    gsync(bar, gen);
    }
    for (int rep = 0; rep < REP_B; rep++) {
    {
      const Params& p = PP;
      const ushort_t* Bt = p.WpqT + (size_t)l * DM * DM;
      const ushort_t* Kb = p.KeysB + (size_t)l * 2048 * 128;
      float* sc = (float*)p.z;
      ushort_t* sP = (ushort_t*)smem;
      for (int j = bid >> 3; j < 128; j += nb >> 3) {
        int mt = (bid & 7) * 8 + ((j & 63) >> 3), nt = (j >> 6) * 8 + (j & 7);
        gemm_tile(p.hn, DM, Bt, DM, DM, DM, mt * 128, nt * 128, smem, [&](int row, int col, float v) { sP[(row - mt * 128) * PLD + (col - nt * 128)] = f2bf(v); });
        scores_tile(Kb + (size_t)nt * 128 * 128, sc, mt, nt, smem);
      }
    }
    gsync(bar, gen);
    }
    for (int rep = 0; rep < REP_C; rep++) {
    { const Params& p = PP; peer_phase(p, l, smem); }
    gsync(bar, gen);
    }
  }
}

extern "C" void kernel_launch(void* const* d_in, const int* in_sizes, int n_in, void* d_out, int out_size, void* d_ws, size_t ws_size, hipStream_t stream) {
  static int grid_blocks = 0;
  if (!grid_blocks) {
    int dev = 0, cus = 0, per_cu = 0;
    hipGetDevice(&dev);
    hipDeviceGetAttribute(&cus, hipDeviceAttributeMultiprocessorCount, dev);
    hipOccupancyMaxActiveBlocksPerMultiprocessor(&per_cu, fwd_megakernel, 256, 0);
    if (per_cu > 2) per_cu = 2;
    if (per_cu < 1) per_cu = 1;
    grid_blocks = (cus * per_cu) & ~7;
  }
  Params p{};
  const float** pin = (const float**)&p;
  for (int i = 0; i < 35; i++) pin[i] = (const float*)d_in[i];
  p.out = (float*)d_out;
  char* w = (char*)d_ws; size_t off = 0;
  auto take = [&](size_t bytes) { char* r = w + off; off += (bytes + 255) & ~(size_t)255; return r; };
  p.bar = (unsigned*)take(2048);
  p.WinT = (ushort_t*)take((size_t)2 * INW * DM * 2);
  p.WqbT = (ushort_t*)take((size_t)2 * 1536 * 512 * 2);
  p.WkvbT = (ushort_t*)take((size_t)2 * 2048 * 256 * 2);
  p.WoutT = (ushort_t*)take((size_t)2 * DM * DM * 2);
  p.WpqT = (ushort_t*)take((size_t)2 * DM * DM * 2);
  p.KeysB = (ushort_t*)take((size_t)2 * 2048 * 128 * 2);
  p.LruW = (ushort_t*)take((size_t)2 * 16 * 2 * 4096 * 2);
  p.Ub = (unsigned char*)take((size_t)2 * NEXP * DM);
  p.Vb = (unsigned char*)take((size_t)2 * NEXP * DM);
  p.Us = (float*)take((size_t)2 * NEXP * 4);
  p.Vs = (float*)take((size_t)2 * NEXP * 4);
  p.hn = (ushort_t*)take((size_t)NTOK * DM * 2);
  p.qa = (ushort_t*)take((size_t)NTOK * 512 * 2);
  p.ckv = (ushort_t*)take((size_t)NKV * 256 * 2);
  p.Q = (ushort_t*)take((size_t)NTOK * 1536 * 2);
  p.K = (ushort_t*)take((size_t)NKV * 1536 * 2);
  p.Vt = (ushort_t*)take((size_t)NKV * 1024 * 2);
  p.mixed = (ushort_t*)take((size_t)NTOK * DM * 2);
  p.z = (float*)take((size_t)NTOK * INW * 4);
  p.qraw = (ushort_t*)take((size_t)NTOK * 1536 * 2);
  p.kvraw = (ushort_t*)take((size_t)NKV * 2048 * 2);
  p.attn = (ushort_t*)take((size_t)NTOK * 1024 * 2);
  p.hs = (ushort_t*)take((size_t)2 * NTOK * 512 * 2);
  p.Pc = (ushort_t*)take((size_t)2 * NTOK * 512 * 2);
  p.hend = (float*)take((size_t)2 * 32 * 512 * 4);
  p.Pend = (float*)take((size_t)2 * 32 * 512 * 4);
  p.x1 = (float*)take((size_t)NTOK * DM * 4);
  p.xA = (float*)take((size_t)NTOK * DM * 4);
  p.mod = (float*)take((size_t)2 * 5 * 12288 * 4);
  p.rope = (float*)take((size_t)1024 * 64 * 4);
  if (off > ws_size) { fprintf(stderr, "workspace too small: need %zu have %zu\n", off, ws_size); return; }
  if (hipMemsetAsync(p.bar, 0, 2048, stream) != hipSuccess) { fprintf(stderr, "memset failed\n"); return; }
  hipLaunchKernelGGL(fwd_megakernel, dim3(grid_blocks), dim3(256), 0, stream, p);
}
```

```cpp
#include <hip/hip_runtime.h>
#include <hip/hip_cooperative_groups.h>
#include <cstdio>
#include <cstdint>
namespace cg = cooperative_groups;

typedef unsigned short ushort_t;
typedef __attribute__((ext_vector_type(8))) short bf16x8;
typedef __attribute__((ext_vector_type(16))) float f32x16;
typedef __attribute__((ext_vector_type(4))) unsigned u32x4;
typedef __attribute__((ext_vector_type(4))) float f32x4;
typedef __attribute__((ext_vector_type(2))) float f32x2_t;
typedef __attribute__((ext_vector_type(2))) __bf16 bf16x2_t;
#define DI __device__ __forceinline__
#define GAS __attribute__((address_space(1)))
#define GLD16(ptr) (*(const GAS u32x4*)(ptr))
#define MFMA32(a, b, c) __builtin_amdgcn_mfma_f32_32x32x16_bf16((a), (b), (c), 0, 0, 0)

#define DM 2048
#define NTOK 8192
#define NCTX 4096
#define INW 2880
#define NKV 10240
#define OFF_ZKV 512
#define OFF_ZKR 768
#define OFF_ZX 832
#define OFF_ZG 1344
#define OFF_ZC 1856
#define NEXP 16384
#define SMEM_BYTES 78848
#ifndef REP_A
#define REP_A 1
#define REP_B 1
#define REP_C 1
#define REP_D 1
#endif

struct Params {
  const float *x_prompt, *x_sample, *cache_ckv, *cache_krope, *state_lru, *c, *c_ctx;
  const float *ada_w, *ada_b, *norm_mix_g, *w_in, *mla_qa_g, *mla_w_qb, *mla_q_g, *mla_kva_g, *mla_w_kvb, *mla_k_g;
  const float *lru_conv_w, *lru_conv_b, *lru_w_a, *lru_b_a, *lru_w_i, *lru_b_i, *lru_lam;
  const float *cm_dw_w, *cm_dw_b, *cm_ln_g, *cm_ln_b, *grp_g, *w_out, *norm_ffn_g;
  const float *peer_w_q, *peer_keys, *peer_u, *peer_v;
  float* out;
  unsigned* bar;
  ushort_t *WinT, *WqbT, *WkvbT, *WoutT, *WpqT, *KeysB, *LruW;
  unsigned char *Ub, *Vb;
  float *Us, *Vs;
  ushort_t *hn, *qa, *ckv, *Q, *K, *Vt, *mixed;
  ushort_t *qraw, *kvraw, *attn, *hs, *Pc;
  float *z, *hend, *Pend, *x1, *xA, *mod, *rope;
};

DI unsigned pack_bf16(float lo, float hi) { f32x2_t v = {lo, hi}; bf16x2_t b = __builtin_convertvector(v, bf16x2_t); return __builtin_bit_cast(unsigned, b); }
DI ushort_t f2bf(float x) { return (ushort_t)(pack_bf16(x, 0.f) & 0xffffu); }
DI float bf_lo(unsigned u) { return __uint_as_float(u << 16); }
DI float bf_hi(unsigned u) { return __uint_as_float(u & 0xffff0000u); }
DI float wave_sum(float v) { for (int o = 32; o; o >>= 1) v += __shfl_xor(v, o); return v; }
DI float sigmoidf_(float x) { return 1.f / (1.f + __expf(-x)); }
DI float gelu_tanh(float x) { return 0.5f * x * (1.f + tanhf(0.7978845608028654f * (x + 0.044715f * x * x * x))); }
DI int crow(int reg, int h) { return (reg & 3) + 8 * (reg >> 2) + 4 * h; }
DI int cvidx(int t) { return t < NCTX ? 0 : 1 + ((t - NCTX) >> 10); }
DI int kvrow_of_token(int t) { if (t < NCTX) return t; int tl = t - NCTX; return NCTX + (tl >> 10) * 1536 + 512 + (tl & 1023); }
DI const float* xrow_in(const Params& p, int l, int t) {
  if (l == 0) return t < NCTX ? p.x_prompt + (size_t)t * DM : p.x_sample + (size_t)(t - NCTX) * DM;
  return p.xA + (size_t)t * DM;
}
DI float dot2bf(unsigned a, unsigned b, float acc) { return __builtin_amdgcn_fdot2_f32_bf16(__builtin_bit_cast(bf16x2_t, a), __builtin_bit_cast(bf16x2_t, b), acc, false); }
DI int opaque(int x) { asm volatile("" : "+v"(x)); return x; }
DI float rdlane_f(float v, int l) { return __int_as_float(__builtin_amdgcn_readlane(__float_as_int(v), l)); }

#define GLD 72
template <class Epi>
DI void gemm_tile(const ushort_t* A, int lda, const ushort_t* Bt, int ldb, int K, int N, int m0, int n0, char* smem, Epi epi) {
  ushort_t* sA = (ushort_t*)smem;
  ushort_t* sB = sA + 128 * GLD;
  const int tid = opaque(threadIdx.x), wave = tid >> 6, lane = tid & 63, wm = wave & 1, wn = wave >> 1;
  const int r = lane & 31, h = lane >> 5;
  f32x16 acc[2][2];
#pragma unroll
  for (int i = 0; i < 2; i++)
#pragma unroll
    for (int j = 0; j < 2; j++)
#pragma unroll
      for (int e = 0; e < 16; e++) acc[i][j][e] = 0.f;
  u32x4 ra0[4], rb0[4], ra1[4], rb1[4];
  const int lrow = tid >> 3, lkc = (tid & 7) * 8;
  const ushort_t* Ap = A + (size_t)(m0 + lrow) * lda + lkc;
  const ushort_t* Bp[4];
#pragma unroll
  for (int i = 0; i < 4; i++) { int br = n0 + lrow + 32 * i; br = br < N ? br : N - 1; Bp[i] = Bt + (size_t)br * ldb + lkc; }
  auto gload = [&](u32x4* ra, u32x4* rb, int k0) {
#pragma unroll
    for (int i = 0; i < 4; i++) {
      ra[i] = GLD16(Ap + (size_t)(32 * i) * lda + k0);
      rb[i] = GLD16(Bp[i] + k0);
    }
  };
  auto lstore = [&](const u32x4* ra, const u32x4* rb, int buf) {
    ushort_t* dA = sA + buf * (2 * 128 * GLD) + lrow * GLD + lkc;
    ushort_t* dB = sB + buf * (2 * 128 * GLD) + lrow * GLD + lkc;
#pragma unroll
    for (int i = 0; i < 4; i++) { *(u32x4*)(dA + 32 * i * GLD) = ra[i]; *(u32x4*)(dB + 32 * i * GLD) = rb[i]; }
  };
  auto compute = [&](int buf) {
    const ushort_t* cA = sA + buf * (2 * 128 * GLD);
    const ushort_t* cB = sB + buf * (2 * 128 * GLD);
    bf16x8 a[2][2], b[2][2];
#pragma unroll
    for (int i = 0; i < 2; i++) {
      a[0][i] = *(const bf16x8*)(cA + (wm * 64 + i * 32 + r) * GLD + h * 8);
      b[0][i] = *(const bf16x8*)(cB + (wn * 64 + i * 32 + r) * GLD + h * 8);
    }
#pragma unroll
    for (int ks = 0; ks < 4; ks++) {
      if (ks < 3) {
#pragma unroll
        for (int i = 0; i < 2; i++) {
          a[(ks + 1) & 1][i] = *(const bf16x8*)(cA + (wm * 64 + i * 32 + r) * GLD + (ks + 1) * 16 + h * 8);
          b[(ks + 1) & 1][i] = *(const bf16x8*)(cB + (wn * 64 + i * 32 + r) * GLD + (ks + 1) * 16 + h * 8);
        }
      }
#pragma unroll
      for (int i = 0; i < 2; i++)
#pragma unroll
        for (int j = 0; j < 2; j++) acc[i][j] = MFMA32(a[ks & 1][i], b[ks & 1][j], acc[i][j]);
    }
  };
  gload(ra0, rb0, 0);
  gload(ra1, rb1, 64);
  lstore(ra0, rb0, 0);
  __syncthreads();
  const int klast = K - 64;
  gload(ra0, rb0, 128 < K ? 128 : klast);
  for (int k0 = 0; k0 < K; k0 += 128) {
    compute(0);
    lstore(ra1, rb1, 1);
    __syncthreads();
    gload(ra1, rb1, k0 + 192 < K ? k0 + 192 : klast);
    compute(1);
    lstore(ra0, rb0, 0);
    __syncthreads();
    gload(ra0, rb0, k0 + 256 < K ? k0 + 256 : klast);
  }
#pragma unroll
  for (int i = 0; i < 2; i++)
#pragma unroll
    for (int j = 0; j < 2; j++)
#pragma unroll
      for (int e = 0; e < 16; e++) {
        int row = m0 + wm * 64 + i * 32 + crow(e, h);
        int col = n0 + wn * 64 + j * 32 + r;
        if (col < N) epi(row, col, acc[i][j][e]);
      }
  __syncthreads();
}

#define PLD 136
DI void scores_tile(const ushort_t* Kt, float* sc, int mt, int nt, char* smem) {
  ushort_t* sP = (ushort_t*)smem;
  ushort_t* sK2 = sP + 128 * PLD;
  const int tid = opaque(threadIdx.x), wave = tid >> 6, lane = tid & 63, wm = wave & 1, wn = wave >> 1;
  const int r = lane & 31, h = lane >> 5;
#pragma unroll
  for (int i = 0; i < 8; i++) { int c = tid + i * 256; int row = c >> 4, kc = (c & 15) * 8; *(u32x4*)(sK2 + row * PLD + kc) = GLD16(Kt + row * 128 + kc); }
  __syncthreads();
  f32x16 acc[2][2];
#pragma unroll
  for (int i = 0; i < 2; i++)
#pragma unroll
    for (int j = 0; j < 2; j++)
#pragma unroll
      for (int e = 0; e < 16; e++) acc[i][j][e] = 0.f;
#pragma unroll
  for (int ks = 0; ks < 8; ks++) {
    bf16x8 a[2], b[2];
#pragma unroll
    for (int i = 0; i < 2; i++) {
      a[i] = *(const bf16x8*)(sP + (wm * 64 + i * 32 + r) * PLD + ks * 16 + h * 8);
      b[i] = *(const bf16x8*)(sK2 + (wn * 64 + i * 32 + r) * PLD + ks * 16 + h * 8);
    }
#pragma unroll
    for (int i = 0; i < 2; i++)
#pragma unroll
      for (int j = 0; j < 2; j++) acc[i][j] = MFMA32(a[i], b[j], acc[i][j]);
  }
#pragma unroll
  for (int i = 0; i < 2; i++)
#pragma unroll
    for (int j = 0; j < 2; j++)
#pragma unroll
      for (int e = 0; e < 16; e++) {
        int row = mt * 128 + wm * 64 + i * 32 + crow(e, h);
        int col = wn * 64 + j * 32 + r;
        sc[(size_t)row * 2048 + nt * 128 + col] = acc[i][j][e];
      }
  __syncthreads();
}

DI void transpose_item(const float* src, int lds_, ushort_t* dst, int ldd, int kt, int nt, float* tile) {
  int tid = opaque(threadIdx.x); int c = tid & 63, r0 = tid >> 6;
#pragma unroll 4
  for (int i = 0; i < 16; i++) { int r = r0 + 4 * i; tile[r * 65 + c] = src[(size_t)(kt * 64 + r) * lds_ + nt * 64 + c]; }
  __syncthreads();
#pragma unroll 4
  for (int i = 0; i < 16; i++) { int r = r0 + 4 * i; dst[(size_t)(nt * 64 + r) * ldd + kt * 64 + c] = f2bf(tile[c * 65 + r]); }
  __syncthreads();
}

DI void convert_chunk(const float* src, ushort_t* dst, size_t base) {
  int tid = opaque(threadIdx.x);
#pragma unroll
  for (int it = 0; it < 4; it++) {
    size_t e = base + it * 2048 + tid * 8;
    float4 a = *(const float4*)(src + e), b = *(const float4*)(src + e + 4);
    uint4 o; o.x = pack_bf16(a.x, a.y); o.y = pack_bf16(a.z, a.w); o.z = pack_bf16(b.x, b.y); o.w = pack_bf16(b.z, b.w);
    *(uint4*)(dst + e) = o;
  }
}


DI void quant_rows(const float* src, unsigned char* dst, float* scl, size_t row0) {
  int tid = opaque(threadIdx.x); int wave = tid >> 6, lane = tid & 63;
  size_t row = row0 + wave;
  const float* r = src + row * DM;
  float4 v[8]; float am = 0.f;
#pragma unroll
  for (int j = 0; j < 8; j++) { v[j] = *(const float4*)(r + (j * 64 + lane) * 4); am = fmaxf(am, fmaxf(fmaxf(fabsf(v[j].x), fabsf(v[j].y)), fmaxf(fabsf(v[j].z), fabsf(v[j].w)))); }
  for (int o = 32; o; o >>= 1) am = fmaxf(am, __shfl_xor(am, o));
  float sc = am > 0.f ? 224.f / am : 1.f;
  if (lane == 0) scl[row] = am > 0.f ? am * (1.f / 224.f) : 1.f;
#pragma unroll
  for (int j = 0; j < 8; j++) {
    int w = 0;
    w = __builtin_amdgcn_cvt_pk_fp8_f32(v[j].x * sc, v[j].y * sc, w, false);
    w = __builtin_amdgcn_cvt_pk_fp8_f32(v[j].z * sc, v[j].w * sc, w, true);
    *(int*)(dst + row * DM + (j * 64 + lane) * 4) = w;
  }
}

DI void mod_item(const Params& p, int item, char* smem) {
  int l = item / 48, cgp = item % 48;
  float* s = (float*)smem;
  float* red = s + 5 * 2048;
  int tid = opaque(threadIdx.x), wave = tid >> 6, lane = tid & 63;
  for (int i = tid; i < 5 * 2048; i += 256) {
    int cv = i >> 11, k = i & 2047;
    float v = cv == 0 ? p.c_ctx[k] : p.c[(cv - 1) * DM + k];
    s[i] = v * sigmoidf_(v);
  }
  __syncthreads();
  const float* W = p.ada_w + (size_t)l * DM * 12288 + cgp * 256 + lane * 4;
  float4 acc[5];
#pragma unroll
  for (int cv = 0; cv < 5; cv++) acc[cv] = make_float4(0, 0, 0, 0);
  int kb = wave * 512;
#pragma unroll 8
  for (int k = kb; k < kb + 512; k++) {
    float4 w = *(const float4*)(W + (size_t)k * 12288);
#pragma unroll
    for (int cv = 0; cv < 5; cv++) {
      float sv = s[cv * 2048 + k];
      acc[cv].x += sv * w.x; acc[cv].y += sv * w.y; acc[cv].z += sv * w.z; acc[cv].w += sv * w.w;
    }
  }
#pragma unroll
  for (int cv = 0; cv < 5; cv++) *(float4*)(red + (wave * 5 + cv) * 256 + lane * 4) = acc[cv];
  __syncthreads();
  for (int i = tid; i < 5 * 256; i += 256) {
    int cv = i >> 8, col = i & 255;
    float v = red[(0 * 5 + cv) * 256 + col] + red[(1 * 5 + cv) * 256 + col] + red[(2 * 5 + cv) * 256 + col] + red[(3 * 5 + cv) * 256 + col];
    int gc = cgp * 256 + col;
    p.mod[(size_t)(l * 5 + cv) * 12288 + gc] = v + p.ada_b[l * 12288 + gc];
  }
  __syncthreads();
}

#define N_MOD 96
#define N_TR_LAYER 3840
#define N_TR (2 * N_TR_LAYER)
#define N_CV_KEYS 64
#define N_CV_U 8192
#define N_PREP (N_MOD + N_TR + N_CV_KEYS + 2 * N_CV_U + 1)

DI void prep_phase(const Params& p, char* smem) {
  for (int it = blockIdx.x; it < N_PREP; it += gridDim.x) {
    if (it < N_MOD) { mod_item(p, it, smem); continue; }
    int i = it - N_MOD;
    if (i < N_TR) {
      int l = i / N_TR_LAYER, j = i % N_TR_LAYER;
      float* tile = (float*)smem;
      if (j < 1440) { transpose_item(p.w_in + (size_t)l * DM * INW, INW, p.WinT + (size_t)l * INW * DM, DM, j / 45, j % 45, tile); continue; }
      j -= 1440;
      if (j < 192) { transpose_item(p.mla_w_qb + (size_t)l * 512 * 1536, 1536, p.WqbT + (size_t)l * 1536 * 512, 512, j / 24, j % 24, tile); continue; }
      j -= 192;
      if (j < 128) { transpose_item(p.mla_w_kvb + (size_t)l * 256 * 2048, 2048, p.WkvbT + (size_t)l * 2048 * 256, 256, j / 32, j % 32, tile); continue; }
      j -= 128;
      if (j < 1024) { transpose_item(p.w_out + (size_t)l * DM * DM, DM, p.WoutT + (size_t)l * DM * DM, DM, j / 32, j % 32, tile); continue; }
      j -= 1024;
      if (j < 1024) { transpose_item(p.peer_w_q + (size_t)l * DM * DM, DM, p.WpqT + (size_t)l * DM * DM, DM, j / 32, j % 32, tile); continue; }
      j -= 1024;
      {
        int mat = j >> 4, dh = j & 15;
        const float* src = (mat ? p.lru_w_i : p.lru_w_a) + (size_t)(l * 16 + dh) * 4096;
        ushort_t* dst = p.LruW + ((size_t)(l * 16 + dh) * 2 + mat) * 4096;
        transpose_item(src, 64, dst, 64, 0, 0, tile);
      }
      continue;
    }
    i -= N_TR;
    if (i < N_CV_KEYS) { convert_chunk(p.peer_keys, p.KeysB, (size_t)i * 8192); continue; }
    i -= N_CV_KEYS;
    if (i < N_CV_U) { quant_rows(p.peer_u, p.Ub, p.Us, (size_t)i * 4); continue; }
    i -= N_CV_U;
    if (i < N_CV_U) { quant_rows(p.peer_v, p.Vb, p.Vs, (size_t)i * 4); continue; }
    for (int e = threadIdx.x; e < 1024 * 32; e += 256) {
      int pos = e >> 5, f = e & 31;
      int fi = f & 15;
      float inv = 1.0f / powf(10000.0f, (float)fi / 16.0f);
      float base = (f < 16) ? (float)(pos >> 6) : (float)(pos & 63);
      float ang = base * inv;
      float sn, cs; sincosf(ang, &sn, &cs);
      p.rope[pos * 64 + f] = cs; p.rope[pos * 64 + 32 + f] = sn;
    }
  }
}

DI void norm_phase(const Params& p, int l, int which) {
  int tidq = opaque(threadIdx.x); int lane = tidq & 63, gw = blockIdx.x * 4 + (tidq >> 6), nw = gridDim.x * 4;
  const float* g = (which ? p.norm_ffn_g : p.norm_mix_g) + l * DM;
  int sh_off = which ? 6144 : 0, sc_off = which ? 8192 : 2048;
  for (int t = gw; t < NTOK; t += nw) {
    const float* xr = which ? p.x1 + (size_t)t * DM : xrow_in(p, l, t);
    const float* md = p.mod + (size_t)(l * 5 + cvidx(t)) * 12288;
    float4 v[8]; float ss = 0.f;
#pragma unroll
    for (int j = 0; j < 8; j++) { v[j] = *(const float4*)(xr + j * 256 + lane * 4); ss += v[j].x * v[j].x + v[j].y * v[j].y + v[j].z * v[j].z + v[j].w * v[j].w; }
    ss = wave_sum(ss);
    float rinv = rsqrtf(ss * (1.f / DM) + 1e-6f);
#pragma unroll
    for (int j = 0; j < 8; j++) {
      int col = j * 256 + lane * 4;
      float4 gg = *(const float4*)(g + col), sc = *(const float4*)(md + sc_off + col), sh = *(const float4*)(md + sh_off + col);
      float y0 = v[j].x * rinv * gg.x * (1.f + sc.x) + sh.x;
      float y1 = v[j].y * rinv * gg.y * (1.f + sc.y) + sh.y;
      float y2 = v[j].z * rinv * gg.z * (1.f + sc.z) + sh.z;
      float y3 = v[j].w * rinv * gg.w * (1.f + sc.w) + sh.w;
      uint2 o; o.x = pack_bf16(y0, y1); o.y = pack_bf16(y2, y3);
      *(uint2*)(p.hn + (size_t)t * DM + col) = o;
    }
  }
}

DI void lru_item(const Params& p, int l, int item, char* smem) {
  int ch = item >> 4, hd = (item >> 1) & 7, d = item & 1;
  int t0 = ch * 256, seq_t0, T, p0;
  if (ch < 16) { seq_t0 = ch * 256; T = 256; p0 = 0; }
  else { int b = (ch - 16) >> 2, cc = (ch - 16) & 3; seq_t0 = NCTX + b * 1024; T = 1024; p0 = cc * 256; }
  ushort_t* sBt = (ushort_t*)smem;
  ushort_t* sA = sBt + 128 * GLD;
  float* sXc = (float*)(sA + 64 * GLD);
  float* sG = sXc + 64 * 64;
  const int tid = opaque(threadIdx.x), wave = tid >> 6, lane = tid & 63;
  const int c = tid & 63, tg = tid >> 6;
  const ushort_t* Bt = p.LruW + ((size_t)((l * 2 + d) * 8 + hd) * 2) * 4096;
#pragma unroll
  for (int i = 0; i < 4; i++) { int cidx = tid + i * 256; int row = cidx >> 3, kc = (cidx & 7) * 8; *(uint4*)(sBt + row * GLD + kc) = *(const uint4*)(Bt + row * 64 + kc); }
  const int chn = hd * 64 + c;
  float cw[4];
#pragma unroll
  for (int j = 0; j < 4; j++) cw[j] = p.lru_conv_w[(l * 4 + j) * 512 + chn];
  const float cb = p.lru_conv_b[l * 512 + chn];
  const float ba = p.lru_b_a[(l * 2 + d) * 512 + chn], bi = p.lru_b_i[(l * 2 + d) * 512 + chn];
  const float lam = p.lru_lam[(l * 2 + d) * 512 + chn];
  const float sp = log1pf(expf(-lam));
  float hst = 0.f, Pp = 1.f;
  const int r = lane & 31, h8 = lane >> 5;
  for (int si = 0; si < 4; si++) {
    int sub = d ? 3 - si : si;
#pragma unroll 4
    for (int i = 0; i < 16; i++) {
      int lt = tg * 16 + i; int pos = p0 + sub * 64 + lt;
      float xc = cb;
#pragma unroll
      for (int j = 0; j < 4; j++) {
        int q = pos - 2 + j;
        float zv = (q >= 0 && q < T) ? p.z[(size_t)(seq_t0 + q) * INW + OFF_ZX + chn] : 0.f;
        xc += cw[j] * zv;
      }
      sXc[lt * 64 + c] = xc; sA[lt * GLD + c] = f2bf(xc);
    }
    __syncthreads();
    {
      int mt = wave & 1, nh = wave >> 1;
      f32x16 acc[2];
#pragma unroll
      for (int i = 0; i < 2; i++)
#pragma unroll
        for (int e = 0; e < 16; e++) acc[i][e] = 0.f;
#pragma unroll
      for (int ks = 0; ks < 4; ks++) {
        bf16x8 a = *(const bf16x8*)(sA + (mt * 32 + r) * GLD + ks * 16 + h8 * 8);
#pragma unroll
        for (int ni = 0; ni < 2; ni++) {
          bf16x8 b = *(const bf16x8*)(sBt + (nh * 64 + ni * 32 + r) * GLD + ks * 16 + h8 * 8);
          acc[ni] = MFMA32(a, b, acc[ni]);
        }
      }
#pragma unroll
      for (int ni = 0; ni < 2; ni++)
#pragma unroll
        for (int e = 0; e < 16; e++) sG[(mt * 32 + crow(e, h8)) * 132 + nh * 64 + ni * 32 + r] = acc[ni][e];
    }
    __syncthreads();
#pragma unroll 4
    for (int i = 0; i < 16; i++) {
      int lt = tg * 16 + i;
      float ga = sG[lt * 132 + c] + ba, gi = sG[lt * 132 + 64 + c] + bi;
      float rr = 1.f / (1.f + expf(-ga)), ii = 1.f / (1.f + expf(-gi));
      float la = -8.0f * rr * sp;
      float a = expf(la);
      float u = sqrtf(-expm1f(2.f * la)) * ii * sXc[lt * 64 + c];
      sG[lt * 132 + c] = a; sG[lt * 132 + 64 + c] = u;
    }
    __syncthreads();
    if (tid < 64) {
      for (int s = 0; s < 64; s++) {
        int lt = d ? 63 - s : s;
        float a = sG[lt * 132 + c], u = sG[lt * 132 + 64 + c];
        hst = a * hst + u; Pp *= a;
        size_t o = ((size_t)d * NTOK + t0 + sub * 64 + lt) * 512 + chn;
        p.hs[o] = f2bf(hst); p.Pc[o] = f2bf(Pp);
      }
    }
    __syncthreads();
  }
  if (tid < 64) {
    p.hend[(d * 32 + ch) * 512 + chn] = hst; p.Pend[(d * 32 + ch) * 512 + chn] = Pp;
    if (ch < 16) p.out[(size_t)NTOK * DM + 16 * 2 * 256 * 256 + 16 * 2 * 256 * 64 + ((ch * 2 + l) * 2 + d) * 512 + chn] = hst;
  }
}

#define CMT 16
DI void cm_item(const Params& p, int l, int item, char* smem) {
  int t0 = item * CMT, seq_t0, T;
  if (t0 < NCTX) { seq_t0 = (t0 >> 8) << 8; T = 256; } else { seq_t0 = NCTX + (((t0 - NCTX) >> 10) << 10); T = 1024; }
  int p0 = t0 - seq_t0;
  unsigned* sGlu = (unsigned*)smem;
  float* red = (float*)(sGlu + (CMT + 30) * 256);
  float* red2 = red + 256;
  const int tid = opaque(threadIdx.x), wave = tid >> 6, lane = tid & 63;
#pragma unroll 8
  for (int rr = 0; rr < CMT + 30; rr++) {
    int pos = p0 - 15 + rr;
    unsigned v = 0;
    if (pos >= 0 && pos < T) {
      const float* zr = p.z + (size_t)(seq_t0 + pos) * INW + OFF_ZC;
      float2 a = *(const float2*)(zr + 2 * tid), b = *(const float2*)(zr + 512 + 2 * tid);
      v = pack_bf16(a.x * sigmoidf_(b.x), a.y * sigmoidf_(b.y));
    }
    sGlu[rr * 256 + tid] = v;
  }
  __syncthreads();
  float acc0[CMT], acc1[CMT];
  {
    float2 bb = *(const float2*)(p.cm_dw_b + l * 512 + 2 * tid);
#pragma unroll
    for (int t = 0; t < CMT; t++) { acc0[t] = bb.x; acc1[t] = bb.y; }
  }
  for (int j = 0; j < 31; j++) {
    float2 w = *(const float2*)(p.cm_dw_w + (size_t)(l * 31 + j) * 512 + 2 * tid);
#pragma unroll
    for (int t = 0; t < CMT; t++) { unsigned u = sGlu[(t + j) * 256 + tid]; acc0[t] += w.x * bf_lo(u); acc1[t] += w.y * bf_hi(u); }
  }
  {
    float ks = 0.f, kss = 0.f;
#pragma unroll
    for (int t = 0; t < CMT; t++) {
      float s = wave_sum(acc0[t] + acc1[t]);
      float ss = wave_sum(acc0[t] * acc0[t] + acc1[t] * acc1[t]);
      if (lane == t) { ks = s; kss = ss; }
    }
    if (lane < CMT) { red[(wave * CMT + lane) * 2] = ks; red[(wave * CMT + lane) * 2 + 1] = kss; }
  }
  __syncthreads();
  {
    float2 lg = *(const float2*)(p.cm_ln_g + l * 512 + 2 * tid), lb = *(const float2*)(p.cm_ln_b + l * 512 + 2 * tid);
    float k2 = 0.f;
#pragma unroll
    for (int t = 0; t < CMT; t++) {
      float s = red[(0 * CMT + t) * 2] + red[(1 * CMT + t) * 2] + red[(2 * CMT + t) * 2] + red[(3 * CMT + t) * 2];
      float ss = red[(0 * CMT + t) * 2 + 1] + red[(1 * CMT + t) * 2 + 1] + red[(2 * CMT + t) * 2 + 1] + red[(3 * CMT + t) * 2 + 1];
      float mu = s * (1.f / 512.f); float var = ss * (1.f / 512.f) - mu * mu; float rstd = rsqrtf(var + 1e-5f);
      float y0 = (acc0[t] - mu) * rstd * lg.x + lb.x, y1 = (acc1[t] - mu) * rstd * lg.y + lb.y;
      y0 = y0 * sigmoidf_(y0); y1 = y1 * sigmoidf_(y1);
      acc0[t] = y0; acc1[t] = y1;
      float s2 = wave_sum(y0 * y0 + y1 * y1);
      if (lane == t) k2 = s2;
    }
    if (lane < CMT) red2[wave * CMT + lane] = k2;
  }
  __syncthreads();
  {
    float2 gg = *(const float2*)(p.grp_g + l * DM + 1536 + 2 * tid);
#pragma unroll
    for (int t = 0; t < CMT; t++) {
      float tot = red2[t] + red2[CMT + t] + red2[2 * CMT + t] + red2[3 * CMT + t];
      float rinv = rsqrtf(tot * (1.f / 512.f) + 1e-6f);
      *(unsigned*)(p.mixed + (size_t)(t0 + t) * DM + 1536 + 2 * tid) = pack_bf16(acc0[t] * rinv * gg.x, acc1[t] * rinv * gg.y);
    }
  }
  __syncthreads();
}

DI void post_inproj_tokens(const Params& p, int l) {
  int tidq = opaque(threadIdx.x); int lane = tidq & 63, gw = blockIdx.x * 4 + (tidq >> 6), nw = gridDim.x * 4;
  float* new_ckv = p.out + (size_t)NTOK * DM;
  float* new_krope = new_ckv + 16 * 2 * 256 * 256;
  for (int t = gw; t < NTOK + 2048; t += nw) {
    if (t >= NTOK) {
      int rr = t - NTOK; int b = rr >> 9, j = rr & 511;
      float4 v = *(const float4*)(p.cache_ckv + ((size_t)(b * 2 + l) * 512 + j) * 256 + lane * 4);
      uint2 o; o.x = pack_bf16(v.x, v.y); o.y = pack_bf16(v.z, v.w);
      *(uint2*)(p.ckv + (size_t)(NCTX + b * 1536 + j) * 256 + lane * 4) = o;
      continue;
    }
    const float* zr = p.z + (size_t)t * INW;
    {
      float4 a = *(const float4*)(zr + lane * 4), b = *(const float4*)(zr + 256 + lane * 4);
      float ss = a.x * a.x + a.y * a.y + a.z * a.z + a.w * a.w + b.x * b.x + b.y * b.y + b.z * b.z + b.w * b.w;
      ss = wave_sum(ss);
      float rinv = rsqrtf(ss * (1.f / 512.f) + 1e-6f);
      float4 g0 = *(const float4*)(p.mla_qa_g + l * 512 + lane * 4), g1 = *(const float4*)(p.mla_qa_g + l * 512 + 256 + lane * 4);
      uint2 o0, o1;
      o0.x = pack_bf16(a.x * rinv * g0.x, a.y * rinv * g0.y); o0.y = pack_bf16(a.z * rinv * g0.z, a.w * rinv * g0.w);
      o1.x = pack_bf16(b.x * rinv * g1.x, b.y * rinv * g1.y); o1.y = pack_bf16(b.z * rinv * g1.z, b.w * rinv * g1.w);
      *(uint2*)(p.qa + (size_t)t * 512 + lane * 4) = o0;
      *(uint2*)(p.qa + (size_t)t * 512 + 256 + lane * 4) = o1;
    }
    {
      float4 a = *(const float4*)(zr + OFF_ZKV + lane * 4);
      float ss = wave_sum(a.x * a.x + a.y * a.y + a.z * a.z + a.w * a.w);
      float rinv = rsqrtf(ss * (1.f / 256.f) + 1e-6f);
      float4 g = *(const float4*)(p.mla_kva_g + l * 256 + lane * 4);
      float4 o = make_float4(a.x * rinv * g.x, a.y * rinv * g.y, a.z * rinv * g.z, a.w * rinv * g.w);
      uint2 ob; ob.x = pack_bf16(o.x, o.y); ob.y = pack_bf16(o.z, o.w);
      *(uint2*)(p.ckv + (size_t)kvrow_of_token(t) * 256 + lane * 4) = ob;
      if (t < NCTX) {
        int b = t >> 8, pos = t & 255;
        *(float4*)(new_ckv + ((size_t)(b * 2 + l) * 256 + pos) * 256 + lane * 4) = o;
        new_krope[((size_t)(b * 2 + l) * 256 + pos) * 64 + lane] = zr[OFF_ZKR + lane];
      }
    }
  }
}

DI void qnorm_tokens(const Params& p, int l) {
  int tidq = opaque(threadIdx.x); int lane = tidq & 63, gw = blockIdx.x * 4 + (tidq >> 6), nw = gridDim.x * 4;
  const float qscale = 0.07216878364870322f * 1.4426950408889634f;
  const float* g = p.mla_q_g + l * 192;
  float g0 = g[lane], g1 = g[64 + lane], g2 = g[128 + lane];
  for (int t = gw; t < NTOK; t += nw) {
    const ushort_t* qr = p.qraw + (size_t)t * 1536;
    bool lat = t >= NCTX; int pos = (t - NCTX) & 1023;
    float cs = 1.f, sn = 0.f;
    if (lat) { cs = p.rope[pos * 64 + (lane & 31)]; sn = p.rope[pos * 64 + 32 + (lane & 31)]; }
#pragma unroll
    for (int hh = 0; hh < 8; hh++) {
      float a = __uint_as_float((unsigned)qr[hh * 192 + lane] << 16), b = __uint_as_float((unsigned)qr[hh * 192 + 64 + lane] << 16), c = __uint_as_float((unsigned)qr[hh * 192 + 128 + lane] << 16);
      float ss = wave_sum(a * a + b * b + c * c);
      float rinv = rsqrtf(ss * (1.f / 192.f) + 1e-6f);
      a *= rinv * g0; b *= rinv * g1; c *= rinv * g2;
      if (lat) {
        float o = __shfl_xor(c, 32);
        c = (lane < 32) ? (c * cs - o * sn) : (o * sn + c * cs);
      }
      ushort_t* qo = p.Q + (size_t)t * 1536 + hh * 192;
      qo[lane] = f2bf(a * qscale); qo[64 + lane] = f2bf(b * qscale); qo[128 + lane] = f2bf(c * qscale);
    }
  }
}

DI void kv_item(const Params& p, int l, int item, char* smem) {
  int rt = item >> 3, hh = item & 7;
  int row0 = rt * 64;
  const int tid = opaque(threadIdx.x), wave = tid >> 6, lane = tid & 63;
  float* tile = (float*)smem;
  const float* g = p.mla_k_g + l * 192;
  float g0 = g[lane], g1 = g[64 + lane], g2 = g[128 + lane];
#pragma unroll 4
  for (int i = 0; i < 16; i++) {
    int lr = wave * 16 + i; int row = row0 + lr;
    const float* kr_src; bool rot = false; int pos = 0;
    if (row < NCTX) { kr_src = p.z + (size_t)row * INW + OFF_ZKR; }
    else {
      int rr = row - NCTX; int b = rr / 1536, j = rr % 1536;
      if (j < 512) kr_src = p.cache_krope + ((size_t)(b * 2 + l) * 512 + j) * 64;
      else { pos = j - 512; kr_src = p.z + (size_t)(NCTX + b * 1024 + pos) * INW + OFF_ZKR; rot = true; }
    }
    const ushort_t* kv = p.kvraw + (size_t)row * 2048 + hh * 256;
    float a = __uint_as_float((unsigned)kv[lane] << 16), b2 = __uint_as_float((unsigned)kv[64 + lane] << 16), c = kr_src[lane];
    float ss = wave_sum(a * a + b2 * b2 + c * c);
    float rinv = rsqrtf(ss * (1.f / 192.f) + 1e-6f);
    a *= rinv * g0; b2 *= rinv * g1; c *= rinv * g2;
    if (rot) {
      float cs = p.rope[pos * 64 + (lane & 31)], sn = p.rope[pos * 64 + 32 + (lane & 31)];
      float o = __shfl_xor(c, 32);
      c = (lane < 32) ? (c * cs - o * sn) : (o * sn + c * cs);
    }
    ushort_t* ko = p.K + (size_t)row * 1536 + hh * 192;
    ko[lane] = f2bf(a); ko[64 + lane] = f2bf(b2); ko[128 + lane] = f2bf(c);
    tile[lr * 129 + lane] = __uint_as_float((unsigned)kv[128 + lane] << 16); tile[lr * 129 + 64 + lane] = __uint_as_float((unsigned)kv[192 + lane] << 16);
  }
  __syncthreads();
  size_t vbase; int T, krow0;
  if (row0 < NCTX) { int sid = row0 >> 8; vbase = (size_t)(sid * 8 + hh) * 128 * 256; T = 256; krow0 = row0 & 255; }
  else { int rr = row0 - NCTX; int b = rr / 1536; vbase = (size_t)16 * 8 * 128 * 256 + (size_t)(b * 8 + hh) * 128 * 1536; T = 1536; krow0 = rr % 1536; }
#pragma unroll
  for (int i = 0; i < 4; i++) {
    int cidx = tid + i * 256; int dv = cidx >> 3, kg = cidx & 7;
    int G = kg >> 1, hhalf = kg & 1;
    float v[8];
#pragma unroll
    for (int s = 0; s < 8; s++) { int key = 16 * G + 8 * (s >> 2) + 4 * hhalf + (s & 3); v[s] = tile[key * 129 + dv]; }
    uint4 o; o.x = pack_bf16(v[0], v[1]); o.y = pack_bf16(v[2], v[3]); o.z = pack_bf16(v[4], v[5]); o.w = pack_bf16(v[6], v[7]);
    *(uint4*)(p.Vt + vbase + (size_t)dv * T + krow0 + kg * 8) = o;
  }
  __syncthreads();
}

#define KLD 200
#define VLD 72
DI void attn_item(const Params& p, int item, char* smem) {
  const int tid = opaque(threadIdx.x), wave = tid >> 6, lane = tid & 63;
  const int qs = wave & 1, kh = wave >> 1;
  int hh, Tk, tq0, kvbase; size_t vbase;
  if (item < 512) {
    int b = item >> 7; hh = (item >> 4) & 7; int qb = item & 15;
    Tk = 1536; tq0 = NCTX + b * 1024 + qb * 64; kvbase = NCTX + b * 1536;
    vbase = (size_t)16 * 8 * 128 * 256 + (size_t)(b * 8 + hh) * 128 * 1536;
  } else {
    int i2 = item - 512; int s = i2 >> 5; hh = (i2 >> 2) & 7; int qb = i2 & 3;
    Tk = 256; tq0 = s * 256 + qb * 64; kvbase = s * 256;
    vbase = (size_t)(s * 8 + hh) * 128 * 256;
  }
  ushort_t* sK = (ushort_t*)smem;
  ushort_t* sV = sK + 64 * KLD;
  const int r = lane & 31, h = lane >> 5;
  bf16x8 qf[12];
  {
    const ushort_t* qp = p.Q + (size_t)(tq0 + qs * 32 + r) * 1536 + hh * 192 + h * 8;
#pragma unroll
    for (int s = 0; s < 12; s++) qf[s] = *(const bf16x8*)(qp + s * 16);
  }
  f32x16 O[4];
#pragma unroll
  for (int i = 0; i < 4; i++)
#pragma unroll
    for (int e = 0; e < 16; e++) O[i][e] = 0.f;
  float m = -INFINITY, lsum = 0.f;
  const int nkt = Tk >> 6;
  const ushort_t* Kg = p.K + (size_t)kvbase * 1536 + hh * 192;
  const ushort_t* Vg = p.Vt + vbase;
  u32x4 rk[6], rv[4];
#pragma unroll
  for (int i = 0; i < 6; i++) { int c = tid + i * 256; int row = c / 24, kc = (c % 24) * 8; rk[i] = GLD16(Kg + (size_t)row * 1536 + kc); }
#pragma unroll
  for (int i = 0; i < 4; i++) { int c = tid + i * 256; int dv = c >> 3, kc = (c & 7) * 8; rv[i] = GLD16(Vg + (size_t)dv * Tk + kc); }
  for (int kt = 0; kt < nkt; kt++) {
    __syncthreads();
#pragma unroll
    for (int i = 0; i < 6; i++) { int c = tid + i * 256; int row = c / 24, kc = (c % 24) * 8; *(u32x4*)(sK + row * KLD + kc) = rk[i]; }
#pragma unroll
    for (int i = 0; i < 4; i++) { int c = tid + i * 256; int dv = c >> 3, kc = (c & 7) * 8; *(u32x4*)(sV + dv * VLD + kc) = rv[i]; }
    __syncthreads();
    if (kt + 1 < nkt) {
#pragma unroll
      for (int i = 0; i < 6; i++) { int c = tid + i * 256; int row = c / 24, kc = (c % 24) * 8; rk[i] = GLD16(Kg + (size_t)((kt + 1) * 64 + row) * 1536 + kc); }
#pragma unroll
      for (int i = 0; i < 4; i++) { int c = tid + i * 256; int dv = c >> 3, kc = (c & 7) * 8; rv[i] = GLD16(Vg + (size_t)dv * Tk + (kt + 1) * 64 + kc); }
    }
    f32x16 S;
#pragma unroll
    for (int e = 0; e < 16; e++) S[e] = 0.f;
    const ushort_t* kp = sK + (kh * 32 + r) * KLD + h * 8;
#pragma unroll
    for (int s = 0; s < 12; s++) { bf16x8 kf = *(const bf16x8*)(kp + s * 16); S = MFMA32(kf, qf[s], S); }
    float mx = S[0];
#pragma unroll
    for (int e = 1; e < 16; e++) mx = fmaxf(mx, S[e]);
    mx = fmaxf(mx, __shfl_xor(mx, 32));
    float mn = fmaxf(m, mx);
    float alpha = exp2f(m - mn);
    float rs = 0.f;
#pragma unroll
    for (int e = 0; e < 16; e++) { S[e] = exp2f(S[e] - mn); rs += S[e]; }
    rs += __shfl_xor(rs, 32);
    lsum = lsum * alpha + rs; m = mn;
#pragma unroll
    for (int i = 0; i < 4; i++)
#pragma unroll
      for (int e = 0; e < 16; e++) O[i][e] *= alpha;
    bf16x8 pf[2];
#pragma unroll
    for (int s2 = 0; s2 < 2; s2++) {
      u32x4 u; u.x = pack_bf16(S[8 * s2], S[8 * s2 + 1]); u.y = pack_bf16(S[8 * s2 + 2], S[8 * s2 + 3]);
      u.z = pack_bf16(S[8 * s2 + 4], S[8 * s2 + 5]); u.w = pack_bf16(S[8 * s2 + 6], S[8 * s2 + 7]);
      pf[s2] = __builtin_bit_cast(bf16x8, u);
    }
    const ushort_t* vp = sV + r * VLD + kh * 32 + h * 8;
#pragma unroll
    for (int dt = 0; dt < 4; dt++)
#pragma unroll
      for (int s2 = 0; s2 < 2; s2++) {
        bf16x8 vf = *(const bf16x8*)(vp + dt * 32 * VLD + s2 * 16);
        O[dt] = MFMA32(vf, pf[s2], O[dt]);
      }
  }
  __syncthreads();
  float* cO = (float*)smem;
  float* cML = cO + 2 * 64 * 64;
  if (kh == 1) {
#pragma unroll
    for (int dt = 0; dt < 4; dt++)
#pragma unroll
      for (int e = 0; e < 16; e++) cO[(qs * 64 + dt * 16 + e) * 64 + lane] = O[dt][e];
    cML[(qs * 2 + 0) * 64 + lane] = m; cML[(qs * 2 + 1) * 64 + lane] = lsum;
  }
  __syncthreads();
  if (kh == 0) {
    float m1 = cML[(qs * 2 + 0) * 64 + lane], l1 = cML[(qs * 2 + 1) * 64 + lane];
    float mf = fmaxf(m, m1);
    float a0 = exp2f(m - mf), a1 = exp2f(m1 - mf);
    float inv = 1.f / (lsum * a0 + l1 * a1);
    a0 *= inv; a1 *= inv;
    ushort_t* op = p.attn + (size_t)(tq0 + qs * 32 + r) * 1024 + hh * 128;
#pragma unroll
    for (int dt = 0; dt < 4; dt++)
#pragma unroll
      for (int gq = 0; gq < 4; gq++) {
        float o0 = O[dt][4 * gq] * a0 + cO[(qs * 64 + dt * 16 + 4 * gq) * 64 + lane] * a1;
        float o1 = O[dt][4 * gq + 1] * a0 + cO[(qs * 64 + dt * 16 + 4 * gq + 1) * 64 + lane] * a1;
        float o2 = O[dt][4 * gq + 2] * a0 + cO[(qs * 64 + dt * 16 + 4 * gq + 2) * 64 + lane] * a1;
        float o3 = O[dt][4 * gq + 3] * a0 + cO[(qs * 64 + dt * 16 + 4 * gq + 3) * 64 + lane] * a1;
        uint2 ov; ov.x = pack_bf16(o0, o1); ov.y = pack_bf16(o2, o3); *(uint2*)(op + dt * 32 + 8 * gq + 4 * h) = ov;
      }
  }
  __syncthreads();
}

DI void merge_tokens(const Params& p, int l) {
  int tidq = opaque(threadIdx.x); int lane = tidq & 63, gw = blockIdx.x * 4 + (tidq >> 6), nw = gridDim.x * 4;
  const float* gg = p.grp_g + l * DM;
  for (int t = gw; t < NTOK; t += nw) {
    {
      const ushort_t* ar = p.attn + (size_t)t * 1024;
      float4 v[4]; float ss = 0.f;
#pragma unroll
      for (int j = 0; j < 4; j++) { uint2 u_ = *(const uint2*)(ar + j * 256 + lane * 4); v[j] = make_float4(bf_lo(u_.x), bf_hi(u_.x), bf_lo(u_.y), bf_hi(u_.y)); ss += v[j].x * v[j].x + v[j].y * v[j].y + v[j].z * v[j].z + v[j].w * v[j].w; }
      ss = wave_sum(ss);
      float rinv = rsqrtf(ss * (1.f / 1024.f) + 1e-6f);
#pragma unroll
      for (int j = 0; j < 4; j++) {
        int col = j * 256 + lane * 4; float4 g = *(const float4*)(gg + col);
        uint2 o; o.x = pack_bf16(v[j].x * rinv * g.x, v[j].y * rinv * g.y); o.y = pack_bf16(v[j].z * rinv * g.z, v[j].w * rinv * g.w);
        *(uint2*)(p.mixed + (size_t)t * DM + col) = o;
      }
    }
    {
      float val[8]; float ss = 0.f;
      int ch = t >> 8;
#pragma unroll
      for (int j = 0; j < 2; j++) {
        int col = j * 256 + lane * 4;
        float cf[4] = {0, 0, 0, 0}, cbk[4] = {0, 0, 0, 0};
        if (t >= NCTX) {
          int b = (t - NCTX) >> 10, cc = (ch - 16) & 3, chb = 16 + b * 4;
          float4 h0f = *(const float4*)(p.state_lru + ((size_t)(b * 2 + l) * 2 + 0) * 512 + col);
          float4 h0b = *(const float4*)(p.state_lru + ((size_t)(b * 2 + l) * 2 + 1) * 512 + col);
          cf[0] = h0f.x; cf[1] = h0f.y; cf[2] = h0f.z; cf[3] = h0f.w;
          cbk[0] = h0b.x; cbk[1] = h0b.y; cbk[2] = h0b.z; cbk[3] = h0b.w;
          for (int jj = 0; jj < cc; jj++) {
            float4 he = *(const float4*)(p.hend + (size_t)(0 * 32 + chb + jj) * 512 + col), pe = *(const float4*)(p.Pend + (size_t)(0 * 32 + chb + jj) * 512 + col);
            cf[0] = he.x + pe.x * cf[0]; cf[1] = he.y + pe.y * cf[1]; cf[2] = he.z + pe.z * cf[2]; cf[3] = he.w + pe.w * cf[3];
          }
          for (int jj = 3; jj > cc; jj--) {
            float4 he = *(const float4*)(p.hend + (size_t)(1 * 32 + chb + jj) * 512 + col), pe = *(const float4*)(p.Pend + (size_t)(1 * 32 + chb + jj) * 512 + col);
            cbk[0] = he.x + pe.x * cbk[0]; cbk[1] = he.y + pe.y * cbk[1]; cbk[2] = he.z + pe.z * cbk[2]; cbk[3] = he.w + pe.w * cbk[3];
          }
        }
        uint2 uhf = *(const uint2*)(p.hs + ((size_t)0 * NTOK + t) * 512 + col), upf = *(const uint2*)(p.Pc + ((size_t)0 * NTOK + t) * 512 + col);
        uint2 uhb = *(const uint2*)(p.hs + ((size_t)1 * NTOK + t) * 512 + col), upb = *(const uint2*)(p.Pc + ((size_t)1 * NTOK + t) * 512 + col);
        float4 hf_ = make_float4(bf_lo(uhf.x), bf_hi(uhf.x), bf_lo(uhf.y), bf_hi(uhf.y)), pf_ = make_float4(bf_lo(upf.x), bf_hi(upf.x), bf_lo(upf.y), bf_hi(upf.y));
        float4 hb_ = make_float4(bf_lo(uhb.x), bf_hi(uhb.x), bf_lo(uhb.y), bf_hi(uhb.y)), pb_ = make_float4(bf_lo(upb.x), bf_hi(upb.x), bf_lo(upb.y), bf_hi(upb.y));
        float4 zg = *(const float4*)(p.z + (size_t)t * INW + OFF_ZG + col);
        float y0 = hf_.x + pf_.x * cf[0] + hb_.x + pb_.x * cbk[0];
        float y1 = hf_.y + pf_.y * cf[1] + hb_.y + pb_.y * cbk[1];
        float y2 = hf_.z + pf_.z * cf[2] + hb_.z + pb_.z * cbk[2];
        float y3 = hf_.w + pf_.w * cf[3] + hb_.w + pb_.w * cbk[3];
        y0 *= gelu_tanh(zg.x); y1 *= gelu_tanh(zg.y); y2 *= gelu_tanh(zg.z); y3 *= gelu_tanh(zg.w);
        val[j * 4] = y0; val[j * 4 + 1] = y1; val[j * 4 + 2] = y2; val[j * 4 + 3] = y3;
        ss += y0 * y0 + y1 * y1 + y2 * y2 + y3 * y3;
      }
      ss = wave_sum(ss);
      float rinv = rsqrtf(ss * (1.f / 512.f) + 1e-6f);
#pragma unroll
      for (int j = 0; j < 2; j++) {
        int col = j * 256 + lane * 4; float4 g = *(const float4*)(gg + 1024 + col);
        uint2 o; o.x = pack_bf16(val[j * 4] * rinv * g.x, val[j * 4 + 1] * rinv * g.y); o.y = pack_bf16(val[j * 4 + 2] * rinv * g.z, val[j * 4 + 3] * rinv * g.w);
        *(uint2*)(p.mixed + (size_t)t * DM + 1024 + col) = o;
      }
    }
  }
}

#define TOPK_INS(TV, TI, XV, XI) { float xv_ = (XV); int xi_ = (XI); _Pragma("unroll") for (int i_ = 0; i_ < 16; i_++) { bool c_ = xv_ > TV[i_]; float nv_ = c_ ? xv_ : TV[i_]; float ov_ = c_ ? TV[i_] : xv_; int ni_ = c_ ? xi_ : TI[i_]; int oi_ = c_ ? TI[i_] : xi_; TV[i_] = nv_; TI[i_] = ni_; xv_ = ov_; xi_ = oi_; } }
DI void peer_phase(const Params& p, int l, char* smem) {
  const int tid = opaque(threadIdx.x), wave = tid >> 6, lane = tid & 63;
  float* wsm = (float*)(smem + wave * 12288);
  float* lv = wsm;
  int* lidx = (int*)(wsm + 1024);
  int* pki = (int*)(wsm + 2048);
  float* pkg = wsm + 2560;
  const float* scores = p.z;
  const unsigned char* Ub = p.Ub + (size_t)l * NEXP * DM;
  const unsigned char* Vb = p.Vb + (size_t)l * NEXP * DM;
  const float* Us = p.Us + l * NEXP;
  const float* Vs = p.Vs + l * NEXP;
  float* dst = l == 0 ? p.xA : p.out;
  for (int tb = blockIdx.x; tb < NTOK / 16; tb += gridDim.x) {
    const int tg = tb * 4 + wave;
    {
      const GAS f32x4* sp = (const GAS f32x4*)(scores + (size_t)(tg * 4 + (lane >> 4)) * 2048 + (lane & 15) * 128);
      float tv[16]; int ti[16];
#pragma unroll
      for (int i = 0; i < 16; i++) { tv[i] = -INFINITY; ti[i] = 0; }
      for (int k = 0; k < 128; k += 8) {
        float x[8];
        { f32x4 xa_ = sp[k >> 2], xb_ = sp[(k >> 2) + 1]; x[0] = xa_[0]; x[1] = xa_[1]; x[2] = xa_[2]; x[3] = xa_[3]; x[4] = xb_[0]; x[5] = xb_[1]; x[6] = xb_[2]; x[7] = xb_[3]; }
#pragma unroll
        for (int u = 0; u < 8; u++) TOPK_INS(tv, ti, x[u], k + u);
      }
#pragma unroll
      for (int i = 0; i < 16; i++) { lv[i * 64 + lane] = tv[i]; lidx[i * 64 + lane] = ti[i]; }
    }
    __syncthreads();
    if (lane < 32) {
      const int tt = lane >> 3, hh = lane & 7;
      const int la = tt * 16 + 2 * hh, lb = la + 1;
      float s1[16], s2[16];
#pragma unroll
      for (int i = 0; i < 16; i++) { s1[i] = lv[i * 64 + la]; s2[i] = lv[i * 64 + lb]; }
      float cv[16]; int cf[16];
#pragma unroll
      for (int i = 0; i < 16; i++) { cv[i] = -INFINITY; cf[i] = 0; }
#pragma unroll
      for (int i = 0; i < 16; i++) {
#pragma unroll
        for (int j = 0; j < 16; j++) {
          if ((i + 1) * (j + 1) <= 16) TOPK_INS(cv, cf, s1[i] + s2[j], i * 16 + j);
        }
      }
      float e[16]; float sum = 0.f;
#pragma unroll
      for (int r = 0; r < 16; r++) { e[r] = __expf(cv[r] - cv[0]); sum += e[r]; }
      const float inv = 1.f / sum;
#pragma unroll
      for (int r = 0; r < 16; r++) {
        int id = lidx[(cf[r] >> 4) * 64 + la] * 128 + lidx[(cf[r] & 15) * 64 + lb];
        pki[tt * 128 + hh * 16 + r] = id; pkg[tt * 128 + hh * 16 + r] = e[r] * inv;
      }
    }
    __syncthreads();
    for (int tt = 0; tt < 4; tt++) {
    const int t = tg * 4 + tt;
    const int idx0 = pki[tt * 128 + lane], idx1 = pki[tt * 128 + 64 + lane];
    const float g0 = pkg[tt * 128 + lane], g1 = pkg[tt * 128 + 64 + lane];
    float xs[32];
#pragma unroll
    for (int j = 0; j < 2; j++) {
      const uint4* xp = (const uint4*)(p.hn + (size_t)t * DM + (j * 64 + lane) * 16);
      uint4 xa = xp[0], xb = xp[1];
      xs[j * 16 + 0] = bf_lo(xa.x); xs[j * 16 + 1] = bf_hi(xa.x); xs[j * 16 + 2] = bf_lo(xa.y); xs[j * 16 + 3] = bf_hi(xa.y);
      xs[j * 16 + 4] = bf_lo(xa.z); xs[j * 16 + 5] = bf_hi(xa.z); xs[j * 16 + 6] = bf_lo(xa.w); xs[j * 16 + 7] = bf_hi(xa.w);
      xs[j * 16 + 8] = bf_lo(xb.x); xs[j * 16 + 9] = bf_hi(xb.x); xs[j * 16 + 10] = bf_lo(xb.y); xs[j * 16 + 11] = bf_hi(xb.y);
      xs[j * 16 + 12] = bf_lo(xb.z); xs[j * 16 + 13] = bf_hi(xb.z); xs[j * 16 + 14] = bf_lo(xb.w); xs[j * 16 + 15] = bf_hi(xb.w);
    }
    const float us0 = Us[idx0], us1 = Us[idx1], vs0 = Vs[idx0], vs1 = Vs[idx1];
    float a0 = 0.f, a1 = 0.f;
    {
      u32x4 ld[8][2];
#pragma unroll
      for (int rr = 0; rr < 8; rr++) {
        int idx = __builtin_amdgcn_readlane(idx0, rr);
        const unsigned char* row = Ub + (size_t)idx * DM;
#pragma unroll
        for (int j = 0; j < 2; j++) ld[rr][j] = GLD16(row + (j * 64 + lane) * 16);
      }
      for (int k0 = 0; k0 < 128; k0 += 8) {
        int nsrc = (k0 + 8 < 64) ? idx0 : idx1;
        float part[8];
#pragma unroll
        for (int rr = 0; rr < 8; rr++) {
          float s = 0.f;
#pragma unroll
          for (int j = 0; j < 2; j++)
#pragma unroll
            for (int q = 0; q < 4; q++) {
              f32x2_t lo = __builtin_amdgcn_cvt_pk_f32_fp8((int)ld[rr][j][q], false);
              f32x2_t hi = __builtin_amdgcn_cvt_pk_f32_fp8((int)ld[rr][j][q], true);
              s += lo[0] * xs[j * 16 + q * 4] + lo[1] * xs[j * 16 + q * 4 + 1] + hi[0] * xs[j * 16 + q * 4 + 2] + hi[1] * xs[j * 16 + q * 4 + 3];
            }
          part[rr] = s;
          if (k0 + 8 < 128) {
            int idx = __builtin_amdgcn_readlane(nsrc, (k0 + 8 + rr) & 63);
            const unsigned char* row = Ub + (size_t)idx * DM;
#pragma unroll
            for (int j = 0; j < 2; j++) ld[rr][j] = GLD16(row + (j * 64 + lane) * 16);
          }
        }
#pragma unroll
        for (int o = 32; o; o >>= 1) {
#pragma unroll
          for (int rr = 0; rr < 8; rr++) part[rr] += __shfl_xor(part[rr], o);
        }
#pragma unroll
        for (int rr = 0; rr < 8; rr++) {
          if (lane == ((k0 + rr) & 63)) { if (k0 < 64) a0 = part[rr]; else a1 = part[rr]; }
        }
      }
    }
    float w0 = g0 * gelu_tanh(a0 * us0) * vs0, w1 = g1 * gelu_tanh(a1 * us1) * vs1;
    float acc[32];
#pragma unroll
    for (int e = 0; e < 32; e++) acc[e] = 0.f;
    {
      u32x4 ld[4][2];
#pragma unroll
      for (int rr = 0; rr < 4; rr++) {
        int idx = __builtin_amdgcn_readlane(idx0, rr);
        const unsigned char* row = Vb + (size_t)idx * DM;
#pragma unroll
        for (int j = 0; j < 2; j++) ld[rr][j] = GLD16(row + (j * 64 + lane) * 16);
      }
      for (int k0 = 0; k0 < 128; k0 += 4) {
        float wsrc = (k0 < 64) ? w0 : w1;
        int nsrc = (k0 + 4 < 64) ? idx0 : idx1;
#pragma unroll
        for (int rr = 0; rr < 4; rr++) {
          float w = rdlane_f(wsrc, (k0 + rr) & 63);
#pragma unroll
          for (int j = 0; j < 2; j++)
#pragma unroll
            for (int q = 0; q < 4; q++) {
              f32x2_t lo = __builtin_amdgcn_cvt_pk_f32_fp8((int)ld[rr][j][q], false);
              f32x2_t hi = __builtin_amdgcn_cvt_pk_f32_fp8((int)ld[rr][j][q], true);
              acc[j * 16 + q * 4 + 0] += w * lo[0]; acc[j * 16 + q * 4 + 1] += w * lo[1];
              acc[j * 16 + q * 4 + 2] += w * hi[0]; acc[j * 16 + q * 4 + 3] += w * hi[1];
            }
          if (k0 + 4 < 128) {
            int idx = __builtin_amdgcn_readlane(nsrc, (k0 + 4 + rr) & 63);
            const unsigned char* row = Vb + (size_t)idx * DM;
#pragma unroll
            for (int j = 0; j < 2; j++) ld[rr][j] = GLD16(row + (j * 64 + lane) * 16);
          }
        }
      }
    }
    const float* md = p.mod + (size_t)(l * 5 + cvidx(t)) * 12288 + 10240;
    float ssq = 0.f;
#pragma unroll
    for (int j = 0; j < 2; j++)
#pragma unroll
      for (int q = 0; q < 4; q++) {
        int col = (j * 64 + lane) * 16 + q * 4;
        float4 xa = *(const float4*)(p.x1 + (size_t)t * DM + col);
        float4 ga = *(const float4*)(md + col);
        float4 oa = make_float4(xa.x + ga.x * acc[j * 16 + q * 4], xa.y + ga.y * acc[j * 16 + q * 4 + 1], xa.z + ga.z * acc[j * 16 + q * 4 + 2], xa.w + ga.w * acc[j * 16 + q * 4 + 3]);
        *(float4*)(dst + (size_t)t * DM + col) = oa;
        acc[j * 16 + q * 4] = oa.x; acc[j * 16 + q * 4 + 1] = oa.y; acc[j * 16 + q * 4 + 2] = oa.z; acc[j * 16 + q * 4 + 3] = oa.w;
        ssq += oa.x * oa.x + oa.y * oa.y + oa.z * oa.z + oa.w * oa.w;
      }
    if (l == 0) {
      ssq = wave_sum(ssq);
      const float rinv = rsqrtf(ssq * (1.f / DM) + 1e-6f);
      const float* g = p.norm_mix_g + DM;
      const float* md1 = p.mod + (size_t)(5 + cvidx(t)) * 12288;
#pragma unroll
      for (int j = 0; j < 2; j++)
#pragma unroll
        for (int q = 0; q < 4; q++) {
          int col = (j * 64 + lane) * 16 + q * 4;
          float4 gg = *(const float4*)(g + col), sc = *(const float4*)(md1 + 2048 + col), sh = *(const float4*)(md1 + col);
          float y0 = acc[j * 16 + q * 4] * rinv * gg.x * (1.f + sc.x) + sh.x;
          float y1 = acc[j * 16 + q * 4 + 1] * rinv * gg.y * (1.f + sc.y) + sh.y;
          float y2 = acc[j * 16 + q * 4 + 2] * rinv * gg.z * (1.f + sc.z) + sh.z;
          float y3 = acc[j * 16 + q * 4 + 3] * rinv * gg.w * (1.f + sc.w) + sh.w;
          uint2 o; o.x = pack_bf16(y0, y1); o.y = pack_bf16(y2, y3);
          *(uint2*)(p.hn + (size_t)t * DM + col) = o;
        }
    }
    }
    __syncthreads();
  }
}

#define XB_TMO      128
#define XB_XCNT(j)  (256  + 64 * (j))
#define XB_XSUB(j)  (1280 + 64 * (j))
#define XB_XGEN(j)  (2304 + 64 * (j))
#define XB_TOP      3328
#define XB_TOPGEN   3392
#define XCD_BAR_WORDS 3456
#define XB_SPIN_CAP (1u << 18)
#define LAS __attribute__((address_space(3)))

__device__ __forceinline__ unsigned xb_ld(unsigned* p)              { return __hip_atomic_load(p, __ATOMIC_RELAXED, __HIP_MEMORY_SCOPE_AGENT); }
__device__ __forceinline__ unsigned xb_add(unsigned* p, unsigned v) { return __hip_atomic_fetch_add(p, v, __ATOMIC_RELAXED, __HIP_MEMORY_SCOPE_AGENT); }
__device__ __forceinline__ unsigned xb_xcc_id() { return (unsigned)__builtin_amdgcn_s_getreg((3 << 11) | 20) & 0xFu; }
#define XB_SPIN(cond, bar) do { unsigned _sp = 0; while (cond) { __builtin_amdgcn_s_sleep(1); \
    if ((++_sp & 255u) == 0u) { if (xb_ld(&(bar)[XB_TMO])) break; if (_sp > XB_SPIN_CAP) { atomicAdd(&(bar)[XB_TMO], 1u); break; } } } } while (0)

struct XcdBarrier {
    unsigned* bar; unsigned x;
    volatile LAS unsigned* st;
};

__device__ __forceinline__ XcdBarrier xcd_barrier_post(unsigned* bar, volatile LAS unsigned* st) {
    XcdBarrier b; b.bar = bar; b.x = xb_xcc_id(); b.st = st;
    if (threadIdx.x == 0) (void)xb_add(&bar[XB_XCNT(b.x)], 1u);
    return b;
}
__device__ __forceinline__ void xcd_barrier_complete(unsigned* bar, unsigned x, unsigned& nloc, unsigned& nx) {
    const unsigned G = gridDim.x * gridDim.y * gridDim.z;
    unsigned sum, cnt, mine, sp = 0u;
    for (;;) {
        sum = 0u; cnt = 0u; mine = 0u;
#pragma unroll
        for (unsigned j = 0; j < 16; ++j) { const unsigned c = xb_ld(&bar[XB_XCNT(j)]); sum += c; cnt += (c > 0u) ? 1u : 0u; mine = (j == x) ? c : mine; }
        if (sum == G) break;
        __builtin_amdgcn_s_sleep(1);
        if ((++sp & 255u) == 0u) { if (xb_ld(&bar[XB_TMO])) break; if (sp > XB_SPIN_CAP) { atomicAdd(&bar[XB_TMO], 1u); break; } }
    }
    nloc = mine > 0u ? mine : 1u; nx = cnt > 0u ? cnt : 1u;
}

__device__ __forceinline__ void xcd_barrier(const XcdBarrier& b) {
    asm volatile("s_waitcnt vmcnt(0)" ::: "memory");
    __syncthreads();
    if (threadIdx.x == 0) {
        unsigned* bar;
        {
            const unsigned long long bp = (unsigned long long)b.bar;
            const unsigned lo = (unsigned)__builtin_amdgcn_readfirstlane(opaque((int)(unsigned)bp));
            const unsigned hi = (unsigned)__builtin_amdgcn_readfirstlane(opaque((int)(unsigned)(bp >> 32)));
            bar = (unsigned*)(((unsigned long long)hi << 32) | lo);
        }
        const unsigned bx = xb_xcc_id() + (unsigned)opaque(0);
        __builtin_amdgcn_s_waitcnt(0);
        unsigned nloc = b.st[0], nx = b.st[1];
        if (nloc == 0u) { xcd_barrier_complete(bar, bx, nloc, nx); b.st[0] = nloc; b.st[1] = nx; }
        const unsigned old = xb_add(&bar[XB_XSUB(bx)], 1u);
        const unsigned gen = old / nloc;
        if (old + 1u == (gen + 1u) * nloc) {
            __builtin_amdgcn_fence(__ATOMIC_RELEASE, "agent");
            asm volatile("s_waitcnt vmcnt(0)" ::: "memory");
            const unsigned og = xb_add(&bar[XB_TOP], 1u);
            const unsigned tg = og / nx;
            if (og + 1u == (tg + 1u) * nx) xb_add(&bar[XB_TOPGEN], 1u);
            else XB_SPIN(xb_ld(&bar[XB_TOPGEN]) == tg, bar);
            __builtin_amdgcn_fence(__ATOMIC_ACQUIRE, "agent");
            xb_add(&bar[XB_XGEN(bx)], 1u);
            asm volatile("s_waitcnt vmcnt(0)" ::: "memory");
        } else {
            XB_SPIN(xb_ld(&bar[XB_XGEN(bx)]) == gen, bar);
            __builtin_amdgcn_fence(__ATOMIC_ACQUIRE, "agent");
            asm volatile("s_waitcnt vmcnt(0)" ::: "memory");
        }
    }
    __syncthreads();
}


DI void gsync(unsigned* bar, unsigned& gen) {
  asm volatile("s_waitcnt vmcnt(0) lgkmcnt(0)" ::: "memory");
  __syncthreads();
  if (threadIdx.x == 0) {
    __builtin_amdgcn_fence(__ATOMIC_RELEASE, "agent");
    asm volatile("s_waitcnt vmcnt(0)" ::: "memory");
    gen++;
    const unsigned ng = gridDim.x >> 3;
    unsigned* gc = bar + 32 * (1 + (blockIdx.x & 7));
    (void)__hip_atomic_fetch_add(gc, 1u, __ATOMIC_RELAXED, __HIP_MEMORY_SCOPE_AGENT);
    if (blockIdx.x < 8) {
      const unsigned gt = gen * ng;
      while (__hip_atomic_load(gc, __ATOMIC_RELAXED, __HIP_MEMORY_SCOPE_AGENT) < gt) __builtin_amdgcn_s_sleep(1);
      (void)__hip_atomic_fetch_add(bar, 1u, __ATOMIC_RELAXED, __HIP_MEMORY_SCOPE_AGENT);
    }
    const unsigned target = gen * 8u;
    while (__hip_atomic_load(bar, __ATOMIC_RELAXED, __HIP_MEMORY_SCOPE_AGENT) < target) __builtin_amdgcn_s_sleep(4);
    __builtin_amdgcn_fence(__ATOMIC_ACQUIRE, "agent");
    asm volatile("s_waitcnt vmcnt(0)" ::: "memory");
  }
  __syncthreads();
}

DI void dump_bf16(const Params& p, const ushort_t* src) {
  size_t n = (size_t)NTOK * DM; size_t tot = n + 16 * 2 * 256 * 256 + 16 * 2 * 256 * 64 + 16 * 2 * 2 * 512;
  for (size_t i = (size_t)blockIdx.x * 256 + threadIdx.x; i < tot; i += (size_t)gridDim.x * 256)
    p.out[i] = i < n ? __uint_as_float(((unsigned)src[i]) << 16) : (i < n + 2 * 5 * 12288 ? p.mod[i - n] : 0.f);
}


DI void dump_f32(const Params& p, const float* src, size_t n) {
  size_t tot = (size_t)NTOK * DM + 16 * 2 * 256 * 256 + 16 * 2 * 256 * 64 + 16 * 2 * 2 * 512;
  for (size_t i = (size_t)blockIdx.x * 256 + threadIdx.x; i < tot; i += (size_t)gridDim.x * 256)
    p.out[i] = i < n ? src[i] : 0.f;
}

__global__ void __launch_bounds__(256, 2) fwd_megakernel(Params pk) {
  __shared__ __attribute__((aligned(16))) char smem[SMEM_BYTES];
  __shared__ __attribute__((aligned(16))) unsigned long long spw[(sizeof(Params) + 7) / 8];
  {
    const unsigned long long* ka = (const unsigned long long*)__builtin_amdgcn_kernarg_segment_ptr();
    if (threadIdx.x < (sizeof(Params) + 7) / 8) spw[threadIdx.x] = ka[threadIdx.x];
    __syncthreads();
  }
#define PP (*(const Params*)((const char*)spw + opaque(0)))
  __shared__ uint4 xb_words;
  if (threadIdx.x == 0) xb_words = make_uint4(0u, 0u, 0u, 0u);
  __syncthreads();
  const XcdBarrier xb = xcd_barrier_post(PP.bar, (volatile LAS unsigned*)&xb_words);
  const int nb = gridDim.x, bid = blockIdx.x;
  const int wave = threadIdx.x >> 6, lane = threadIdx.x & 63;

  for (int rep = 0; rep < REP_A; rep++) {
  { const Params& p = PP; prep_phase(p, smem); }
  xcd_barrier(xb);
  }

  for (int l = 0; l < 2; l++) {
    for (int rep = 0; rep < REP_D; rep++) {
    if (l == 0) { { const Params& p = PP; norm_phase(p, l, 0); } xcd_barrier(xb); }
    }
    for (int rep = 0; rep < REP_B; rep++) {
    {
      const Params& p = PP;
      const ushort_t* Bt = p.WinT + (size_t)l * INW * DM;
      float* z = p.z;
      for (int j = bid >> 3; j < 192; j += nb >> 3) {
        int mt = (bid & 7) * 8 + ((j & 63) >> 3), nt = (j >> 6) * 8 + (j & 7);
        if (nt >= 23) continue;
        gemm_tile(p.hn, DM, Bt, DM, DM, INW, mt * 128, nt * 128, smem, [&](int row, int col, float v) { z[(size_t)row * INW + col] = v; });
      }
    }
    xcd_barrier(xb);
    }
    for (int rep = 0; rep < REP_D; rep++) {
    {
      const Params& p = PP;
      for (int it = bid; it < 512 + NTOK / CMT; it += nb) {
        if (it < 512) lru_item(p, l, it, smem); else cm_item(p, l, it - 512, smem);
      }
    }
    { const Params& p = PP; post_inproj_tokens(p, l); }
    xcd_barrier(xb);
    }
    for (int rep = 0; rep < REP_B; rep++) {
    {
      const Params& p = PP;
      const ushort_t* Bq = p.WqbT + (size_t)l * 1536 * 512;
      const ushort_t* Bkv = p.WkvbT + (size_t)l * 2048 * 256;
      ushort_t* qraw = p.qraw; ushort_t* kvraw = p.kvraw;
      for (int j = bid >> 3; j < 256; j += nb >> 3) {
        if (j < 160) {
          int rem = j % 80; int mt = (bid & 7) * 10 + (rem >> 3), nt = (j / 80) * 8 + (rem & 7);
          gemm_tile(p.ckv, 256, Bkv, 256, 256, 2048, mt * 128, nt * 128, smem, [&](int row, int col, float v) { kvraw[(size_t)row * 2048 + col] = f2bf(v); });
        } else {
          int j2 = j - 160; int rem = j2 % 48; int mt = (bid & 7) * 8 + rem / 6, nt = (j2 / 48) * 6 + rem % 6;
          gemm_tile(p.qa, 512, Bq, 512, 512, 1536, mt * 128, nt * 128, smem, [&](int row, int col, float v) { qraw[(size_t)row * 1536 + col] = f2bf(v); });
        }
      }
    }
    xcd_barrier(xb);
    }
    for (int rep = 0; rep < REP_D; rep++) {
    { const Params& p = PP; for (int it = bid; it < 160 * 8; it += nb) kv_item(p, l, it, smem); }
    { const Params& p = PP; qnorm_tokens(p, l); }
    xcd_barrier(xb);
    }
    for (int rep = 0; rep < REP_D; rep++) {
    { const Params& p = PP; for (int it = bid; it < 1024; it += nb) attn_item(p, it, smem); }
    xcd_barrier(xb);
    }
    for (int rep = 0; rep < REP_D; rep++) {
    { const Params& p = PP; merge_tokens(p, l); }
    xcd_barrier(xb);
    }
    for (int rep = 0; rep < REP_B; rep++) {
    {
      const Params& p = PP;
      const ushort_t* Bt = p.WoutT + (size_t)l * DM * DM;
      float* x1 = p.x1;
      for (int j = bid >> 3; j < 128; j += nb >> 3) {
        int mt = (bid & 7) * 8 + ((j & 63) >> 3), nt = (j >> 6) * 8 + (j & 7);
        gemm_tile(p.mixed, DM, Bt, DM, DM, DM, mt * 128, nt * 128, smem, [&](int row, int col, float v) {
          const float* xr = xrow_in(p, l, row);
          float g1 = p.mod[(size_t)(l * 5 + cvidx(row)) * 12288 + 4096 + col];
          x1[(size_t)row * DM + col] = xr[col] + g1 * v;
        });
      }
    }
    xcd_barrier(xb);
    }
    for (int rep = 0; rep < REP_D; rep++) {
    { const Params& p = PP; norm_phase(p, l, 1); }
    xcd_barrier(xb);
    }
    for (int rep = 0; rep < REP_B; rep++) {
    {
      const Params& p = PP;
      const ushort_t* Bt = p.WpqT + (size_t)l * DM * DM;
      const ushort_t* Kb = p.KeysB + (size_t)l * 2048 * 128;
      float* sc = (float*)p.z;
      ushort_t* sP = (ushort_t*)smem;
      for (int j = bid >> 3; j < 128; j += nb >> 3) {
        int mt = (bid & 7) * 8 + ((j & 63) >> 3), nt = (j >> 6) * 8 + (j & 7);
        gemm_tile(p.hn, DM, Bt, DM, DM, DM, mt * 128, nt * 128, smem, [&](int row, int col, float v) { sP[(row - mt * 128) * PLD + (col - nt * 128)] = f2bf(v); });
        scores_tile(Kb + (size_t)nt * 128 * 128, sc, mt, nt, smem);
      }
    }
    xcd_barrier(xb);
    }
    for (int rep = 0; rep < REP_C; rep++) {
    { const Params& p = PP; peer_phase(p, l, smem); }
    xcd_barrier(xb);
    }
  }
}

extern "C" void kernel_launch(void* const* d_in, const int* in_sizes, int n_in, void* d_out, int out_size, void* d_ws, size_t ws_size, hipStream_t stream) {
  static int grid_blocks = 0;
  if (!grid_blocks) {
    int dev = 0, cus = 0, per_cu = 0;
    hipGetDevice(&dev);
    hipDeviceGetAttribute(&cus, hipDeviceAttributeMultiprocessorCount, dev);
    hipOccupancyMaxActiveBlocksPerMultiprocessor(&per_cu, fwd_megakernel, 256, 0);
    if (per_cu > 2) per_cu = 2;
    if (per_cu < 1) per_cu = 1;
    grid_blocks = (cus * per_cu) & ~7;
  }
  Params p{};
  const float** pin = (const float**)&p;
  for (int i = 0; i < 35; i++) pin[i] = (const float*)d_in[i];
  p.out = (float*)d_out;
  char* w = (char*)d_ws; size_t off = 0;
  auto take = [&](size_t bytes) { char* r = w + off; off += (bytes + 255) & ~(size_t)255; return r; };
  p.bar = (unsigned*)take(16384);
  p.WinT = (ushort_t*)take((size_t)2 * INW * DM * 2);
  p.WqbT = (ushort_t*)take((size_t)2 * 1536 * 512 * 2);
  p.WkvbT = (ushort_t*)take((size_t)2 * 2048 * 256 * 2);
  p.WoutT = (ushort_t*)take((size_t)2 * DM * DM * 2);
  p.WpqT = (ushort_t*)take((size_t)2 * DM * DM * 2);
  p.KeysB = (ushort_t*)take((size_t)2 * 2048 * 128 * 2);
  p.LruW = (ushort_t*)take((size_t)2 * 16 * 2 * 4096 * 2);
  p.Ub = (unsigned char*)take((size_t)2 * NEXP * DM);
  p.Vb = (unsigned char*)take((size_t)2 * NEXP * DM);
  p.Us = (float*)take((size_t)2 * NEXP * 4);
  p.Vs = (float*)take((size_t)2 * NEXP * 4);
  p.hn = (ushort_t*)take((size_t)NTOK * DM * 2);
  p.qa = (ushort_t*)take((size_t)NTOK * 512 * 2);
  p.ckv = (ushort_t*)take((size_t)NKV * 256 * 2);
  p.Q = (ushort_t*)take((size_t)NTOK * 1536 * 2);
  p.K = (ushort_t*)take((size_t)NKV * 1536 * 2);
  p.Vt = (ushort_t*)take((size_t)NKV * 1024 * 2);
  p.mixed = (ushort_t*)take((size_t)NTOK * DM * 2);
  p.z = (float*)take((size_t)NTOK * INW * 4);
  p.qraw = (ushort_t*)take((size_t)NTOK * 1536 * 2);
  p.kvraw = (ushort_t*)take((size_t)NKV * 2048 * 2);
  p.attn = (ushort_t*)take((size_t)NTOK * 1024 * 2);
  p.hs = (ushort_t*)take((size_t)2 * NTOK * 512 * 2);
  p.Pc = (ushort_t*)take((size_t)2 * NTOK * 512 * 2);
  p.hend = (float*)take((size_t)2 * 32 * 512 * 4);
  p.Pend = (float*)take((size_t)2 * 32 * 512 * 4);
  p.x1 = (float*)take((size_t)NTOK * DM * 4);
  p.xA = (float*)take((size_t)NTOK * DM * 4);
  p.mod = (float*)take((size_t)2 * 5 * 12288 * 4);
  p.rope = (float*)take((size_t)1024 * 64 * 4);
  if (off > ws_size) { fprintf(stderr, "workspace too small: need %zu have %zu\n", off, ws_size); return; }
  if (hipMemsetAsync(p.bar, 0, 16384, stream) != hipSuccess) { fprintf(stderr, "memset failed\n"); return; }
  hipLaunchKernelGGL(fwd_megakernel, dim3(grid_blocks), dim3(256), 0, stream, p);
}
```

```cpp
#include <hip/hip_runtime.h>
#include <hip/hip_cooperative_groups.h>
#include <cstdio>
#include <cstdint>
namespace cg = cooperative_groups;

typedef unsigned short ushort_t;
typedef __attribute__((ext_vector_type(8))) short bf16x8;
typedef __attribute__((ext_vector_type(16))) float f32x16;
typedef __attribute__((ext_vector_type(4))) unsigned u32x4;
typedef __attribute__((ext_vector_type(4))) float f32x4;
typedef __attribute__((ext_vector_type(2))) float f32x2_t;
typedef __attribute__((ext_vector_type(2))) __bf16 bf16x2_t;
#define DI __device__ __forceinline__
#define GAS __attribute__((address_space(1)))
#define GLD16(ptr) (*(const GAS u32x4*)(ptr))
#define MFMA32(a, b, c) __builtin_amdgcn_mfma_f32_32x32x16_bf16((a), (b), (c), 0, 0, 0)

#define DM 2048
#define NTOK 8192
#define NCTX 4096
#define INW 2880
#define NKV 10240
#define OFF_ZKV 512
#define OFF_ZKR 768
#define OFF_ZX 832
#define OFF_ZG 1344
#define OFF_ZC 1856
#define NEXP 16384
#define SMEM_BYTES 78848
#ifndef REP_A
#define REP_A 1
#define REP_B 1
#define REP_C 1
#define REP_D 1
#endif

struct Params {
  const float *x_prompt, *x_sample, *cache_ckv, *cache_krope, *state_lru, *c, *c_ctx;
  const float *ada_w, *ada_b, *norm_mix_g, *w_in, *mla_qa_g, *mla_w_qb, *mla_q_g, *mla_kva_g, *mla_w_kvb, *mla_k_g;
  const float *lru_conv_w, *lru_conv_b, *lru_w_a, *lru_b_a, *lru_w_i, *lru_b_i, *lru_lam;
  const float *cm_dw_w, *cm_dw_b, *cm_ln_g, *cm_ln_b, *grp_g, *w_out, *norm_ffn_g;
  const float *peer_w_q, *peer_keys, *peer_u, *peer_v;
  float* out;
  unsigned* bar;
  ushort_t *WinT, *WqbT, *WkvbT, *WoutT, *WpqT, *KeysB, *LruW;
  unsigned char *Ub, *Vb;
  float *Us, *Vs;
  ushort_t *hn, *qa, *ckv, *Q, *K, *Vt, *mixed;
  ushort_t *qraw, *kvraw, *attn, *hs, *Pc;
  float *z, *hend, *Pend, *x1, *xA, *mod, *rope;
};

DI unsigned pack_bf16(float lo, float hi) { f32x2_t v = {lo, hi}; bf16x2_t b = __builtin_convertvector(v, bf16x2_t); return __builtin_bit_cast(unsigned, b); }
DI ushort_t f2bf(float x) { return (ushort_t)(pack_bf16(x, 0.f) & 0xffffu); }
DI float bf_lo(unsigned u) { return __uint_as_float(u << 16); }
DI float bf_hi(unsigned u) { return __uint_as_float(u & 0xffff0000u); }
DI float wave_sum(float v) { for (int o = 32; o; o >>= 1) v += __shfl_xor(v, o); return v; }
DI float sigmoidf_(float x) { return 1.f / (1.f + __expf(-x)); }
DI float gelu_tanh(float x) { return 0.5f * x * (1.f + tanhf(0.7978845608028654f * (x + 0.044715f * x * x * x))); }
DI int crow(int reg, int h) { return (reg & 3) + 8 * (reg >> 2) + 4 * h; }
DI int cvidx(int t) { return t < NCTX ? 0 : 1 + ((t - NCTX) >> 10); }
DI int kvrow_of_token(int t) { if (t < NCTX) return t; int tl = t - NCTX; return NCTX + (tl >> 10) * 1536 + 512 + (tl & 1023); }
DI const float* xrow_in(const Params& p, int l, int t) {
  if (l == 0) return t < NCTX ? p.x_prompt + (size_t)t * DM : p.x_sample + (size_t)(t - NCTX) * DM;
  return p.xA + (size_t)t * DM;
}
DI float dot2bf(unsigned a, unsigned b, float acc) { return __builtin_amdgcn_fdot2_f32_bf16(__builtin_bit_cast(bf16x2_t, a), __builtin_bit_cast(bf16x2_t, b), acc, false); }
DI int opaque(int x) { asm volatile("" : "+v"(x)); return x; }
DI float rdlane_f(float v, int l) { return __int_as_float(__builtin_amdgcn_readlane(__float_as_int(v), l)); }

#define GLD 72
template <class Epi>
DI void gemm_tile(const ushort_t* A, int lda, const ushort_t* Bt, int ldb, int K, int N, int m0, int n0, char* smem, Epi epi) {
  ushort_t* sA = (ushort_t*)smem;
  ushort_t* sB = sA + 128 * GLD;
  const int tid = opaque(threadIdx.x), wave = tid >> 6, lane = tid & 63, wm = wave & 1, wn = wave >> 1;
  const int r = lane & 31, h = lane >> 5;
  f32x16 acc[2][2];
#pragma unroll
  for (int i = 0; i < 2; i++)
#pragma unroll
    for (int j = 0; j < 2; j++)
#pragma unroll
      for (int e = 0; e < 16; e++) acc[i][j][e] = 0.f;
  u32x4 ra0[4], rb0[4], ra1[4], rb1[4];
  const int lrow = tid >> 3, lkc = (tid & 7) * 8;
  const ushort_t* Ap = A + (size_t)(m0 + lrow) * lda + lkc;
  const ushort_t* Bp[4];
#pragma unroll
  for (int i = 0; i < 4; i++) { int br = n0 + lrow + 32 * i; br = br < N ? br : N - 1; Bp[i] = Bt + (size_t)br * ldb + lkc; }
  auto gload = [&](u32x4* ra, u32x4* rb, int k0) {
#pragma unroll
    for (int i = 0; i < 4; i++) {
      ra[i] = GLD16(Ap + (size_t)(32 * i) * lda + k0);
      rb[i] = GLD16(Bp[i] + k0);
    }
  };
  auto lstore = [&](const u32x4* ra, const u32x4* rb, int buf) {
    ushort_t* dA = sA + buf * (2 * 128 * GLD) + lrow * GLD + lkc;
    ushort_t* dB = sB + buf * (2 * 128 * GLD) + lrow * GLD + lkc;
#pragma unroll
    for (int i = 0; i < 4; i++) { *(u32x4*)(dA + 32 * i * GLD) = ra[i]; *(u32x4*)(dB + 32 * i * GLD) = rb[i]; }
  };
  auto compute = [&](int buf) {
    const ushort_t* cA = sA + buf * (2 * 128 * GLD);
    const ushort_t* cB = sB + buf * (2 * 128 * GLD);
    bf16x8 a[2][2], b[2][2];
#pragma unroll
    for (int i = 0; i < 2; i++) {
      a[0][i] = *(const bf16x8*)(cA + (wm * 64 + i * 32 + r) * GLD + h * 8);
      b[0][i] = *(const bf16x8*)(cB + (wn * 64 + i * 32 + r) * GLD + h * 8);
    }
#pragma unroll
    for (int ks = 0; ks < 4; ks++) {
      if (ks < 3) {
#pragma unroll
        for (int i = 0; i < 2; i++) {
          a[(ks + 1) & 1][i] = *(const bf16x8*)(cA + (wm * 64 + i * 32 + r) * GLD + (ks + 1) * 16 + h * 8);
          b[(ks + 1) & 1][i] = *(const bf16x8*)(cB + (wn * 64 + i * 32 + r) * GLD + (ks + 1) * 16 + h * 8);
        }
      }
#pragma unroll
      for (int i = 0; i < 2; i++)
#pragma unroll
        for (int j = 0; j < 2; j++) acc[i][j] = MFMA32(a[ks & 1][i], b[ks & 1][j], acc[i][j]);
    }
  };
  gload(ra0, rb0, 0);
  gload(ra1, rb1, 64);
  lstore(ra0, rb0, 0);
  __syncthreads();
  const int klast = K - 64;
  gload(ra0, rb0, 128 < K ? 128 : klast);
  for (int k0 = 0; k0 < K; k0 += 128) {
    compute(0);
    lstore(ra1, rb1, 1);
    __syncthreads();
    gload(ra1, rb1, k0 + 192 < K ? k0 + 192 : klast);
    compute(1);
    lstore(ra0, rb0, 0);
    __syncthreads();
    gload(ra0, rb0, k0 + 256 < K ? k0 + 256 : klast);
  }
#pragma unroll
  for (int i = 0; i < 2; i++)
#pragma unroll
    for (int j = 0; j < 2; j++)
#pragma unroll
      for (int e = 0; e < 16; e++) {
        int row = m0 + wm * 64 + i * 32 + crow(e, h);
        int col = n0 + wn * 64 + j * 32 + r;
        if (col < N) epi(row, col, acc[i][j][e]);
      }
  __syncthreads();
}

#define PLD 136
DI void scores_tile(const ushort_t* Kt, float* sc, int mt, int nt, char* smem) {
  ushort_t* sP = (ushort_t*)smem;
  ushort_t* sK2 = sP + 128 * PLD;
  const int tid = opaque(threadIdx.x), wave = tid >> 6, lane = tid & 63, wm = wave & 1, wn = wave >> 1;
  const int r = lane & 31, h = lane >> 5;
#pragma unroll
  for (int i = 0; i < 8; i++) { int c = tid + i * 256; int row = c >> 4, kc = (c & 15) * 8; *(u32x4*)(sK2 + row * PLD + kc) = GLD16(Kt + row * 128 + kc); }
  __syncthreads();
  f32x16 acc[2][2];
#pragma unroll
  for (int i = 0; i < 2; i++)
#pragma unroll
    for (int j = 0; j < 2; j++)
#pragma unroll
      for (int e = 0; e < 16; e++) acc[i][j][e] = 0.f;
#pragma unroll
  for (int ks = 0; ks < 8; ks++) {
    bf16x8 a[2], b[2];
#pragma unroll
    for (int i = 0; i < 2; i++) {
      a[i] = *(const bf16x8*)(sP + (wm * 64 + i * 32 + r) * PLD + ks * 16 + h * 8);
      b[i] = *(const bf16x8*)(sK2 + (wn * 64 + i * 32 + r) * PLD + ks * 16 + h * 8);
    }
#pragma unroll
    for (int i = 0; i < 2; i++)
#pragma unroll
      for (int j = 0; j < 2; j++) acc[i][j] = MFMA32(a[i], b[j], acc[i][j]);
  }
#pragma unroll
  for (int i = 0; i < 2; i++)
#pragma unroll
    for (int j = 0; j < 2; j++)
#pragma unroll
      for (int e = 0; e < 16; e++) {
        int row = mt * 128 + wm * 64 + i * 32 + crow(e, h);
        int col = wn * 64 + j * 32 + r;
        sc[(size_t)row * 2048 + nt * 128 + col] = acc[i][j][e];
      }
  __syncthreads();
}

DI void transpose_item(const float* src, int lds_, ushort_t* dst, int ldd, int kt, int nt, float* tile) {
  int tid = opaque(threadIdx.x); int c = tid & 63, r0 = tid >> 6;
#pragma unroll 4
  for (int i = 0; i < 16; i++) { int r = r0 + 4 * i; tile[r * 65 + c] = src[(size_t)(kt * 64 + r) * lds_ + nt * 64 + c]; }
  __syncthreads();
#pragma unroll 4
  for (int i = 0; i < 16; i++) { int r = r0 + 4 * i; dst[(size_t)(nt * 64 + r) * ldd + kt * 64 + c] = f2bf(tile[c * 65 + r]); }
  __syncthreads();
}

DI void convert_chunk(const float* src, ushort_t* dst, size_t base) {
  int tid = opaque(threadIdx.x);
#pragma unroll
  for (int it = 0; it < 4; it++) {
    size_t e = base + it * 2048 + tid * 8;
    float4 a = *(const float4*)(src + e), b = *(const float4*)(src + e + 4);
    uint4 o; o.x = pack_bf16(a.x, a.y); o.y = pack_bf16(a.z, a.w); o.z = pack_bf16(b.x, b.y); o.w = pack_bf16(b.z, b.w);
    *(uint4*)(dst + e) = o;
  }
}


DI void quant_rows(const float* src, unsigned char* dst, float* scl, size_t row0) {
  int tid = opaque(threadIdx.x); int wave = tid >> 6, lane = tid & 63;
  const size_t rowa = row0 + wave * 2;
  float4 v[2][8]; float am[2] = {0.f, 0.f};
#pragma unroll
  for (int q = 0; q < 2; q++)
#pragma unroll
    for (int j = 0; j < 8; j++) { f32x4 t_ = *(const GAS f32x4*)(src + (rowa + q) * DM + (j * 64 + lane) * 4); v[q][j] = make_float4(t_[0], t_[1], t_[2], t_[3]); }
#pragma unroll
  for (int q = 0; q < 2; q++)
#pragma unroll
    for (int j = 0; j < 8; j++) am[q] = fmaxf(am[q], fmaxf(fmaxf(fabsf(v[q][j].x), fabsf(v[q][j].y)), fmaxf(fabsf(v[q][j].z), fabsf(v[q][j].w))));
  for (int o = 32; o; o >>= 1) { am[0] = fmaxf(am[0], __shfl_xor(am[0], o)); am[1] = fmaxf(am[1], __shfl_xor(am[1], o)); }
#pragma unroll
  for (int q = 0; q < 2; q++) {
    float sc = am[q] > 0.f ? 224.f / am[q] : 1.f;
    if (lane == 0) scl[rowa + q] = am[q] > 0.f ? am[q] * (1.f / 224.f) : 1.f;
#pragma unroll
    for (int j = 0; j < 8; j++) {
      int w = 0;
      w = __builtin_amdgcn_cvt_pk_fp8_f32(v[q][j].x * sc, v[q][j].y * sc, w, false);
      w = __builtin_amdgcn_cvt_pk_fp8_f32(v[q][j].z * sc, v[q][j].w * sc, w, true);
      *(int*)(dst + (rowa + q) * DM + (j * 64 + lane) * 4) = w;
    }
  }
}

DI void mod_item(const Params& p, int item, char* smem) {
  int l = item / 48, cgp = item % 48;
  float* s = (float*)smem;
  float* red = s + 5 * 2048;
  int tid = opaque(threadIdx.x), wave = tid >> 6, lane = tid & 63;
  for (int i = tid; i < 5 * 2048; i += 256) {
    int cv = i >> 11, k = i & 2047;
    float v = cv == 0 ? p.c_ctx[k] : p.c[(cv - 1) * DM + k];
    s[i] = v * sigmoidf_(v);
  }
  __syncthreads();
  const float* W = p.ada_w + (size_t)l * DM * 12288 + cgp * 256 + lane * 4;
  float4 acc[5];
#pragma unroll
  for (int cv = 0; cv < 5; cv++) acc[cv] = make_float4(0, 0, 0, 0);
  int kb = wave * 512;
#pragma unroll 8
  for (int k = kb; k < kb + 512; k++) {
    float4 w = *(const float4*)(W + (size_t)k * 12288);
#pragma unroll
    for (int cv = 0; cv < 5; cv++) {
      float sv = s[cv * 2048 + k];
      acc[cv].x += sv * w.x; acc[cv].y += sv * w.y; acc[cv].z += sv * w.z; acc[cv].w += sv * w.w;
    }
  }
#pragma unroll
  for (int cv = 0; cv < 5; cv++) *(float4*)(red + (wave * 5 + cv) * 256 + lane * 4) = acc[cv];
  __syncthreads();
  for (int i = tid; i < 5 * 256; i += 256) {
    int cv = i >> 8, col = i & 255;
    float v = red[(0 * 5 + cv) * 256 + col] + red[(1 * 5 + cv) * 256 + col] + red[(2 * 5 + cv) * 256 + col] + red[(3 * 5 + cv) * 256 + col];
    int gc = cgp * 256 + col;
    p.mod[(size_t)(l * 5 + cv) * 12288 + gc] = v + p.ada_b[l * 12288 + gc];
  }
  __syncthreads();
}

#define N_MOD 96
#define N_TR_LAYER 3840
#define N_TR (2 * N_TR_LAYER)
#define N_CV_KEYS 64
#define N_CV_U 4096
#define N_PREP (N_MOD + N_TR + N_CV_KEYS + 2 * N_CV_U + 1)

DI void prep_phase(const Params& p, char* smem) {
  for (int it = blockIdx.x; it < N_PREP; it += gridDim.x) {
    if (it < N_MOD) { mod_item(p, it, smem); continue; }
    int i = it - N_MOD;
    if (i < N_TR) {
      int l = i / N_TR_LAYER, j = i % N_TR_LAYER;
      float* tile = (float*)smem;
      if (j < 1440) { transpose_item(p.w_in + (size_t)l * DM * INW, INW, p.WinT + (size_t)l * INW * DM, DM, j / 45, j % 45, tile); continue; }
      j -= 1440;
      if (j < 192) { transpose_item(p.mla_w_qb + (size_t)l * 512 * 1536, 1536, p.WqbT + (size_t)l * 1536 * 512, 512, j / 24, j % 24, tile); continue; }
      j -= 192;
      if (j < 128) { transpose_item(p.mla_w_kvb + (size_t)l * 256 * 2048, 2048, p.WkvbT + (size_t)l * 2048 * 256, 256, j / 32, j % 32, tile); continue; }
      j -= 128;
      if (j < 1024) { transpose_item(p.w_out + (size_t)l * DM * DM, DM, p.WoutT + (size_t)l * DM * DM, DM, j / 32, j % 32, tile); continue; }
      j -= 1024;
      if (j < 1024) { transpose_item(p.peer_w_q + (size_t)l * DM * DM, DM, p.WpqT + (size_t)l * DM * DM, DM, j / 32, j % 32, tile); continue; }
      j -= 1024;
      {
        int mat = j >> 4, dh = j & 15;
        const float* src = (mat ? p.lru_w_i : p.lru_w_a) + (size_t)(l * 16 + dh) * 4096;
        ushort_t* dst = p.LruW + ((size_t)(l * 16 + dh) * 2 + mat) * 4096;
        transpose_item(src, 64, dst, 64, 0, 0, tile);
      }
      continue;
    }
    i -= N_TR;
    if (i < N_CV_KEYS) { convert_chunk(p.peer_keys, p.KeysB, (size_t)i * 8192); continue; }
    i -= N_CV_KEYS;
    if (i < N_CV_U) { quant_rows(p.peer_u, p.Ub, p.Us, (size_t)i * 8); continue; }
    i -= N_CV_U;
    if (i < N_CV_U) { quant_rows(p.peer_v, p.Vb, p.Vs, (size_t)i * 8); continue; }
    for (int e = threadIdx.x; e < 1024 * 32; e += 256) {
      int pos = e >> 5, f = e & 31;
      int fi = f & 15;
      float inv = 1.0f / powf(10000.0f, (float)fi / 16.0f);
      float base = (f < 16) ? (float)(pos >> 6) : (float)(pos & 63);
      float ang = base * inv;
      float sn, cs; sincosf(ang, &sn, &cs);
      p.rope[pos * 64 + f] = cs; p.rope[pos * 64 + 32 + f] = sn;
    }
  }
}

DI void norm_phase(const Params& p, int l, int which) {
  int tidq = opaque(threadIdx.x); int lane = tidq & 63, gw = blockIdx.x * 4 + (tidq >> 6), nw = gridDim.x * 4;
  const float* g = (which ? p.norm_ffn_g : p.norm_mix_g) + l * DM;
  int sh_off = which ? 6144 : 0, sc_off = which ? 8192 : 2048;
  for (int t = gw; t < NTOK; t += nw) {
    const float* xr = which ? p.x1 + (size_t)t * DM : xrow_in(p, l, t);
    const float* md = p.mod + (size_t)(l * 5 + cvidx(t)) * 12288;
    float4 v[8]; float ss = 0.f;
#pragma unroll
    for (int j = 0; j < 8; j++) { v[j] = *(const float4*)(xr + j * 256 + lane * 4); ss += v[j].x * v[j].x + v[j].y * v[j].y + v[j].z * v[j].z + v[j].w * v[j].w; }
    ss = wave_sum(ss);
    float rinv = rsqrtf(ss * (1.f / DM) + 1e-6f);
#pragma unroll
    for (int j = 0; j < 8; j++) {
      int col = j * 256 + lane * 4;
      float4 gg = *(const float4*)(g + col), sc = *(const float4*)(md + sc_off + col), sh = *(const float4*)(md + sh_off + col);
      float y0 = v[j].x * rinv * gg.x * (1.f + sc.x) + sh.x;
      float y1 = v[j].y * rinv * gg.y * (1.f + sc.y) + sh.y;
      float y2 = v[j].z * rinv * gg.z * (1.f + sc.z) + sh.z;
      float y3 = v[j].w * rinv * gg.w * (1.f + sc.w) + sh.w;
      uint2 o; o.x = pack_bf16(y0, y1); o.y = pack_bf16(y2, y3);
      *(uint2*)(p.hn + (size_t)t * DM + col) = o;
    }
  }
}

DI void lru_item(const Params& p, int l, int item, char* smem) {
  int ch = item >> 4, hd = (item >> 1) & 7, d = item & 1;
  int t0 = ch * 256, seq_t0, T, p0;
  if (ch < 16) { seq_t0 = ch * 256; T = 256; p0 = 0; }
  else { int b = (ch - 16) >> 2, cc = (ch - 16) & 3; seq_t0 = NCTX + b * 1024; T = 1024; p0 = cc * 256; }
  ushort_t* sBt = (ushort_t*)smem;
  ushort_t* sA = sBt + 128 * GLD;
  float* sXc = (float*)(sA + 64 * GLD);
  float* sG = sXc + 64 * 64;
  const int tid = opaque(threadIdx.x), wave = tid >> 6, lane = tid & 63;
  const int c = tid & 63, tg = tid >> 6;
  const ushort_t* Bt = p.LruW + ((size_t)((l * 2 + d) * 8 + hd) * 2) * 4096;
#pragma unroll
  for (int i = 0; i < 4; i++) { int cidx = tid + i * 256; int row = cidx >> 3, kc = (cidx & 7) * 8; *(uint4*)(sBt + row * GLD + kc) = *(const uint4*)(Bt + row * 64 + kc); }
  const int chn = hd * 64 + c;
  float cw[4];
#pragma unroll
  for (int j = 0; j < 4; j++) cw[j] = p.lru_conv_w[(l * 4 + j) * 512 + chn];
  const float cb = p.lru_conv_b[l * 512 + chn];
  const float ba = p.lru_b_a[(l * 2 + d) * 512 + chn], bi = p.lru_b_i[(l * 2 + d) * 512 + chn];
  const float lam = p.lru_lam[(l * 2 + d) * 512 + chn];
  const float sp = log1pf(expf(-lam));
  float hst = 0.f, Pp = 1.f;
  const int r = lane & 31, h8 = lane >> 5;
  for (int si = 0; si < 4; si++) {
    int sub = d ? 3 - si : si;
#pragma unroll 4
    for (int i = 0; i < 16; i++) {
      int lt = tg * 16 + i; int pos = p0 + sub * 64 + lt;
      float xc = cb;
#pragma unroll
      for (int j = 0; j < 4; j++) {
        int q = pos - 2 + j;
        float zv = (q >= 0 && q < T) ? p.z[(size_t)(seq_t0 + q) * INW + OFF_ZX + chn] : 0.f;
        xc += cw[j] * zv;
      }
      sXc[lt * 64 + c] = xc; sA[lt * GLD + c] = f2bf(xc);
    }
    __syncthreads();
    {
      int mt = wave & 1, nh = wave >> 1;
      f32x16 acc[2];
#pragma unroll
      for (int i = 0; i < 2; i++)
#pragma unroll
        for (int e = 0; e < 16; e++) acc[i][e] = 0.f;
#pragma unroll
      for (int ks = 0; ks < 4; ks++) {
        bf16x8 a = *(const bf16x8*)(sA + (mt * 32 + r) * GLD + ks * 16 + h8 * 8);
#pragma unroll
        for (int ni = 0; ni < 2; ni++) {
          bf16x8 b = *(const bf16x8*)(sBt + (nh * 64 + ni * 32 + r) * GLD + ks * 16 + h8 * 8);
          acc[ni] = MFMA32(a, b, acc[ni]);
        }
      }
#pragma unroll
      for (int ni = 0; ni < 2; ni++)
#pragma unroll
        for (int e = 0; e < 16; e++) sG[(mt * 32 + crow(e, h8)) * 132 + nh * 64 + ni * 32 + r] = acc[ni][e];
    }
    __syncthreads();
#pragma unroll 4
    for (int i = 0; i < 16; i++) {
      int lt = tg * 16 + i;
      float ga = sG[lt * 132 + c] + ba, gi = sG[lt * 132 + 64 + c] + bi;
      float rr = 1.f / (1.f + expf(-ga)), ii = 1.f / (1.f + expf(-gi));
      float la = -8.0f * rr * sp;
      float a = expf(la);
      float u = sqrtf(-expm1f(2.f * la)) * ii * sXc[lt * 64 + c];
      sG[lt * 132 + c] = a; sG[lt * 132 + 64 + c] = u;
    }
    __syncthreads();
    if (tid < 64) {
      for (int s = 0; s < 64; s++) {
        int lt = d ? 63 - s : s;
        float a = sG[lt * 132 + c], u = sG[lt * 132 + 64 + c];
        hst = a * hst + u; Pp *= a;
        size_t o = ((size_t)d * NTOK + t0 + sub * 64 + lt) * 512 + chn;
        p.hs[o] = f2bf(hst); p.Pc[o] = f2bf(Pp);
      }
    }
    __syncthreads();
  }
  if (tid < 64) {
    p.hend[(d * 32 + ch) * 512 + chn] = hst; p.Pend[(d * 32 + ch) * 512 + chn] = Pp;
    if (ch < 16) p.out[(size_t)NTOK * DM + 16 * 2 * 256 * 256 + 16 * 2 * 256 * 64 + ((ch * 2 + l) * 2 + d) * 512 + chn] = hst;
  }
}

#define CMT 16
DI void cm_item(const Params& p, int l, int item, char* smem) {
  int t0 = item * CMT, seq_t0, T;
  if (t0 < NCTX) { seq_t0 = (t0 >> 8) << 8; T = 256; } else { seq_t0 = NCTX + (((t0 - NCTX) >> 10) << 10); T = 1024; }
  int p0 = t0 - seq_t0;
  unsigned* sGlu = (unsigned*)smem;
  float* red = (float*)(sGlu + (CMT + 30) * 256);
  float* red2 = red + 256;
  const int tid = opaque(threadIdx.x), wave = tid >> 6, lane = tid & 63;
#pragma unroll 8
  for (int rr = 0; rr < CMT + 30; rr++) {
    int pos = p0 - 15 + rr;
    unsigned v = 0;
    if (pos >= 0 && pos < T) {
      const float* zr = p.z + (size_t)(seq_t0 + pos) * INW + OFF_ZC;
      float2 a = *(const float2*)(zr + 2 * tid), b = *(const float2*)(zr + 512 + 2 * tid);
      v = pack_bf16(a.x * sigmoidf_(b.x), a.y * sigmoidf_(b.y));
    }
    sGlu[rr * 256 + tid] = v;
  }
  __syncthreads();
  float acc0[CMT], acc1[CMT];
  {
    float2 bb = *(const float2*)(p.cm_dw_b + l * 512 + 2 * tid);
#pragma unroll
    for (int t = 0; t < CMT; t++) { acc0[t] = bb.x; acc1[t] = bb.y; }
  }
  for (int j = 0; j < 31; j++) {
    float2 w = *(const float2*)(p.cm_dw_w + (size_t)(l * 31 + j) * 512 + 2 * tid);
#pragma unroll
    for (int t = 0; t < CMT; t++) { unsigned u = sGlu[(t + j) * 256 + tid]; acc0[t] += w.x * bf_lo(u); acc1[t] += w.y * bf_hi(u); }
  }
  {
    float ks = 0.f, kss = 0.f;
#pragma unroll
    for (int t = 0; t < CMT; t++) {
      float s = wave_sum(acc0[t] + acc1[t]);
      float ss = wave_sum(acc0[t] * acc0[t] + acc1[t] * acc1[t]);
      if (lane == t) { ks = s; kss = ss; }
    }
    if (lane < CMT) { red[(wave * CMT + lane) * 2] = ks; red[(wave * CMT + lane) * 2 + 1] = kss; }
  }
  __syncthreads();
  {
    float2 lg = *(const float2*)(p.cm_ln_g + l * 512 + 2 * tid), lb = *(const float2*)(p.cm_ln_b + l * 512 + 2 * tid);
    float k2 = 0.f;
#pragma unroll
    for (int t = 0; t < CMT; t++) {
      float s = red[(0 * CMT + t) * 2] + red[(1 * CMT + t) * 2] + red[(2 * CMT + t) * 2] + red[(3 * CMT + t) * 2];
      float ss = red[(0 * CMT + t) * 2 + 1] + red[(1 * CMT + t) * 2 + 1] + red[(2 * CMT + t) * 2 + 1] + red[(3 * CMT + t) * 2 + 1];
      float mu = s * (1.f / 512.f); float var = ss * (1.f / 512.f) - mu * mu; float rstd = rsqrtf(var + 1e-5f);
      float y0 = (acc0[t] - mu) * rstd * lg.x + lb.x, y1 = (acc1[t] - mu) * rstd * lg.y + lb.y;
      y0 = y0 * sigmoidf_(y0); y1 = y1 * sigmoidf_(y1);
      acc0[t] = y0; acc1[t] = y1;
      float s2 = wave_sum(y0 * y0 + y1 * y1);
      if (lane == t) k2 = s2;
    }
    if (lane < CMT) red2[wave * CMT + lane] = k2;
  }
  __syncthreads();
  {
    float2 gg = *(const float2*)(p.grp_g + l * DM + 1536 + 2 * tid);
#pragma unroll
    for (int t = 0; t < CMT; t++) {
      float tot = red2[t] + red2[CMT + t] + red2[2 * CMT + t] + red2[3 * CMT + t];
      float rinv = rsqrtf(tot * (1.f / 512.f) + 1e-6f);
      *(unsigned*)(p.mixed + (size_t)(t0 + t) * DM + 1536 + 2 * tid) = pack_bf16(acc0[t] * rinv * gg.x, acc1[t] * rinv * gg.y);
    }
  }
  __syncthreads();
}

DI void post_inproj_tokens(const Params& p, int l) {
  int tidq = opaque(threadIdx.x); int lane = tidq & 63, gw = blockIdx.x * 4 + (tidq >> 6), nw = gridDim.x * 4;
  float* new_ckv = p.out + (size_t)NTOK * DM;
  float* new_krope = new_ckv + 16 * 2 * 256 * 256;
  for (int t = gw; t < NTOK + 2048; t += nw) {
    if (t >= NTOK) {
      int rr = t - NTOK; int b = rr >> 9, j = rr & 511;
      float4 v = *(const float4*)(p.cache_ckv + ((size_t)(b * 2 + l) * 512 + j) * 256 + lane * 4);
      uint2 o; o.x = pack_bf16(v.x, v.y); o.y = pack_bf16(v.z, v.w);
      *(uint2*)(p.ckv + (size_t)(NCTX + b * 1536 + j) * 256 + lane * 4) = o;
      continue;
    }
    const float* zr = p.z + (size_t)t * INW;
    {
      float4 a = *(const float4*)(zr + lane * 4), b = *(const float4*)(zr + 256 + lane * 4);
      float ss = a.x * a.x + a.y * a.y + a.z * a.z + a.w * a.w + b.x * b.x + b.y * b.y + b.z * b.z + b.w * b.w;
      ss = wave_sum(ss);
      float rinv = rsqrtf(ss * (1.f / 512.f) + 1e-6f);
      float4 g0 = *(const float4*)(p.mla_qa_g + l * 512 + lane * 4), g1 = *(const float4*)(p.mla_qa_g + l * 512 + 256 + lane * 4);
      uint2 o0, o1;
      o0.x = pack_bf16(a.x * rinv * g0.x, a.y * rinv * g0.y); o0.y = pack_bf16(a.z * rinv * g0.z, a.w * rinv * g0.w);
      o1.x = pack_bf16(b.x * rinv * g1.x, b.y * rinv * g1.y); o1.y = pack_bf16(b.z * rinv * g1.z, b.w * rinv * g1.w);
      *(uint2*)(p.qa + (size_t)t * 512 + lane * 4) = o0;
      *(uint2*)(p.qa + (size_t)t * 512 + 256 + lane * 4) = o1;
    }
    {
      float4 a = *(const float4*)(zr + OFF_ZKV + lane * 4);
      float ss = wave_sum(a.x * a.x + a.y * a.y + a.z * a.z + a.w * a.w);
      float rinv = rsqrtf(ss * (1.f / 256.f) + 1e-6f);
      float4 g = *(const float4*)(p.mla_kva_g + l * 256 + lane * 4);
      float4 o = make_float4(a.x * rinv * g.x, a.y * rinv * g.y, a.z * rinv * g.z, a.w * rinv * g.w);
      uint2 ob; ob.x = pack_bf16(o.x, o.y); ob.y = pack_bf16(o.z, o.w);
      *(uint2*)(p.ckv + (size_t)kvrow_of_token(t) * 256 + lane * 4) = ob;
      if (t < NCTX) {
        int b = t >> 8, pos = t & 255;
        *(float4*)(new_ckv + ((size_t)(b * 2 + l) * 256 + pos) * 256 + lane * 4) = o;
        new_krope[((size_t)(b * 2 + l) * 256 + pos) * 64 + lane] = zr[OFF_ZKR + lane];
      }
    }
  }
}

DI void qnorm_tokens(const Params& p, int l) {
  int tidq = opaque(threadIdx.x); int lane = tidq & 63, gw = blockIdx.x * 4 + (tidq >> 6), nw = gridDim.x * 4;
  const float qscale = 0.07216878364870322f * 1.4426950408889634f;
  const float* g = p.mla_q_g + l * 192;
  float g0 = g[lane], g1 = g[64 + lane], g2 = g[128 + lane];
  for (int t = gw; t < NTOK; t += nw) {
    const ushort_t* qr = p.qraw + (size_t)t * 1536;
    bool lat = t >= NCTX; int pos = (t - NCTX) & 1023;
    float cs = 1.f, sn = 0.f;
    if (lat) { cs = p.rope[pos * 64 + (lane & 31)]; sn = p.rope[pos * 64 + 32 + (lane & 31)]; }
#pragma unroll
    for (int hh = 0; hh < 8; hh++) {
      float a = __uint_as_float((unsigned)qr[hh * 192 + lane] << 16), b = __uint_as_float((unsigned)qr[hh * 192 + 64 + lane] << 16), c = __uint_as_float((unsigned)qr[hh * 192 + 128 + lane] << 16);
      float ss = wave_sum(a * a + b * b + c * c);
      float rinv = rsqrtf(ss * (1.f / 192.f) + 1e-6f);
      a *= rinv * g0; b *= rinv * g1; c *= rinv * g2;
      if (lat) {
        float o = __shfl_xor(c, 32);
        c = (lane < 32) ? (c * cs - o * sn) : (o * sn + c * cs);
      }
      ushort_t* qo = p.Q + (size_t)t * 1536 + hh * 192;
      qo[lane] = f2bf(a * qscale); qo[64 + lane] = f2bf(b * qscale); qo[128 + lane] = f2bf(c * qscale);
    }
  }
}

DI void kv_item(const Params& p, int l, int item, char* smem) {
  int rt = item >> 3, hh = item & 7;
  int row0 = rt * 64;
  const int tid = opaque(threadIdx.x), wave = tid >> 6, lane = tid & 63;
  float* tile = (float*)smem;
  const float* g = p.mla_k_g + l * 192;
  float g0 = g[lane], g1 = g[64 + lane], g2 = g[128 + lane];
#pragma unroll 4
  for (int i = 0; i < 16; i++) {
    int lr = wave * 16 + i; int row = row0 + lr;
    const float* kr_src; bool rot = false; int pos = 0;
    if (row < NCTX) { kr_src = p.z + (size_t)row * INW + OFF_ZKR; }
    else {
      int rr = row - NCTX; int b = rr / 1536, j = rr % 1536;
      if (j < 512) kr_src = p.cache_krope + ((size_t)(b * 2 + l) * 512 + j) * 64;
      else { pos = j - 512; kr_src = p.z + (size_t)(NCTX + b * 1024 + pos) * INW + OFF_ZKR; rot = true; }
    }
    const ushort_t* kv = p.kvraw + (size_t)row * 2048 + hh * 256;
    float a = __uint_as_float((unsigned)kv[lane] << 16), b2 = __uint_as_float((unsigned)kv[64 + lane] << 16), c = kr_src[lane];
    float ss = wave_sum(a * a + b2 * b2 + c * c);
    float rinv = rsqrtf(ss * (1.f / 192.f) + 1e-6f);
    a *= rinv * g0; b2 *= rinv * g1; c *= rinv * g2;
    if (rot) {
      float cs = p.rope[pos * 64 + (lane & 31)], sn = p.rope[pos * 64 + 32 + (lane & 31)];
      float o = __shfl_xor(c, 32);
      c = (lane < 32) ? (c * cs - o * sn) : (o * sn + c * cs);
    }
    ushort_t* ko = p.K + (size_t)row * 1536 + hh * 192;
    ko[lane] = f2bf(a); ko[64 + lane] = f2bf(b2); ko[128 + lane] = f2bf(c);
    tile[lr * 129 + lane] = __uint_as_float((unsigned)kv[128 + lane] << 16); tile[lr * 129 + 64 + lane] = __uint_as_float((unsigned)kv[192 + lane] << 16);
  }
  __syncthreads();
  size_t vbase; int T, krow0;
  if (row0 < NCTX) { int sid = row0 >> 8; vbase = (size_t)(sid * 8 + hh) * 128 * 256; T = 256; krow0 = row0 & 255; }
  else { int rr = row0 - NCTX; int b = rr / 1536; vbase = (size_t)16 * 8 * 128 * 256 + (size_t)(b * 8 + hh) * 128 * 1536; T = 1536; krow0 = rr % 1536; }
#pragma unroll
  for (int i = 0; i < 4; i++) {
    int cidx = tid + i * 256; int dv = cidx >> 3, kg = cidx & 7;
    int G = kg >> 1, hhalf = kg & 1;
    float v[8];
#pragma unroll
    for (int s = 0; s < 8; s++) { int key = 16 * G + 8 * (s >> 2) + 4 * hhalf + (s & 3); v[s] = tile[key * 129 + dv]; }
    uint4 o; o.x = pack_bf16(v[0], v[1]); o.y = pack_bf16(v[2], v[3]); o.z = pack_bf16(v[4], v[5]); o.w = pack_bf16(v[6], v[7]);
    *(uint4*)(p.Vt + vbase + (size_t)dv * T + krow0 + kg * 8) = o;
  }
  __syncthreads();
}

#define KLD 200
#define VLD 72
DI void attn_item(const Params& p, int item, char* smem) {
  const int tid = opaque(threadIdx.x), wave = tid >> 6, lane = tid & 63;
  const int qs = wave & 1, kh = wave >> 1;
  int hh, Tk, tq0, kvbase; size_t vbase;
  if (item < 512) {
    int b = item >> 7; hh = (item >> 4) & 7; int qb = item & 15;
    Tk = 1536; tq0 = NCTX + b * 1024 + qb * 64; kvbase = NCTX + b * 1536;
    vbase = (size_t)16 * 8 * 128 * 256 + (size_t)(b * 8 + hh) * 128 * 1536;
  } else {
    int i2 = item - 512; int s = i2 >> 5; hh = (i2 >> 2) & 7; int qb = i2 & 3;
    Tk = 256; tq0 = s * 256 + qb * 64; kvbase = s * 256;
    vbase = (size_t)(s * 8 + hh) * 128 * 256;
  }
  ushort_t* sK = (ushort_t*)smem;
  ushort_t* sV = sK + 64 * KLD;
  const int r = lane & 31, h = lane >> 5;
  bf16x8 qf[12];
  {
    const ushort_t* qp = p.Q + (size_t)(tq0 + qs * 32 + r) * 1536 + hh * 192 + h * 8;
#pragma unroll
    for (int s = 0; s < 12; s++) qf[s] = *(const bf16x8*)(qp + s * 16);
  }
  f32x16 O[4];
#pragma unroll
  for (int i = 0; i < 4; i++)
#pragma unroll
    for (int e = 0; e < 16; e++) O[i][e] = 0.f;
  float m = -INFINITY, lsum = 0.f;
  const int nkt = Tk >> 6;
  const ushort_t* Kg = p.K + (size_t)kvbase * 1536 + hh * 192;
  const ushort_t* Vg = p.Vt + vbase;
  u32x4 rk[6], rv[4];
#pragma unroll
  for (int i = 0; i < 6; i++) { int c = tid + i * 256; int row = c / 24, kc = (c % 24) * 8; rk[i] = GLD16(Kg + (size_t)row * 1536 + kc); }
#pragma unroll
  for (int i = 0; i < 4; i++) { int c = tid + i * 256; int dv = c >> 3, kc = (c & 7) * 8; rv[i] = GLD16(Vg + (size_t)dv * Tk + kc); }
  for (int kt = 0; kt < nkt; kt++) {
    __syncthreads();
#pragma unroll
    for (int i = 0; i < 6; i++) { int c = tid + i * 256; int row = c / 24, kc = (c % 24) * 8; *(u32x4*)(sK + row * KLD + kc) = rk[i]; }
#pragma unroll
    for (int i = 0; i < 4; i++) { int c = tid + i * 256; int dv = c >> 3, kc = (c & 7) * 8; *(u32x4*)(sV + dv * VLD + kc) = rv[i]; }
    __syncthreads();
    if (kt + 1 < nkt) {
#pragma unroll
      for (int i = 0; i < 6; i++) { int c = tid + i * 256; int row = c / 24, kc = (c % 24) * 8; rk[i] = GLD16(Kg + (size_t)((kt + 1) * 64 + row) * 1536 + kc); }
#pragma unroll
      for (int i = 0; i < 4; i++) { int c = tid + i * 256; int dv = c >> 3, kc = (c & 7) * 8; rv[i] = GLD16(Vg + (size_t)dv * Tk + (kt + 1) * 64 + kc); }
    }
    f32x16 S;
#pragma unroll
    for (int e = 0; e < 16; e++) S[e] = 0.f;
    const ushort_t* kp = sK + (kh * 32 + r) * KLD + h * 8;
#pragma unroll
    for (int s = 0; s < 12; s++) { bf16x8 kf = *(const bf16x8*)(kp + s * 16); S = MFMA32(kf, qf[s], S); }
    float mx = S[0];
#pragma unroll
    for (int e = 1; e < 16; e++) mx = fmaxf(mx, S[e]);
    mx = fmaxf(mx, __shfl_xor(mx, 32));
    float mn = fmaxf(m, mx);
    float alpha = exp2f(m - mn);
    float rs = 0.f;
#pragma unroll
    for (int e = 0; e < 16; e++) { S[e] = exp2f(S[e] - mn); rs += S[e]; }
    rs += __shfl_xor(rs, 32);
    lsum = lsum * alpha + rs; m = mn;
#pragma unroll
    for (int i = 0; i < 4; i++)
#pragma unroll
      for (int e = 0; e < 16; e++) O[i][e] *= alpha;
    bf16x8 pf[2];
#pragma unroll
    for (int s2 = 0; s2 < 2; s2++) {
      u32x4 u; u.x = pack_bf16(S[8 * s2], S[8 * s2 + 1]); u.y = pack_bf16(S[8 * s2 + 2], S[8 * s2 + 3]);
      u.z = pack_bf16(S[8 * s2 + 4], S[8 * s2 + 5]); u.w = pack_bf16(S[8 * s2 + 6], S[8 * s2 + 7]);
      pf[s2] = __builtin_bit_cast(bf16x8, u);
    }
    const ushort_t* vp = sV + r * VLD + kh * 32 + h * 8;
#pragma unroll
    for (int dt = 0; dt < 4; dt++)
#pragma unroll
      for (int s2 = 0; s2 < 2; s2++) {
        bf16x8 vf = *(const bf16x8*)(vp + dt * 32 * VLD + s2 * 16);
        O[dt] = MFMA32(vf, pf[s2], O[dt]);
      }
  }
  __syncthreads();
  float* cO = (float*)smem;
  float* cML = cO + 2 * 64 * 64;
  if (kh == 1) {
#pragma unroll
    for (int dt = 0; dt < 4; dt++)
#pragma unroll
      for (int e = 0; e < 16; e++) cO[(qs * 64 + dt * 16 + e) * 64 + lane] = O[dt][e];
    cML[(qs * 2 + 0) * 64 + lane] = m; cML[(qs * 2 + 1) * 64 + lane] = lsum;
  }
  __syncthreads();
  if (kh == 0) {
    float m1 = cML[(qs * 2 + 0) * 64 + lane], l1 = cML[(qs * 2 + 1) * 64 + lane];
    float mf = fmaxf(m, m1);
    float a0 = exp2f(m - mf), a1 = exp2f(m1 - mf);
    float inv = 1.f / (lsum * a0 + l1 * a1);
    a0 *= inv; a1 *= inv;
    ushort_t* op = p.attn + (size_t)(tq0 + qs * 32 + r) * 1024 + hh * 128;
#pragma unroll
    for (int dt = 0; dt < 4; dt++)
#pragma unroll
      for (int gq = 0; gq < 4; gq++) {
        float o0 = O[dt][4 * gq] * a0 + cO[(qs * 64 + dt * 16 + 4 * gq) * 64 + lane] * a1;
        float o1 = O[dt][4 * gq + 1] * a0 + cO[(qs * 64 + dt * 16 + 4 * gq + 1) * 64 + lane] * a1;
        float o2 = O[dt][4 * gq + 2] * a0 + cO[(qs * 64 + dt * 16 + 4 * gq + 2) * 64 + lane] * a1;
        float o3 = O[dt][4 * gq + 3] * a0 + cO[(qs * 64 + dt * 16 + 4 * gq + 3) * 64 + lane] * a1;
        uint2 ov; ov.x = pack_bf16(o0, o1); ov.y = pack_bf16(o2, o3); *(uint2*)(op + dt * 32 + 8 * gq + 4 * h) = ov;
      }
  }
  __syncthreads();
}

DI void merge_tokens(const Params& p, int l) {
  int tidq = opaque(threadIdx.x); int lane = tidq & 63, gw = blockIdx.x * 4 + (tidq >> 6), nw = gridDim.x * 4;
  const float* gg = p.grp_g + l * DM;
  for (int t = gw; t < NTOK; t += nw) {
    {
      const ushort_t* ar = p.attn + (size_t)t * 1024;
      float4 v[4]; float ss = 0.f;
#pragma unroll
      for (int j = 0; j < 4; j++) { uint2 u_ = *(const uint2*)(ar + j * 256 + lane * 4); v[j] = make_float4(bf_lo(u_.x), bf_hi(u_.x), bf_lo(u_.y), bf_hi(u_.y)); ss += v[j].x * v[j].x + v[j].y * v[j].y + v[j].z * v[j].z + v[j].w * v[j].w; }
      ss = wave_sum(ss);
      float rinv = rsqrtf(ss * (1.f / 1024.f) + 1e-6f);
#pragma unroll
      for (int j = 0; j < 4; j++) {
        int col = j * 256 + lane * 4; float4 g = *(const float4*)(gg + col);
        uint2 o; o.x = pack_bf16(v[j].x * rinv * g.x, v[j].y * rinv * g.y); o.y = pack_bf16(v[j].z * rinv * g.z, v[j].w * rinv * g.w);
        *(uint2*)(p.mixed + (size_t)t * DM + col) = o;
      }
    }
    {
      float val[8]; float ss = 0.f;
      int ch = t >> 8;
#pragma unroll
      for (int j = 0; j < 2; j++) {
        int col = j * 256 + lane * 4;
        float cf[4] = {0, 0, 0, 0}, cbk[4] = {0, 0, 0, 0};
        if (t >= NCTX) {
          int b = (t - NCTX) >> 10, cc = (ch - 16) & 3, chb = 16 + b * 4;
          float4 h0f = *(const float4*)(p.state_lru + ((size_t)(b * 2 + l) * 2 + 0) * 512 + col);
          float4 h0b = *(const float4*)(p.state_lru + ((size_t)(b * 2 + l) * 2 + 1) * 512 + col);
          cf[0] = h0f.x; cf[1] = h0f.y; cf[2] = h0f.z; cf[3] = h0f.w;
          cbk[0] = h0b.x; cbk[1] = h0b.y; cbk[2] = h0b.z; cbk[3] = h0b.w;
          for (int jj = 0; jj < cc; jj++) {
            float4 he = *(const float4*)(p.hend + (size_t)(0 * 32 + chb + jj) * 512 + col), pe = *(const float4*)(p.Pend + (size_t)(0 * 32 + chb + jj) * 512 + col);
            cf[0] = he.x + pe.x * cf[0]; cf[1] = he.y + pe.y * cf[1]; cf[2] = he.z + pe.z * cf[2]; cf[3] = he.w + pe.w * cf[3];
          }
          for (int jj = 3; jj > cc; jj--) {
            float4 he = *(const float4*)(p.hend + (size_t)(1 * 32 + chb + jj) * 512 + col), pe = *(const float4*)(p.Pend + (size_t)(1 * 32 + chb + jj) * 512 + col);
            cbk[0] = he.x + pe.x * cbk[0]; cbk[1] = he.y + pe.y * cbk[1]; cbk[2] = he.z + pe.z * cbk[2]; cbk[3] = he.w + pe.w * cbk[3];
          }
        }
        uint2 uhf = *(const uint2*)(p.hs + ((size_t)0 * NTOK + t) * 512 + col), upf = *(const uint2*)(p.Pc + ((size_t)0 * NTOK + t) * 512 + col);
        uint2 uhb = *(const uint2*)(p.hs + ((size_t)1 * NTOK + t) * 512 + col), upb = *(const uint2*)(p.Pc + ((size_t)1 * NTOK + t) * 512 + col);
        float4 hf_ = make_float4(bf_lo(uhf.x), bf_hi(uhf.x), bf_lo(uhf.y), bf_hi(uhf.y)), pf_ = make_float4(bf_lo(upf.x), bf_hi(upf.x), bf_lo(upf.y), bf_hi(upf.y));
        float4 hb_ = make_float4(bf_lo(uhb.x), bf_hi(uhb.x), bf_lo(uhb.y), bf_hi(uhb.y)), pb_ = make_float4(bf_lo(upb.x), bf_hi(upb.x), bf_lo(upb.y), bf_hi(upb.y));
        float4 zg = *(const float4*)(p.z + (size_t)t * INW + OFF_ZG + col);
        float y0 = hf_.x + pf_.x * cf[0] + hb_.x + pb_.x * cbk[0];
        float y1 = hf_.y + pf_.y * cf[1] + hb_.y + pb_.y * cbk[1];
        float y2 = hf_.z + pf_.z * cf[2] + hb_.z + pb_.z * cbk[2];
        float y3 = hf_.w + pf_.w * cf[3] + hb_.w + pb_.w * cbk[3];
        y0 *= gelu_tanh(zg.x); y1 *= gelu_tanh(zg.y); y2 *= gelu_tanh(zg.z); y3 *= gelu_tanh(zg.w);
        val[j * 4] = y0; val[j * 4 + 1] = y1; val[j * 4 + 2] = y2; val[j * 4 + 3] = y3;
        ss += y0 * y0 + y1 * y1 + y2 * y2 + y3 * y3;
      }
      ss = wave_sum(ss);
      float rinv = rsqrtf(ss * (1.f / 512.f) + 1e-6f);
#pragma unroll
      for (int j = 0; j < 2; j++) {
        int col = j * 256 + lane * 4; float4 g = *(const float4*)(gg + 1024 + col);
        uint2 o; o.x = pack_bf16(val[j * 4] * rinv * g.x, val[j * 4 + 1] * rinv * g.y); o.y = pack_bf16(val[j * 4 + 2] * rinv * g.z, val[j * 4 + 3] * rinv * g.w);
        *(uint2*)(p.mixed + (size_t)t * DM + 1024 + col) = o;
      }
    }
  }
}

#define TOPK_INS(TV, TI, XV, XI) { float xv_ = (XV); int xi_ = (XI); _Pragma("unroll") for (int i_ = 0; i_ < 16; i_++) { bool c_ = xv_ > TV[i_]; float nv_ = c_ ? xv_ : TV[i_]; float ov_ = c_ ? TV[i_] : xv_; int ni_ = c_ ? xi_ : TI[i_]; int oi_ = c_ ? TI[i_] : xi_; TV[i_] = nv_; TI[i_] = ni_; xv_ = ov_; xi_ = oi_; } }
DI void peer_phase(const Params& p, int l, char* smem) {
  const int tid = opaque(threadIdx.x), wave = tid >> 6, lane = tid & 63;
  float* wsm = (float*)(smem + wave * 12288);
  float* lv = wsm;
  int* lidx = (int*)(wsm + 1024);
  int* pki = (int*)(wsm + 2048);
  float* pkg = wsm + 2560;
  const float* scores = p.z;
  const unsigned char* Ub = p.Ub + (size_t)l * NEXP * DM;
  const unsigned char* Vb = p.Vb + (size_t)l * NEXP * DM;
  const float* Us = p.Us + l * NEXP;
  const float* Vs = p.Vs + l * NEXP;
  float* dst = l == 0 ? p.xA : p.out;
  for (int tb = blockIdx.x; tb < NTOK / 16; tb += gridDim.x) {
    const int tg = tb * 4 + wave;
    {
      const GAS f32x4* sp = (const GAS f32x4*)(scores + (size_t)(tg * 4 + (lane >> 4)) * 2048 + (lane & 15) * 128);
      float tv[16]; int ti[16];
#pragma unroll
      for (int i = 0; i < 16; i++) { tv[i] = -INFINITY; ti[i] = 0; }
      for (int k = 0; k < 128; k += 8) {
        float x[8];
        { f32x4 xa_ = sp[k >> 2], xb_ = sp[(k >> 2) + 1]; x[0] = xa_[0]; x[1] = xa_[1]; x[2] = xa_[2]; x[3] = xa_[3]; x[4] = xb_[0]; x[5] = xb_[1]; x[6] = xb_[2]; x[7] = xb_[3]; }
#pragma unroll
        for (int u = 0; u < 8; u++) TOPK_INS(tv, ti, x[u], k + u);
      }
#pragma unroll
      for (int i = 0; i < 16; i++) { lv[i * 64 + lane] = tv[i]; lidx[i * 64 + lane] = ti[i]; }
    }
    __syncthreads();
    if (lane < 32) {
      const int tt = lane >> 3, hh = lane & 7;
      const int la = tt * 16 + 2 * hh, lb = la + 1;
      float s1[16], s2[16];
#pragma unroll
      for (int i = 0; i < 16; i++) { s1[i] = lv[i * 64 + la]; s2[i] = lv[i * 64 + lb]; }
      float cv[16]; int cf[16];
#pragma unroll
      for (int i = 0; i < 16; i++) { cv[i] = -INFINITY; cf[i] = 0; }
#pragma unroll
      for (int i = 0; i < 16; i++) {
#pragma unroll
        for (int j = 0; j < 16; j++) {
          if ((i + 1) * (j + 1) <= 16) TOPK_INS(cv, cf, s1[i] + s2[j], i * 16 + j);
        }
      }
      float e[16]; float sum = 0.f;
#pragma unroll
      for (int r = 0; r < 16; r++) { e[r] = __expf(cv[r] - cv[0]); sum += e[r]; }
      const float inv = 1.f / sum;
#pragma unroll
      for (int r = 0; r < 16; r++) {
        int id = lidx[(cf[r] >> 4) * 64 + la] * 128 + lidx[(cf[r] & 15) * 64 + lb];
        pki[tt * 128 + hh * 16 + r] = id; pkg[tt * 128 + hh * 16 + r] = e[r] * inv;
      }
    }
    __syncthreads();
    for (int tt = 0; tt < 4; tt++) {
    const int t = tg * 4 + tt;
    const int idx0 = pki[tt * 128 + lane], idx1 = pki[tt * 128 + 64 + lane];
    const float g0 = pkg[tt * 128 + lane], g1 = pkg[tt * 128 + 64 + lane];
    float xs[32];
#pragma unroll
    for (int j = 0; j < 2; j++) {
      const uint4* xp = (const uint4*)(p.hn + (size_t)t * DM + (j * 64 + lane) * 16);
      uint4 xa = xp[0], xb = xp[1];
      xs[j * 16 + 0] = bf_lo(xa.x); xs[j * 16 + 1] = bf_hi(xa.x); xs[j * 16 + 2] = bf_lo(xa.y); xs[j * 16 + 3] = bf_hi(xa.y);
      xs[j * 16 + 4] = bf_lo(xa.z); xs[j * 16 + 5] = bf_hi(xa.z); xs[j * 16 + 6] = bf_lo(xa.w); xs[j * 16 + 7] = bf_hi(xa.w);
      xs[j * 16 + 8] = bf_lo(xb.x); xs[j * 16 + 9] = bf_hi(xb.x); xs[j * 16 + 10] = bf_lo(xb.y); xs[j * 16 + 11] = bf_hi(xb.y);
      xs[j * 16 + 12] = bf_lo(xb.z); xs[j * 16 + 13] = bf_hi(xb.z); xs[j * 16 + 14] = bf_lo(xb.w); xs[j * 16 + 15] = bf_hi(xb.w);
    }
    const float us0 = Us[idx0], us1 = Us[idx1], vs0 = Vs[idx0], vs1 = Vs[idx1];
    float a0 = 0.f, a1 = 0.f;
    {
      u32x4 ld[8][2];
#pragma unroll
      for (int rr = 0; rr < 8; rr++) {
        int idx = __builtin_amdgcn_readlane(idx0, rr);
        const unsigned char* row = Ub + (size_t)idx * DM;
#pragma unroll
        for (int j = 0; j < 2; j++) ld[rr][j] = GLD16(row + (j * 64 + lane) * 16);
      }
      for (int k0 = 0; k0 < 128; k0 += 8) {
        int nsrc = (k0 + 8 < 64) ? idx0 : idx1;
        float part[8];
#pragma unroll
        for (int rr = 0; rr < 8; rr++) {
          float s = 0.f;
#pragma unroll
          for (int j = 0; j < 2; j++)
#pragma unroll
            for (int q = 0; q < 4; q++) {
              f32x2_t lo = __builtin_amdgcn_cvt_pk_f32_fp8((int)ld[rr][j][q], false);
              f32x2_t hi = __builtin_amdgcn_cvt_pk_f32_fp8((int)ld[rr][j][q], true);
              s += lo[0] * xs[j * 16 + q * 4] + lo[1] * xs[j * 16 + q * 4 + 1] + hi[0] * xs[j * 16 + q * 4 + 2] + hi[1] * xs[j * 16 + q * 4 + 3];
            }
          part[rr] = s;
          if (k0 + 8 < 128) {
            int idx = __builtin_amdgcn_readlane(nsrc, (k0 + 8 + rr) & 63);
            const unsigned char* row = Ub + (size_t)idx * DM;
#pragma unroll
            for (int j = 0; j < 2; j++) ld[rr][j] = GLD16(row + (j * 64 + lane) * 16);
          }
        }
#pragma unroll
        for (int o = 32; o; o >>= 1) {
#pragma unroll
          for (int rr = 0; rr < 8; rr++) part[rr] += __shfl_xor(part[rr], o);
        }
#pragma unroll
        for (int rr = 0; rr < 8; rr++) {
          if (lane == ((k0 + rr) & 63)) { if (k0 < 64) a0 = part[rr]; else a1 = part[rr]; }
        }
      }
    }
    float w0 = g0 * gelu_tanh(a0 * us0) * vs0, w1 = g1 * gelu_tanh(a1 * us1) * vs1;
    float acc[32];
#pragma unroll
    for (int e = 0; e < 32; e++) acc[e] = 0.f;
    {
      u32x4 ld[4][2];
#pragma unroll
      for (int rr = 0; rr < 4; rr++) {
        int idx = __builtin_amdgcn_readlane(idx0, rr);
        const unsigned char* row = Vb + (size_t)idx * DM;
#pragma unroll
        for (int j = 0; j < 2; j++) ld[rr][j] = GLD16(row + (j * 64 + lane) * 16);
      }
      for (int k0 = 0; k0 < 128; k0 += 4) {
        float wsrc = (k0 < 64) ? w0 : w1;
        int nsrc = (k0 + 4 < 64) ? idx0 : idx1;
#pragma unroll
        for (int rr = 0; rr < 4; rr++) {
          float w = rdlane_f(wsrc, (k0 + rr) & 63);
#pragma unroll
          for (int j = 0; j < 2; j++)
#pragma unroll
            for (int q = 0; q < 4; q++) {
              f32x2_t lo = __builtin_amdgcn_cvt_pk_f32_fp8((int)ld[rr][j][q], false);
              f32x2_t hi = __builtin_amdgcn_cvt_pk_f32_fp8((int)ld[rr][j][q], true);
              acc[j * 16 + q * 4 + 0] += w * lo[0]; acc[j * 16 + q * 4 + 1] += w * lo[1];
              acc[j * 16 + q * 4 + 2] += w * hi[0]; acc[j * 16 + q * 4 + 3] += w * hi[1];
            }
          if (k0 + 4 < 128) {
            int idx = __builtin_amdgcn_readlane(nsrc, (k0 + 4 + rr) & 63);
            const unsigned char* row = Vb + (size_t)idx * DM;
#pragma unroll
            for (int j = 0; j < 2; j++) ld[rr][j] = GLD16(row + (j * 64 + lane) * 16);
          }
        }
      }
    }
    const float* md = p.mod + (size_t)(l * 5 + cvidx(t)) * 12288 + 10240;
    float ssq = 0.f;
#pragma unroll
    for (int j = 0; j < 2; j++)
#pragma unroll
      for (int q = 0; q < 4; q++) {
        int col = (j * 64 + lane) * 16 + q * 4;
        float4 xa = *(const float4*)(p.x1 + (size_t)t * DM + col);
        float4 ga = *(const float4*)(md + col);
        float4 oa = make_float4(xa.x + ga.x * acc[j * 16 + q * 4], xa.y + ga.y * acc[j * 16 + q * 4 + 1], xa.z + ga.z * acc[j * 16 + q * 4 + 2], xa.w + ga.w * acc[j * 16 + q * 4 + 3]);
        *(float4*)(dst + (size_t)t * DM + col) = oa;
        acc[j * 16 + q * 4] = oa.x; acc[j * 16 + q * 4 + 1] = oa.y; acc[j * 16 + q * 4 + 2] = oa.z; acc[j * 16 + q * 4 + 3] = oa.w;
        ssq += oa.x * oa.x + oa.y * oa.y + oa.z * oa.z + oa.w * oa.w;
      }
    if (l == 0) {
      ssq = wave_sum(ssq);
      const float rinv = rsqrtf(ssq * (1.f / DM) + 1e-6f);
      const float* g = p.norm_mix_g + DM;
      const float* md1 = p.mod + (size_t)(5 + cvidx(t)) * 12288;
#pragma unroll
      for (int j = 0; j < 2; j++)
#pragma unroll
        for (int q = 0; q < 4; q++) {
          int col = (j * 64 + lane) * 16 + q * 4;
          float4 gg = *(const float4*)(g + col), sc = *(const float4*)(md1 + 2048 + col), sh = *(const float4*)(md1 + col);
          float y0 = acc[j * 16 + q * 4] * rinv * gg.x * (1.f + sc.x) + sh.x;
          float y1 = acc[j * 16 + q * 4 + 1] * rinv * gg.y * (1.f + sc.y) + sh.y;
          float y2 = acc[j * 16 + q * 4 + 2] * rinv * gg.z * (1.f + sc.z) + sh.z;
          float y3 = acc[j * 16 + q * 4 + 3] * rinv * gg.w * (1.f + sc.w) + sh.w;
          uint2 o; o.x = pack_bf16(y0, y1); o.y = pack_bf16(y2, y3);
          *(uint2*)(p.hn + (size_t)t * DM + col) = o;
        }
    }
    }
    __syncthreads();
  }
}

#define XB_TMO      128
#define XB_XCNT(j)  (256  + 64 * (j))
#define XB_XSUB(j)  (1280 + 64 * (j))
#define XB_XGEN(j)  (2304 + 64 * (j))
#define XB_TOP      3328
#define XB_TOPGEN   3392
#define XCD_BAR_WORDS 3456
#define XB_SPIN_CAP (1u << 18)
#define LAS __attribute__((address_space(3)))

__device__ __forceinline__ unsigned xb_ld(unsigned* p)              { return __hip_atomic_load(p, __ATOMIC_RELAXED, __HIP_MEMORY_SCOPE_AGENT); }
__device__ __forceinline__ unsigned xb_add(unsigned* p, unsigned v) { return __hip_atomic_fetch_add(p, v, __ATOMIC_RELAXED, __HIP_MEMORY_SCOPE_AGENT); }
__device__ __forceinline__ unsigned xb_xcc_id() { return (unsigned)__builtin_amdgcn_s_getreg((3 << 11) | 20) & 0xFu; }
#define XB_SPIN(cond, bar) do { unsigned _sp = 0; while (cond) { __builtin_amdgcn_s_sleep(1); \
    if ((++_sp & 255u) == 0u) { if (xb_ld(&(bar)[XB_TMO])) break; if (_sp > XB_SPIN_CAP) { atomicAdd(&(bar)[XB_TMO], 1u); break; } } } } while (0)

struct XcdBarrier {
    unsigned* bar; unsigned x;
    volatile LAS unsigned* st;
};

__device__ __forceinline__ XcdBarrier xcd_barrier_post(unsigned* bar, volatile LAS unsigned* st) {
    XcdBarrier b; b.bar = bar; b.x = xb_xcc_id(); b.st = st;
    if (threadIdx.x == 0) (void)xb_add(&bar[XB_XCNT(b.x)], 1u);
    return b;
}
__device__ __forceinline__ void xcd_barrier_complete(unsigned* bar, unsigned x, unsigned& nloc, unsigned& nx) {
    const unsigned G = gridDim.x * gridDim.y * gridDim.z;
    unsigned sum, cnt, mine, sp = 0u;
    for (;;) {
        sum = 0u; cnt = 0u; mine = 0u;
#pragma unroll
        for (unsigned j = 0; j < 16; ++j) { const unsigned c = xb_ld(&bar[XB_XCNT(j)]); sum += c; cnt += (c > 0u) ? 1u : 0u; mine = (j == x) ? c : mine; }
        if (sum == G) break;
        __builtin_amdgcn_s_sleep(1);
        if ((++sp & 255u) == 0u) { if (xb_ld(&bar[XB_TMO])) break; if (sp > XB_SPIN_CAP) { atomicAdd(&bar[XB_TMO], 1u); break; } }
    }
    nloc = mine > 0u ? mine : 1u; nx = cnt > 0u ? cnt : 1u;
}

__device__ __forceinline__ void xcd_barrier(const XcdBarrier& b) {
    asm volatile("s_waitcnt vmcnt(0)" ::: "memory");
    __syncthreads();
    if (threadIdx.x == 0) {
        unsigned* bar;
        {
            const unsigned long long bp = (unsigned long long)b.bar;
            const unsigned lo = (unsigned)__builtin_amdgcn_readfirstlane(opaque((int)(unsigned)bp));
            const unsigned hi = (unsigned)__builtin_amdgcn_readfirstlane(opaque((int)(unsigned)(bp >> 32)));
            bar = (unsigned*)(((unsigned long long)hi << 32) | lo);
        }
        const unsigned bx = xb_xcc_id() + (unsigned)opaque(0);
        __builtin_amdgcn_s_waitcnt(0);
        unsigned nloc = b.st[0], nx = b.st[1];
        if (nloc == 0u) { xcd_barrier_complete(bar, bx, nloc, nx); b.st[0] = nloc; b.st[1] = nx; }
        const unsigned old = xb_add(&bar[XB_XSUB(bx)], 1u);
        const unsigned gen = old / nloc;
        if (old + 1u == (gen + 1u) * nloc) {
            __builtin_amdgcn_fence(__ATOMIC_RELEASE, "agent");
            asm volatile("s_waitcnt vmcnt(0)" ::: "memory");
            const unsigned og = xb_add(&bar[XB_TOP], 1u);
            const unsigned tg = og / nx;
            if (og + 1u == (tg + 1u) * nx) xb_add(&bar[XB_TOPGEN], 1u);
            else XB_SPIN(xb_ld(&bar[XB_TOPGEN]) == tg, bar);
            __builtin_amdgcn_fence(__ATOMIC_ACQUIRE, "agent");
            xb_add(&bar[XB_XGEN(bx)], 1u);
            asm volatile("s_waitcnt vmcnt(0)" ::: "memory");
        } else {
            XB_SPIN(xb_ld(&bar[XB_XGEN(bx)]) == gen, bar);
            __builtin_amdgcn_fence(__ATOMIC_ACQUIRE, "agent");
            asm volatile("s_waitcnt vmcnt(0)" ::: "memory");
        }
    }
    __syncthreads();
}


DI void gsync(unsigned* bar, unsigned& gen) {
  asm volatile("s_waitcnt vmcnt(0) lgkmcnt(0)" ::: "memory");
  __syncthreads();
  if (threadIdx.x == 0) {
    __builtin_amdgcn_fence(__ATOMIC_RELEASE, "agent");
    asm volatile("s_waitcnt vmcnt(0)" ::: "memory");
    gen++;
    const unsigned ng = gridDim.x >> 3;
    unsigned* gc = bar + 32 * (1 + (blockIdx.x & 7));
    (void)__hip_atomic_fetch_add(gc, 1u, __ATOMIC_RELAXED, __HIP_MEMORY_SCOPE_AGENT);
    if (blockIdx.x < 8) {
      const unsigned gt = gen * ng;
      while (__hip_atomic_load(gc, __ATOMIC_RELAXED, __HIP_MEMORY_SCOPE_AGENT) < gt) __builtin_amdgcn_s_sleep(1);
      (void)__hip_atomic_fetch_add(bar, 1u, __ATOMIC_RELAXED, __HIP_MEMORY_SCOPE_AGENT);
    }
    const unsigned target = gen * 8u;
    while (__hip_atomic_load(bar, __ATOMIC_RELAXED, __HIP_MEMORY_SCOPE_AGENT) < target) __builtin_amdgcn_s_sleep(4);
    __builtin_amdgcn_fence(__ATOMIC_ACQUIRE, "agent");
    asm volatile("s_waitcnt vmcnt(0)" ::: "memory");
  }
  __syncthreads();
}

DI void dump_bf16(const Params& p, const ushort_t* src) {
  size_t n = (size_t)NTOK * DM; size_t tot = n + 16 * 2 * 256 * 256 + 16 * 2 * 256 * 64 + 16 * 2 * 2 * 512;
  for (size_t i = (size_t)blockIdx.x * 256 + threadIdx.x; i < tot; i += (size_t)gridDim.x * 256)
    p.out[i] = i < n ? __uint_as_float(((unsigned)src[i]) << 16) : (i < n + 2 * 5 * 12288 ? p.mod[i - n] : 0.f);
}


DI void dump_f32(const Params& p, const float* src, size_t n) {
  size_t tot = (size_t)NTOK * DM + 16 * 2 * 256 * 256 + 16 * 2 * 256 * 64 + 16 * 2 * 2 * 512;
  for (size_t i = (size_t)blockIdx.x * 256 + threadIdx.x; i < tot; i += (size_t)gridDim.x * 256)
    p.out[i] = i < n ? src[i] : 0.f;
}

__global__ void __launch_bounds__(256, 2) fwd_megakernel(Params pk) {
  __shared__ __attribute__((aligned(16))) char smem[SMEM_BYTES];
  __shared__ __attribute__((aligned(16))) unsigned long long spw[(sizeof(Params) + 7) / 8];
  {
    const unsigned long long* ka = (const unsigned long long*)__builtin_amdgcn_kernarg_segment_ptr();
    if (threadIdx.x < (sizeof(Params) + 7) / 8) spw[threadIdx.x] = ka[threadIdx.x];
    __syncthreads();
  }
#define PP (*(const Params*)((const char*)spw + opaque(0)))
  __shared__ uint4 xb_words;
  if (threadIdx.x == 0) xb_words = make_uint4(0u, 0u, 0u, 0u);
  __syncthreads();
  const XcdBarrier xb = xcd_barrier_post(PP.bar, (volatile LAS unsigned*)&xb_words);
  const int nb = gridDim.x, bid = blockIdx.x;
  const int wave = threadIdx.x >> 6, lane = threadIdx.x & 63;

  for (int rep = 0; rep < REP_A; rep++) {
  { const Params& p = PP; prep_phase(p, smem); }
  xcd_barrier(xb);
  }

  for (int l = 0; l < 2; l++) {
    for (int rep = 0; rep < REP_D; rep++) {
    if (l == 0) { { const Params& p = PP; norm_phase(p, l, 0); } xcd_barrier(xb); }
    }
    for (int rep = 0; rep < REP_B; rep++) {
    {
      const Params& p = PP;
      const ushort_t* Bt = p.WinT + (size_t)l * INW * DM;
      float* z = p.z;
      for (int j = bid >> 3; j < 192; j += nb >> 3) {
        int mt = (bid & 7) * 8 + ((j & 63) >> 3), nt = (j >> 6) * 8 + (j & 7);
        if (nt >= 23) continue;
        gemm_tile(p.hn, DM, Bt, DM, DM, INW, mt * 128, nt * 128, smem, [&](int row, int col, float v) { z[(size_t)row * INW + col] = v; });
      }
    }
    xcd_barrier(xb);
    }
    for (int rep = 0; rep < REP_D; rep++) {
    {
      const Params& p = PP;
      for (int it = bid; it < 512 + NTOK / CMT; it += nb) {
        if (it < 512) lru_item(p, l, it, smem); else cm_item(p, l, it - 512, smem);
      }
    }
    { const Params& p = PP; post_inproj_tokens(p, l); }
    xcd_barrier(xb);
    }
    for (int rep = 0; rep < REP_B; rep++) {
    {
      const Params& p = PP;
      const ushort_t* Bq = p.WqbT + (size_t)l * 1536 * 512;
      const ushort_t* Bkv = p.WkvbT + (size_t)l * 2048 * 256;
      ushort_t* qraw = p.qraw; ushort_t* kvraw = p.kvraw;
      for (int j = bid >> 3; j < 256; j += nb >> 3) {
        if (j < 160) {
          int rem = j % 80; int mt = (bid & 7) * 10 + (rem >> 3), nt = (j / 80) * 8 + (rem & 7);
          gemm_tile(p.ckv, 256, Bkv, 256, 256, 2048, mt * 128, nt * 128, smem, [&](int row, int col, float v) { kvraw[(size_t)row * 2048 + col] = f2bf(v); });
        } else {
          int j2 = j - 160; int rem = j2 % 48; int mt = (bid & 7) * 8 + rem / 6, nt = (j2 / 48) * 6 + rem % 6;
          gemm_tile(p.qa, 512, Bq, 512, 512, 1536, mt * 128, nt * 128, smem, [&](int row, int col, float v) { qraw[(size_t)row * 1536 + col] = f2bf(v); });
        }
      }
    }
    xcd_barrier(xb);
    }
    for (int rep = 0; rep < REP_D; rep++) {
    { const Params& p = PP; for (int it = bid; it < 160 * 8; it += nb) kv_item(p, l, it, smem); }
    { const Params& p = PP; qnorm_tokens(p, l); }
    xcd_barrier(xb);
    }
    for (int rep = 0; rep < REP_D; rep++) {
    { const Params& p = PP; for (int it = bid; it < 1024; it += nb) attn_item(p, it, smem); }
    xcd_barrier(xb);
    }
    for (int rep = 0; rep < REP_D; rep++) {
    { const Params& p = PP; merge_tokens(p, l); }
    xcd_barrier(xb);
    }
    for (int rep = 0; rep < REP_B; rep++) {
    {
      const Params& p = PP;
      const ushort_t* Bt = p.WoutT + (size_t)l * DM * DM;
      float* x1 = p.x1;
      for (int j = bid >> 3; j < 128; j += nb >> 3) {
        int mt = (bid & 7) * 8 + ((j & 63) >> 3), nt = (j >> 6) * 8 + (j & 7);
        gemm_tile(p.mixed, DM, Bt, DM, DM, DM, mt * 128, nt * 128, smem, [&](int row, int col, float v) {
          const float* xr = xrow_in(p, l, row);
          float g1 = p.mod[(size_t)(l * 5 + cvidx(row)) * 12288 + 4096 + col];
          x1[(size_t)row * DM + col] = xr[col] + g1 * v;
        });
      }
    }
    xcd_barrier(xb);
    }
    for (int rep = 0; rep < REP_D; rep++) {
    { const Params& p = PP; norm_phase(p, l, 1); }
    xcd_barrier(xb);
    }
    for (int rep = 0; rep < REP_B; rep++) {
    {
      const Params& p = PP;
      const ushort_t* Bt = p.WpqT + (size_t)l * DM * DM;
      const ushort_t* Kb = p.KeysB + (size_t)l * 2048 * 128;
      float* sc = (float*)p.z;
      ushort_t* sP = (ushort_t*)smem;
      for (int j = bid >> 3; j < 128; j += nb >> 3) {
        int mt = (bid & 7) * 8 + ((j & 63) >> 3), nt = (j >> 6) * 8 + (j & 7);
        gemm_tile(p.hn, DM, Bt, DM, DM, DM, mt * 128, nt * 128, smem, [&](int row, int col, float v) { sP[(row - mt * 128) * PLD + (col - nt * 128)] = f2bf(v); });
        scores_tile(Kb + (size_t)nt * 128 * 128, sc, mt, nt, smem);
      }
    }
    xcd_barrier(xb);
    }
    for (int rep = 0; rep < REP_C; rep++) {
    { const Params& p = PP; peer_phase(p, l, smem); }
    xcd_barrier(xb);
    }
  }
}

extern "C" void kernel_launch(void* const* d_in, const int* in_sizes, int n_in, void* d_out, int out_size, void* d_ws, size_t ws_size, hipStream_t stream) {
  static int grid_blocks = 0;
  if (!grid_blocks) {
    int dev = 0, cus = 0, per_cu = 0;
    hipGetDevice(&dev);
    hipDeviceGetAttribute(&cus, hipDeviceAttributeMultiprocessorCount, dev);
    hipOccupancyMaxActiveBlocksPerMultiprocessor(&per_cu, fwd_megakernel, 256, 0);
    if (per_cu > 2) per_cu = 2;
    if (per_cu < 1) per_cu = 1;
    grid_blocks = (cus * per_cu) & ~7;
  }
  Params p{};
  const float** pin = (const float**)&p;
  for (int i = 0; i < 35; i++) pin[i] = (const float*)d_in[i];
  p.out = (float*)d_out;
  char* w = (char*)d_ws; size_t off = 0;
  auto take = [&](size_t bytes) { char* r = w + off; off += (bytes + 255) & ~(size_t)255; return r; };
  p.bar = (unsigned*)take(16384);
  p.WinT = (ushort_t*)take((size_t)2 * INW * DM * 2);
  p.WqbT = (ushort_t*)take((size_t)2 * 1536 * 512 * 2);
  p.WkvbT = (ushort_t*)take((size_t)2 * 2048 * 256 * 2);
  p.WoutT = (ushort_t*)take((size_t)2 * DM * DM * 2);
  p.WpqT = (ushort_t*)take((size_t)2 * DM * DM * 2);
  p.KeysB = (ushort_t*)take((size_t)2 * 2048 * 128 * 2);
  p.LruW = (ushort_t*)take((size_t)2 * 16 * 2 * 4096 * 2);
  p.Ub = (unsigned char*)take((size_t)2 * NEXP * DM);
  p.Vb = (unsigned char*)take((size_t)2 * NEXP * DM);
  p.Us = (float*)take((size_t)2 * NEXP * 4);
  p.Vs = (float*)take((size_t)2 * NEXP * 4);
  p.hn = (ushort_t*)take((size_t)NTOK * DM * 2);
  p.qa = (ushort_t*)take((size_t)NTOK * 512 * 2);
  p.ckv = (ushort_t*)take((size_t)NKV * 256 * 2);
  p.Q = (ushort_t*)take((size_t)NTOK * 1536 * 2);
  p.K = (ushort_t*)take((size_t)NKV * 1536 * 2);
  p.Vt = (ushort_t*)take((size_t)NKV * 1024 * 2);
  p.mixed = (ushort_t*)take((size_t)NTOK * DM * 2);
  p.z = (float*)take((size_t)NTOK * INW * 4);
  p.qraw = (ushort_t*)take((size_t)NTOK * 1536 * 2);
  p.kvraw = (ushort_t*)take((size_t)NKV * 2048 * 2);
  p.attn = (ushort_t*)take((size_t)NTOK * 1024 * 2);
  p.hs = (ushort_t*)take((size_t)2 * NTOK * 512 * 2);
  p.Pc = (ushort_t*)take((size_t)2 * NTOK * 512 * 2);
  p.hend = (float*)take((size_t)2 * 32 * 512 * 4);
  p.Pend = (float*)take((size_t)2 * 32 * 512 * 4);
  p.x1 = (float*)take((size_t)NTOK * DM * 4);
  p.xA = (float*)take((size_t)NTOK * DM * 4);
  p.mod = (float*)take((size_t)2 * 5 * 12288 * 4);
  p.rope = (float*)take((size_t)1024 * 64 * 4);
  if (off > ws_size) { fprintf(stderr, "workspace too small: need %zu have %zu\n", off, ws_size); return; }
  if (hipMemsetAsync(p.bar, 0, 16384, stream) != hipSuccess) { fprintf(stderr, "memset failed\n"); return; }
  hipLaunchKernelGGL(fwd_megakernel, dim3(grid_blocks), dim3(256), 0, stream, p);
}
```

```cpp
#include <hip/hip_runtime.h>
#include <hip/hip_cooperative_groups.h>
#include <cstdio>
#include <cstdint>
namespace cg = cooperative_groups;

typedef unsigned short ushort_t;
typedef __attribute__((ext_vector_type(8))) short bf16x8;
typedef __attribute__((ext_vector_type(16))) float f32x16;
typedef __attribute__((ext_vector_type(4))) unsigned u32x4;
typedef __attribute__((ext_vector_type(4))) float f32x4;
typedef __attribute__((ext_vector_type(2))) float f32x2_t;
typedef __attribute__((ext_vector_type(2))) __bf16 bf16x2_t;
#define DI __device__ __forceinline__
#define GAS __attribute__((address_space(1)))
#define GLD16(ptr) (*(const GAS u32x4*)(ptr))
#define MFMA32(a, b, c) __builtin_amdgcn_mfma_f32_32x32x16_bf16((a), (b), (c), 0, 0, 0)

#define DM 2048
#define NTOK 8192
#define NCTX 4096
#define INW 2880
#define NKV 10240
#define OFF_ZKV 512
#define OFF_ZKR 768
#define OFF_ZX 832
#define OFF_ZG 1344
#define OFF_ZC 1856
#define NEXP 16384
#define SMEM_BYTES 78848
#ifndef REP_A
#define REP_A 1
#define REP_B 1
#define REP_C 1
#define REP_D 1
#endif

struct Params {
  const float *x_prompt, *x_sample, *cache_ckv, *cache_krope, *state_lru, *c, *c_ctx;
  const float *ada_w, *ada_b, *norm_mix_g, *w_in, *mla_qa_g, *mla_w_qb, *mla_q_g, *mla_kva_g, *mla_w_kvb, *mla_k_g;
  const float *lru_conv_w, *lru_conv_b, *lru_w_a, *lru_b_a, *lru_w_i, *lru_b_i, *lru_lam;
  const float *cm_dw_w, *cm_dw_b, *cm_ln_g, *cm_ln_b, *grp_g, *w_out, *norm_ffn_g;
  const float *peer_w_q, *peer_keys, *peer_u, *peer_v;
  float* out;
  unsigned* bar;
  ushort_t *WinT, *WqbT, *WkvbT, *WoutT, *WpqT, *KeysB, *LruW;
  unsigned char *Ub, *Vb;
  float *Us, *Vs;
  ushort_t *hn, *qa, *ckv, *Q, *K, *Vt, *mixed;
  ushort_t *qraw, *kvraw, *attn, *hs, *Pc;
  float *z, *hend, *Pend, *x1, *xA, *mod, *rope;
};

DI unsigned pack_bf16(float lo, float hi) { f32x2_t v = {lo, hi}; bf16x2_t b = __builtin_convertvector(v, bf16x2_t); return __builtin_bit_cast(unsigned, b); }
DI ushort_t f2bf(float x) { return (ushort_t)(pack_bf16(x, 0.f) & 0xffffu); }
DI float bf_lo(unsigned u) { return __uint_as_float(u << 16); }
DI float bf_hi(unsigned u) { return __uint_as_float(u & 0xffff0000u); }
DI float wave_sum(float v) { for (int o = 32; o; o >>= 1) v += __shfl_xor(v, o); return v; }
DI float sigmoidf_(float x) { return 1.f / (1.f + __expf(-x)); }
DI float gelu_tanh(float x) { return 0.5f * x * (1.f + tanhf(0.7978845608028654f * (x + 0.044715f * x * x * x))); }
DI int crow(int reg, int h) { return (reg & 3) + 8 * (reg >> 2) + 4 * h; }
DI int cvidx(int t) { return t < NCTX ? 0 : 1 + ((t - NCTX) >> 10); }
DI int kvrow_of_token(int t) { if (t < NCTX) return t; int tl = t - NCTX; return NCTX + (tl >> 10) * 1536 + 512 + (tl & 1023); }
DI const float* xrow_in(const Params& p, int l, int t) {
  if (l == 0) return t < NCTX ? p.x_prompt + (size_t)t * DM : p.x_sample + (size_t)(t - NCTX) * DM;
  return p.xA + (size_t)t * DM;
}
DI float dot2bf(unsigned a, unsigned b, float acc) { return __builtin_amdgcn_fdot2_f32_bf16(__builtin_bit_cast(bf16x2_t, a), __builtin_bit_cast(bf16x2_t, b), acc, false); }
DI int opaque(int x) { asm volatile("" : "+v"(x)); return x; }
DI float rdlane_f(float v, int l) { return __int_as_float(__builtin_amdgcn_readlane(__float_as_int(v), l)); }

#define GLD 72
template <class Epi>
DI void gemm_tile(const ushort_t* A, int lda, const ushort_t* Bt, int ldb, int K, int N, int m0, int n0, char* smem, Epi epi) {
  ushort_t* sA = (ushort_t*)smem;
  ushort_t* sB = sA + 128 * GLD;
  const int tid = opaque(threadIdx.x), wave = tid >> 6, lane = tid & 63, wm = wave & 1, wn = wave >> 1;
  const int r = lane & 31, h = lane >> 5;
  f32x16 acc[2][2];
#pragma unroll
  for (int i = 0; i < 2; i++)
#pragma unroll
    for (int j = 0; j < 2; j++)
#pragma unroll
      for (int e = 0; e < 16; e++) acc[i][j][e] = 0.f;
  u32x4 ra0[4], rb0[4], ra1[4], rb1[4];
  const int lrow = tid >> 3, lkc = (tid & 7) * 8;
  const ushort_t* Ap = A + (size_t)(m0 + lrow) * lda + lkc;
  const ushort_t* Bp[4];
#pragma unroll
  for (int i = 0; i < 4; i++) { int br = n0 + lrow + 32 * i; br = br < N ? br : N - 1; Bp[i] = Bt + (size_t)br * ldb + lkc; }
  auto gload = [&](u32x4* ra, u32x4* rb, int k0) {
#pragma unroll
    for (int i = 0; i < 4; i++) {
      ra[i] = GLD16(Ap + (size_t)(32 * i) * lda + k0);
      rb[i] = GLD16(Bp[i] + k0);
    }
  };
  auto lstore = [&](const u32x4* ra, const u32x4* rb, int buf) {
    ushort_t* dA = sA + buf * (2 * 128 * GLD) + lrow * GLD + lkc;
    ushort_t* dB = sB + buf * (2 * 128 * GLD) + lrow * GLD + lkc;
#pragma unroll
    for (int i = 0; i < 4; i++) { *(u32x4*)(dA + 32 * i * GLD) = ra[i]; *(u32x4*)(dB + 32 * i * GLD) = rb[i]; }
  };
  auto compute = [&](int buf) {
    const ushort_t* cA = sA + buf * (2 * 128 * GLD);
    const ushort_t* cB = sB + buf * (2 * 128 * GLD);
    bf16x8 a[2][2], b[2][2];
#pragma unroll
    for (int i = 0; i < 2; i++) {
      a[0][i] = *(const bf16x8*)(cA + (wm * 64 + i * 32 + r) * GLD + h * 8);
      b[0][i] = *(const bf16x8*)(cB + (wn * 64 + i * 32 + r) * GLD + h * 8);
    }
#pragma unroll
    for (int ks = 0; ks < 4; ks++) {
      if (ks < 3) {
#pragma unroll
        for (int i = 0; i < 2; i++) {
          a[(ks + 1) & 1][i] = *(const bf16x8*)(cA + (wm * 64 + i * 32 + r) * GLD + (ks + 1) * 16 + h * 8);
          b[(ks + 1) & 1][i] = *(const bf16x8*)(cB + (wn * 64 + i * 32 + r) * GLD + (ks + 1) * 16 + h * 8);
        }
      }
#pragma unroll
      for (int i = 0; i < 2; i++)
#pragma unroll
        for (int j = 0; j < 2; j++) acc[i][j] = MFMA32(a[ks & 1][i], b[ks & 1][j], acc[i][j]);
    }
  };
  gload(ra0, rb0, 0);
  gload(ra1, rb1, 64);
  lstore(ra0, rb0, 0);
  __syncthreads();
  const int klast = K - 64;
  gload(ra0, rb0, 128 < K ? 128 : klast);
  for (int k0 = 0; k0 < K; k0 += 128) {
    compute(0);
    lstore(ra1, rb1, 1);
    __syncthreads();
    gload(ra1, rb1, k0 + 192 < K ? k0 + 192 : klast);
    compute(1);
    lstore(ra0, rb0, 0);
    __syncthreads();
    gload(ra0, rb0, k0 + 256 < K ? k0 + 256 : klast);
  }
#pragma unroll
  for (int i = 0; i < 2; i++)
#pragma unroll
    for (int j = 0; j < 2; j++)
#pragma unroll
      for (int e = 0; e < 16; e++) {
        int row = m0 + wm * 64 + i * 32 + crow(e, h);
        int col = n0 + wn * 64 + j * 32 + r;
        if (col < N) epi(row, col, acc[i][j][e]);
      }
  __syncthreads();
}

#define PLD 136
DI void scores_tile(const ushort_t* Kt, float* sc, int mt, int nt, char* smem) {
  ushort_t* sP = (ushort_t*)smem;
  ushort_t* sK2 = sP + 128 * PLD;
  const int tid = opaque(threadIdx.x), wave = tid >> 6, lane = tid & 63, wm = wave & 1, wn = wave >> 1;
  const int r = lane & 31, h = lane >> 5;
#pragma unroll
  for (int i = 0; i < 8; i++) { int c = tid + i * 256; int row = c >> 4, kc = (c & 15) * 8; *(u32x4*)(sK2 + row * PLD + kc) = GLD16(Kt + row * 128 + kc); }
  __syncthreads();
  f32x16 acc[2][2];
#pragma unroll
  for (int i = 0; i < 2; i++)
#pragma unroll
    for (int j = 0; j < 2; j++)
#pragma unroll
      for (int e = 0; e < 16; e++) acc[i][j][e] = 0.f;
#pragma unroll
  for (int ks = 0; ks < 8; ks++) {
    bf16x8 a[2], b[2];
#pragma unroll
    for (int i = 0; i < 2; i++) {
      a[i] = *(const bf16x8*)(sP + (wm * 64 + i * 32 + r) * PLD + ks * 16 + h * 8);
      b[i] = *(const bf16x8*)(sK2 + (wn * 64 + i * 32 + r) * PLD + ks * 16 + h * 8);
    }
#pragma unroll
    for (int i = 0; i < 2; i++)
#pragma unroll
      for (int j = 0; j < 2; j++) acc[i][j] = MFMA32(a[i], b[j], acc[i][j]);
  }
#pragma unroll
  for (int i = 0; i < 2; i++)
#pragma unroll
    for (int j = 0; j < 2; j++)
#pragma unroll
      for (int e = 0; e < 16; e++) {
        int row = mt * 128 + wm * 64 + i * 32 + crow(e, h);
        int col = wn * 64 + j * 32 + r;
        sc[(size_t)row * 2048 + nt * 128 + col] = acc[i][j][e];
      }
  __syncthreads();
}

DI void transpose_item(const float* src, int lds_, ushort_t* dst, int ldd, int kt, int nt, float* tile) {
  int tid = opaque(threadIdx.x); int c = tid & 63, r0 = tid >> 6;
#pragma unroll 4
  for (int i = 0; i < 16; i++) { int r = r0 + 4 * i; tile[r * 65 + c] = src[(size_t)(kt * 64 + r) * lds_ + nt * 64 + c]; }
  __syncthreads();
#pragma unroll 4
  for (int i = 0; i < 16; i++) { int r = r0 + 4 * i; dst[(size_t)(nt * 64 + r) * ldd + kt * 64 + c] = f2bf(tile[c * 65 + r]); }
  __syncthreads();
}

DI void convert_chunk(const float* src, ushort_t* dst, size_t base) {
  int tid = opaque(threadIdx.x);
#pragma unroll
  for (int it = 0; it < 4; it++) {
    size_t e = base + it * 2048 + tid * 8;
    float4 a = *(const float4*)(src + e), b = *(const float4*)(src + e + 4);
    uint4 o; o.x = pack_bf16(a.x, a.y); o.y = pack_bf16(a.z, a.w); o.z = pack_bf16(b.x, b.y); o.w = pack_bf16(b.z, b.w);
    *(uint4*)(dst + e) = o;
  }
}


DI void quant_rows(const float* src, unsigned char* dst, float* scl, size_t row0) {
  int tid = opaque(threadIdx.x); int wave = tid >> 6, lane = tid & 63;
  const size_t rowa = row0 + wave * 2;
  float4 v[2][8]; float am[2] = {0.f, 0.f};
#pragma unroll
  for (int q = 0; q < 2; q++)
#pragma unroll
    for (int j = 0; j < 8; j++) { f32x4 t_ = *(const GAS f32x4*)(src + (rowa + q) * DM + (j * 64 + lane) * 4); v[q][j] = make_float4(t_[0], t_[1], t_[2], t_[3]); }
#pragma unroll
  for (int q = 0; q < 2; q++)
#pragma unroll
    for (int j = 0; j < 8; j++) am[q] = fmaxf(am[q], fmaxf(fmaxf(fabsf(v[q][j].x), fabsf(v[q][j].y)), fmaxf(fabsf(v[q][j].z), fabsf(v[q][j].w))));
  for (int o = 32; o; o >>= 1) { am[0] = fmaxf(am[0], __shfl_xor(am[0], o)); am[1] = fmaxf(am[1], __shfl_xor(am[1], o)); }
#pragma unroll
  for (int q = 0; q < 2; q++) {
    float sc = am[q] > 0.f ? 224.f / am[q] : 1.f;
    if (lane == 0) scl[rowa + q] = am[q] > 0.f ? am[q] * (1.f / 224.f) : 1.f;
#pragma unroll
    for (int j = 0; j < 8; j++) {
      int w = 0;
      w = __builtin_amdgcn_cvt_pk_fp8_f32(v[q][j].x * sc, v[q][j].y * sc, w, false);
      w = __builtin_amdgcn_cvt_pk_fp8_f32(v[q][j].z * sc, v[q][j].w * sc, w, true);
      *(int*)(dst + (rowa + q) * DM + (j * 64 + lane) * 4) = w;
    }
  }
}

DI void mod_item(const Params& p, int item, char* smem) {
  int l = item / 48, cgp = item % 48;
  float* s = (float*)smem;
  float* red = s + 5 * 2048;
  int tid = opaque(threadIdx.x), wave = tid >> 6, lane = tid & 63;
  for (int i = tid; i < 5 * 2048; i += 256) {
    int cv = i >> 11, k = i & 2047;
    float v = cv == 0 ? p.c_ctx[k] : p.c[(cv - 1) * DM + k];
    s[i] = v * sigmoidf_(v);
  }
  __syncthreads();
  const float* W = p.ada_w + (size_t)l * DM * 12288 + cgp * 256 + lane * 4;
  float4 acc[5];
#pragma unroll
  for (int cv = 0; cv < 5; cv++) acc[cv] = make_float4(0, 0, 0, 0);
  int kb = wave * 512;
#pragma unroll 8
  for (int k = kb; k < kb + 512; k++) {
    float4 w = *(const float4*)(W + (size_t)k * 12288);
#pragma unroll
    for (int cv = 0; cv < 5; cv++) {
      float sv = s[cv * 2048 + k];
      acc[cv].x += sv * w.x; acc[cv].y += sv * w.y; acc[cv].z += sv * w.z; acc[cv].w += sv * w.w;
    }
  }
#pragma unroll
  for (int cv = 0; cv < 5; cv++) *(float4*)(red + (wave * 5 + cv) * 256 + lane * 4) = acc[cv];
  __syncthreads();
  for (int i = tid; i < 5 * 256; i += 256) {
    int cv = i >> 8, col = i & 255;
    float v = red[(0 * 5 + cv) * 256 + col] + red[(1 * 5 + cv) * 256 + col] + red[(2 * 5 + cv) * 256 + col] + red[(3 * 5 + cv) * 256 + col];
    int gc = cgp * 256 + col;
    p.mod[(size_t)(l * 5 + cv) * 12288 + gc] = v + p.ada_b[l * 12288 + gc];
  }
  __syncthreads();
}

#define N_MOD 96
#define N_TR_LAYER 3840
#define N_TR (2 * N_TR_LAYER)
#define N_CV_KEYS 64
#define N_CV_U 4096
#define N_PREP (N_MOD + N_TR + N_CV_KEYS + 2 * N_CV_U + 1)

DI void prep_phase(const Params& p, char* smem) {
  for (int it = blockIdx.x; it < N_PREP; it += gridDim.x) {
    if (it < N_MOD) { mod_item(p, it, smem); continue; }
    int i = it - N_MOD;
    if (i < N_TR) {
      int l = i / N_TR_LAYER, j = i % N_TR_LAYER;
      float* tile = (float*)smem;
      if (j < 1440) { transpose_item(p.w_in + (size_t)l * DM * INW, INW, p.WinT + (size_t)l * INW * DM, DM, j / 45, j % 45, tile); continue; }
      j -= 1440;
      if (j < 192) { transpose_item(p.mla_w_qb + (size_t)l * 512 * 1536, 1536, p.WqbT + (size_t)l * 1536 * 512, 512, j / 24, j % 24, tile); continue; }
      j -= 192;
      if (j < 128) { transpose_item(p.mla_w_kvb + (size_t)l * 256 * 2048, 2048, p.WkvbT + (size_t)l * 2048 * 256, 256, j / 32, j % 32, tile); continue; }
      j -= 128;
      if (j < 1024) { transpose_item(p.w_out + (size_t)l * DM * DM, DM, p.WoutT + (size_t)l * DM * DM, DM, j / 32, j % 32, tile); continue; }
      j -= 1024;
      if (j < 1024) { transpose_item(p.peer_w_q + (size_t)l * DM * DM, DM, p.WpqT + (size_t)l * DM * DM, DM, j / 32, j % 32, tile); continue; }
      j -= 1024;
      {
        int mat = j >> 4, dh = j & 15;
        const float* src = (mat ? p.lru_w_i : p.lru_w_a) + (size_t)(l * 16 + dh) * 4096;
        ushort_t* dst = p.LruW + ((size_t)(l * 16 + dh) * 2 + mat) * 4096;
        transpose_item(src, 64, dst, 64, 0, 0, tile);
      }
      continue;
    }
    i -= N_TR;
    if (i < N_CV_KEYS) { convert_chunk(p.peer_keys, p.KeysB, (size_t)i * 8192); continue; }
    i -= N_CV_KEYS;
    if (i < N_CV_U) { quant_rows(p.peer_u, p.Ub, p.Us, (size_t)i * 8); continue; }
    i -= N_CV_U;
    if (i < N_CV_U) { quant_rows(p.peer_v, p.Vb, p.Vs, (size_t)i * 8); continue; }
    for (int e = threadIdx.x; e < 1024 * 32; e += 256) {
      int pos = e >> 5, f = e & 31;
      int fi = f & 15;
      float inv = 1.0f / powf(10000.0f, (float)fi / 16.0f);
      float base = (f < 16) ? (float)(pos >> 6) : (float)(pos & 63);
      float ang = base * inv;
      float sn, cs; sincosf(ang, &sn, &cs);
      p.rope[pos * 64 + f] = cs; p.rope[pos * 64 + 32 + f] = sn;
    }
  }
}

DI void norm_phase(const Params& p, int l, int which) {
  int tidq = opaque(threadIdx.x); int lane = tidq & 63, gw = blockIdx.x * 4 + (tidq >> 6), nw = gridDim.x * 4;
  const float* g = (which ? p.norm_ffn_g : p.norm_mix_g) + l * DM;
  int sh_off = which ? 6144 : 0, sc_off = which ? 8192 : 2048;
  for (int t = gw; t < NTOK; t += nw) {
    const float* xr = which ? p.x1 + (size_t)t * DM : xrow_in(p, l, t);
    const float* md = p.mod + (size_t)(l * 5 + cvidx(t)) * 12288;
    float4 v[8]; float ss = 0.f;
#pragma unroll
    for (int j = 0; j < 8; j++) { v[j] = *(const float4*)(xr + j * 256 + lane * 4); ss += v[j].x * v[j].x + v[j].y * v[j].y + v[j].z * v[j].z + v[j].w * v[j].w; }
    ss = wave_sum(ss);
    float rinv = rsqrtf(ss * (1.f / DM) + 1e-6f);
#pragma unroll
    for (int j = 0; j < 8; j++) {
      int col = j * 256 + lane * 4;
      float4 gg = *(const float4*)(g + col), sc = *(const float4*)(md + sc_off + col), sh = *(const float4*)(md + sh_off + col);
      float y0 = v[j].x * rinv * gg.x * (1.f + sc.x) + sh.x;
      float y1 = v[j].y * rinv * gg.y * (1.f + sc.y) + sh.y;
      float y2 = v[j].z * rinv * gg.z * (1.f + sc.z) + sh.z;
      float y3 = v[j].w * rinv * gg.w * (1.f + sc.w) + sh.w;
      uint2 o; o.x = pack_bf16(y0, y1); o.y = pack_bf16(y2, y3);
      *(uint2*)(p.hn + (size_t)t * DM + col) = o;
    }
  }
}

DI void lru_item(const Params& p, int l, int item, char* smem) {
  int ch = item >> 4, hd = (item >> 1) & 7, d = item & 1;
  int t0 = ch * 256, seq_t0, T, p0;
  if (ch < 16) { seq_t0 = ch * 256; T = 256; p0 = 0; }
  else { int b = (ch - 16) >> 2, cc = (ch - 16) & 3; seq_t0 = NCTX + b * 1024; T = 1024; p0 = cc * 256; }
  ushort_t* sBt = (ushort_t*)smem;
  ushort_t* sA = sBt + 128 * GLD;
  float* sXc = (float*)(sA + 64 * GLD);
  float* sG = sXc + 64 * 64;
  const int tid = opaque(threadIdx.x), wave = tid >> 6, lane = tid & 63;
  const int c = tid & 63, tg = tid >> 6;
  const ushort_t* Bt = p.LruW + ((size_t)((l * 2 + d) * 8 + hd) * 2) * 4096;
#pragma unroll
  for (int i = 0; i < 4; i++) { int cidx = tid + i * 256; int row = cidx >> 3, kc = (cidx & 7) * 8; *(uint4*)(sBt + row * GLD + kc) = *(const uint4*)(Bt + row * 64 + kc); }
  const int chn = hd * 64 + c;
  float cw[4];
#pragma unroll
  for (int j = 0; j < 4; j++) cw[j] = p.lru_conv_w[(l * 4 + j) * 512 + chn];
  const float cb = p.lru_conv_b[l * 512 + chn];
  const float ba = p.lru_b_a[(l * 2 + d) * 512 + chn], bi = p.lru_b_i[(l * 2 + d) * 512 + chn];
  const float lam = p.lru_lam[(l * 2 + d) * 512 + chn];
  const float sp = log1pf(expf(-lam));
  float hst = 0.f, Pp = 1.f;
  const int r = lane & 31, h8 = lane >> 5;
  for (int si = 0; si < 4; si++) {
    int sub = d ? 3 - si : si;
#pragma unroll 4
    for (int i = 0; i < 16; i++) {
      int lt = tg * 16 + i; int pos = p0 + sub * 64 + lt;
      float xc = cb;
#pragma unroll
      for (int j = 0; j < 4; j++) {
        int q = pos - 2 + j;
        float zv = (q >= 0 && q < T) ? p.z[(size_t)(seq_t0 + q) * INW + OFF_ZX + chn] : 0.f;
        xc += cw[j] * zv;
      }
      sXc[lt * 64 + c] = xc; sA[lt * GLD + c] = f2bf(xc);
    }
    __syncthreads();
    {
      int mt = wave & 1, nh = wave >> 1;
      f32x16 acc[2];
#pragma unroll
      for (int i = 0; i < 2; i++)
#pragma unroll
        for (int e = 0; e < 16; e++) acc[i][e] = 0.f;
#pragma unroll
      for (int ks = 0; ks < 4; ks++) {
        bf16x8 a = *(const bf16x8*)(sA + (mt * 32 + r) * GLD + ks * 16 + h8 * 8);
#pragma unroll
        for (int ni = 0; ni < 2; ni++) {
          bf16x8 b = *(const bf16x8*)(sBt + (nh * 64 + ni * 32 + r) * GLD + ks * 16 + h8 * 8);
          acc[ni] = MFMA32(a, b, acc[ni]);
        }
      }
#pragma unroll
      for (int ni = 0; ni < 2; ni++)
#pragma unroll
        for (int e = 0; e < 16; e++) sG[(mt * 32 + crow(e, h8)) * 132 + nh * 64 + ni * 32 + r] = acc[ni][e];
    }
    __syncthreads();
#pragma unroll 4
    for (int i = 0; i < 16; i++) {
      int lt = tg * 16 + i;
      float ga = sG[lt * 132 + c] + ba, gi = sG[lt * 132 + 64 + c] + bi;
      float rr = sigmoidf_(ga), ii = sigmoidf_(gi);
      float la = -8.0f * rr * sp;
      float a = __expf(la);
      const float x2 = 2.f * la;
      const float em = (x2 > -0.25f) ? -x2 * (1.f + x2 * (0.5f + x2 * (0.16666667f + x2 * (0.041666668f + x2 * 0.0083333338f)))) : -expm1f(x2);
      float u = __builtin_sqrtf(em) * ii * sXc[lt * 64 + c];
      sG[lt * 132 + c] = a; sG[lt * 132 + 64 + c] = u;
    }
    __syncthreads();
    if (tid < 64) {
      for (int s = 0; s < 64; s++) {
        int lt = d ? 63 - s : s;
        float a = sG[lt * 132 + c], u = sG[lt * 132 + 64 + c];
        hst = a * hst + u; Pp *= a;
        size_t o = ((size_t)d * NTOK + t0 + sub * 64 + lt) * 512 + chn;
        p.hs[o] = f2bf(hst); p.Pc[o] = f2bf(Pp);
      }
    }
    __syncthreads();
  }
  if (tid < 64) {
    p.hend[(d * 32 + ch) * 512 + chn] = hst; p.Pend[(d * 32 + ch) * 512 + chn] = Pp;
    if (ch < 16) p.out[(size_t)NTOK * DM + 16 * 2 * 256 * 256 + 16 * 2 * 256 * 64 + ((ch * 2 + l) * 2 + d) * 512 + chn] = hst;
  }
}

#define CMT 16
DI void cm_item(const Params& p, int l, int item, char* smem) {
  int t0 = item * CMT, seq_t0, T;
  if (t0 < NCTX) { seq_t0 = (t0 >> 8) << 8; T = 256; } else { seq_t0 = NCTX + (((t0 - NCTX) >> 10) << 10); T = 1024; }
  int p0 = t0 - seq_t0;
  unsigned* sGlu = (unsigned*)smem;
  float* red = (float*)(sGlu + (CMT + 30) * 256);
  float* red2 = red + 256;
  const int tid = opaque(threadIdx.x), wave = tid >> 6, lane = tid & 63;
#pragma unroll 8
  for (int rr = 0; rr < CMT + 30; rr++) {
    int pos = p0 - 15 + rr;
    unsigned v = 0;
    if (pos >= 0 && pos < T) {
      const float* zr = p.z + (size_t)(seq_t0 + pos) * INW + OFF_ZC;
      float2 a = *(const float2*)(zr + 2 * tid), b = *(const float2*)(zr + 512 + 2 * tid);
      v = pack_bf16(a.x * sigmoidf_(b.x), a.y * sigmoidf_(b.y));
    }
    sGlu[rr * 256 + tid] = v;
  }
  __syncthreads();
  float acc0[CMT], acc1[CMT];
  {
    float2 bb = *(const float2*)(p.cm_dw_b + l * 512 + 2 * tid);
#pragma unroll
    for (int t = 0; t < CMT; t++) { acc0[t] = bb.x; acc1[t] = bb.y; }
  }
  for (int j = 0; j < 31; j++) {
    float2 w = *(const float2*)(p.cm_dw_w + (size_t)(l * 31 + j) * 512 + 2 * tid);
#pragma unroll
    for (int t = 0; t < CMT; t++) { unsigned u = sGlu[(t + j) * 256 + tid]; acc0[t] += w.x * bf_lo(u); acc1[t] += w.y * bf_hi(u); }
  }
  {
    float ks = 0.f, kss = 0.f;
#pragma unroll
    for (int t = 0; t < CMT; t++) {
      float s = wave_sum(acc0[t] + acc1[t]);
      float ss = wave_sum(acc0[t] * acc0[t] + acc1[t] * acc1[t]);
      if (lane == t) { ks = s; kss = ss; }
    }
    if (lane < CMT) { red[(wave * CMT + lane) * 2] = ks; red[(wave * CMT + lane) * 2 + 1] = kss; }
  }
  __syncthreads();
  {
    float2 lg = *(const float2*)(p.cm_ln_g + l * 512 + 2 * tid), lb = *(const float2*)(p.cm_ln_b + l * 512 + 2 * tid);
    float k2 = 0.f;
#pragma unroll
    for (int t = 0; t < CMT; t++) {
      float s = red[(0 * CMT + t) * 2] + red[(1 * CMT + t) * 2] + red[(2 * CMT + t) * 2] + red[(3 * CMT + t) * 2];
      float ss = red[(0 * CMT + t) * 2 + 1] + red[(1 * CMT + t) * 2 + 1] + red[(2 * CMT + t) * 2 + 1] + red[(3 * CMT + t) * 2 + 1];
      float mu = s * (1.f / 512.f); float var = ss * (1.f / 512.f) - mu * mu; float rstd = rsqrtf(var + 1e-5f);
      float y0 = (acc0[t] - mu) * rstd * lg.x + lb.x, y1 = (acc1[t] - mu) * rstd * lg.y + lb.y;
      y0 = y0 * sigmoidf_(y0); y1 = y1 * sigmoidf_(y1);
      acc0[t] = y0; acc1[t] = y1;
      float s2 = wave_sum(y0 * y0 + y1 * y1);
      if (lane == t) k2 = s2;
    }
    if (lane < CMT) red2[wave * CMT + lane] = k2;
  }
  __syncthreads();
  {
    float2 gg = *(const float2*)(p.grp_g + l * DM + 1536 + 2 * tid);
#pragma unroll
    for (int t = 0; t < CMT; t++) {
      float tot = red2[t] + red2[CMT + t] + red2[2 * CMT + t] + red2[3 * CMT + t];
      float rinv = rsqrtf(tot * (1.f / 512.f) + 1e-6f);
      *(unsigned*)(p.mixed + (size_t)(t0 + t) * DM + 1536 + 2 * tid) = pack_bf16(acc0[t] * rinv * gg.x, acc1[t] * rinv * gg.y);
    }
  }
  __syncthreads();
}

DI void post_inproj_tokens(const Params& p, int l) {
  int tidq = opaque(threadIdx.x); int lane = tidq & 63, gw = blockIdx.x * 4 + (tidq >> 6), nw = gridDim.x * 4;
  float* new_ckv = p.out + (size_t)NTOK * DM;
  float* new_krope = new_ckv + 16 * 2 * 256 * 256;
  for (int t = gw; t < NTOK + 2048; t += nw) {
    if (t >= NTOK) {
      int rr = t - NTOK; int b = rr >> 9, j = rr & 511;
      float4 v = *(const float4*)(p.cache_ckv + ((size_t)(b * 2 + l) * 512 + j) * 256 + lane * 4);
      uint2 o; o.x = pack_bf16(v.x, v.y); o.y = pack_bf16(v.z, v.w);
      *(uint2*)(p.ckv + (size_t)(NCTX + b * 1536 + j) * 256 + lane * 4) = o;
      continue;
    }
    const float* zr = p.z + (size_t)t * INW;
    {
      float4 a = *(const float4*)(zr + lane * 4), b = *(const float4*)(zr + 256 + lane * 4);
      float ss = a.x * a.x + a.y * a.y + a.z * a.z + a.w * a.w + b.x * b.x + b.y * b.y + b.z * b.z + b.w * b.w;
      ss = wave_sum(ss);
      float rinv = rsqrtf(ss * (1.f / 512.f) + 1e-6f);
      float4 g0 = *(const float4*)(p.mla_qa_g + l * 512 + lane * 4), g1 = *(const float4*)(p.mla_qa_g + l * 512 + 256 + lane * 4);
      uint2 o0, o1;
      o0.x = pack_bf16(a.x * rinv * g0.x, a.y * rinv * g0.y); o0.y = pack_bf16(a.z * rinv * g0.z, a.w * rinv * g0.w);
      o1.x = pack_bf16(b.x * rinv * g1.x, b.y * rinv * g1.y); o1.y = pack_bf16(b.z * rinv * g1.z, b.w * rinv * g1.w);
      *(uint2*)(p.qa + (size_t)t * 512 + lane * 4) = o0;
      *(uint2*)(p.qa + (size_t)t * 512 + 256 + lane * 4) = o1;
    }
    {
      float4 a = *(const float4*)(zr + OFF_ZKV + lane * 4);
      float ss = wave_sum(a.x * a.x + a.y * a.y + a.z * a.z + a.w * a.w);
      float rinv = rsqrtf(ss * (1.f / 256.f) + 1e-6f);
      float4 g = *(const float4*)(p.mla_kva_g + l * 256 + lane * 4);
      float4 o = make_float4(a.x * rinv * g.x, a.y * rinv * g.y, a.z * rinv * g.z, a.w * rinv * g.w);
      uint2 ob; ob.x = pack_bf16(o.x, o.y); ob.y = pack_bf16(o.z, o.w);
      *(uint2*)(p.ckv + (size_t)kvrow_of_token(t) * 256 + lane * 4) = ob;
      if (t < NCTX) {
        int b = t >> 8, pos = t & 255;
        *(float4*)(new_ckv + ((size_t)(b * 2 + l) * 256 + pos) * 256 + lane * 4) = o;
        new_krope[((size_t)(b * 2 + l) * 256 + pos) * 64 + lane] = zr[OFF_ZKR + lane];
      }
    }
  }
}

DI void qnorm_tokens(const Params& p, int l) {
  int tidq = opaque(threadIdx.x); int lane = tidq & 63, gw = blockIdx.x * 4 + (tidq >> 6), nw = gridDim.x * 4;
  const float qscale = 0.07216878364870322f * 1.4426950408889634f;
  const float* g = p.mla_q_g + l * 192;
  float g0 = g[lane], g1 = g[64 + lane], g2 = g[128 + lane];
  for (int t = gw; t < NTOK; t += nw) {
    const ushort_t* qr = p.qraw + (size_t)t * 1536;
    bool lat = t >= NCTX; int pos = (t - NCTX) & 1023;
    float cs = 1.f, sn = 0.f;
    if (lat) { cs = p.rope[pos * 64 + (lane & 31)]; sn = p.rope[pos * 64 + 32 + (lane & 31)]; }
#pragma unroll
    for (int hh = 0; hh < 8; hh++) {
      float a = __uint_as_float((unsigned)qr[hh * 192 + lane] << 16), b = __uint_as_float((unsigned)qr[hh * 192 + 64 + lane] << 16), c = __uint_as_float((unsigned)qr[hh * 192 + 128 + lane] << 16);
      float ss = wave_sum(a * a + b * b + c * c);
      float rinv = rsqrtf(ss * (1.f / 192.f) + 1e-6f);
      a *= rinv * g0; b *= rinv * g1; c *= rinv * g2;
      if (lat) {
        float o = __shfl_xor(c, 32);
        c = (lane < 32) ? (c * cs - o * sn) : (o * sn + c * cs);
      }
      ushort_t* qo = p.Q + (size_t)t * 1536 + hh * 192;
      qo[lane] = f2bf(a * qscale); qo[64 + lane] = f2bf(b * qscale); qo[128 + lane] = f2bf(c * qscale);
    }
  }
}

DI void kv_item(const Params& p, int l, int item, char* smem) {
  int rt = item >> 3, hh = item & 7;
  int row0 = rt * 64;
  const int tid = opaque(threadIdx.x), wave = tid >> 6, lane = tid & 63;
  float* tile = (float*)smem;
  const float* g = p.mla_k_g + l * 192;
  float g0 = g[lane], g1 = g[64 + lane], g2 = g[128 + lane];
#pragma unroll 4
  for (int i = 0; i < 16; i++) {
    int lr = wave * 16 + i; int row = row0 + lr;
    const float* kr_src; bool rot = false; int pos = 0;
    if (row < NCTX) { kr_src = p.z + (size_t)row * INW + OFF_ZKR; }
    else {
      int rr = row - NCTX; int b = rr / 1536, j = rr % 1536;
      if (j < 512) kr_src = p.cache_krope + ((size_t)(b * 2 + l) * 512 + j) * 64;
      else { pos = j - 512; kr_src = p.z + (size_t)(NCTX + b * 1024 + pos) * INW + OFF_ZKR; rot = true; }
    }
    const ushort_t* kv = p.kvraw + (size_t)row * 2048 + hh * 256;
    float a = __uint_as_float((unsigned)kv[lane] << 16), b2 = __uint_as_float((unsigned)kv[64 + lane] << 16), c = kr_src[lane];
    float ss = wave_sum(a * a + b2 * b2 + c * c);
    float rinv = rsqrtf(ss * (1.f / 192.f) + 1e-6f);
    a *= rinv * g0; b2 *= rinv * g1; c *= rinv * g2;
    if (rot) {
      float cs = p.rope[pos * 64 + (lane & 31)], sn = p.rope[pos * 64 + 32 + (lane & 31)];
      float o = __shfl_xor(c, 32);
      c = (lane < 32) ? (c * cs - o * sn) : (o * sn + c * cs);
    }
    ushort_t* ko = p.K + (size_t)row * 1536 + hh * 192;
    ko[lane] = f2bf(a); ko[64 + lane] = f2bf(b2); ko[128 + lane] = f2bf(c);
    tile[lr * 129 + lane] = __uint_as_float((unsigned)kv[128 + lane] << 16); tile[lr * 129 + 64 + lane] = __uint_as_float((unsigned)kv[192 + lane] << 16);
  }
  __syncthreads();
  size_t vbase; int T, krow0;
  if (row0 < NCTX) { int sid = row0 >> 8; vbase = (size_t)(sid * 8 + hh) * 128 * 256; T = 256; krow0 = row0 & 255; }
  else { int rr = row0 - NCTX; int b = rr / 1536; vbase = (size_t)16 * 8 * 128 * 256 + (size_t)(b * 8 + hh) * 128 * 1536; T = 1536; krow0 = rr % 1536; }
#pragma unroll
  for (int i = 0; i < 4; i++) {
    int cidx = tid + i * 256; int dv = cidx >> 3, kg = cidx & 7;
    int G = kg >> 1, hhalf = kg & 1;
    float v[8];
#pragma unroll
    for (int s = 0; s < 8; s++) { int key = 16 * G + 8 * (s >> 2) + 4 * hhalf + (s & 3); v[s] = tile[key * 129 + dv]; }
    uint4 o; o.x = pack_bf16(v[0], v[1]); o.y = pack_bf16(v[2], v[3]); o.z = pack_bf16(v[4], v[5]); o.w = pack_bf16(v[6], v[7]);
    *(uint4*)(p.Vt + vbase + (size_t)dv * T + krow0 + kg * 8) = o;
  }
  __syncthreads();
}

#define KLD 200
#define VLD 72
DI void attn_item(const Params& p, int item, char* smem) {
  const int tid = opaque(threadIdx.x), wave = tid >> 6, lane = tid & 63;
  const int qs = wave & 1, kh = wave >> 1;
  int hh, Tk, tq0, kvbase; size_t vbase;
  if (item < 512) {
    int b = item >> 7; hh = (item >> 4) & 7; int qb = item & 15;
    Tk = 1536; tq0 = NCTX + b * 1024 + qb * 64; kvbase = NCTX + b * 1536;
    vbase = (size_t)16 * 8 * 128 * 256 + (size_t)(b * 8 + hh) * 128 * 1536;
  } else {
    int i2 = item - 512; int s = i2 >> 5; hh = (i2 >> 2) & 7; int qb = i2 & 3;
    Tk = 256; tq0 = s * 256 + qb * 64; kvbase = s * 256;
    vbase = (size_t)(s * 8 + hh) * 128 * 256;
  }
  ushort_t* sK = (ushort_t*)smem;
  ushort_t* sV = sK + 64 * KLD;
  const int r = lane & 31, h = lane >> 5;
  bf16x8 qf[12];
  {
    const ushort_t* qp = p.Q + (size_t)(tq0 + qs * 32 + r) * 1536 + hh * 192 + h * 8;
#pragma unroll
    for (int s = 0; s < 12; s++) qf[s] = *(const bf16x8*)(qp + s * 16);
  }
  f32x16 O[4];
#pragma unroll
  for (int i = 0; i < 4; i++)
#pragma unroll
    for (int e = 0; e < 16; e++) O[i][e] = 0.f;
  float m = -INFINITY, lsum = 0.f;
  const int nkt = Tk >> 6;
  const ushort_t* Kg = p.K + (size_t)kvbase * 1536 + hh * 192;
  const ushort_t* Vg = p.Vt + vbase;
  u32x4 rk[6], rv[4];
#pragma unroll
  for (int i = 0; i < 6; i++) { int c = tid + i * 256; int row = c / 24, kc = (c % 24) * 8; rk[i] = GLD16(Kg + (size_t)row * 1536 + kc); }
#pragma unroll
  for (int i = 0; i < 4; i++) { int c = tid + i * 256; int dv = c >> 3, kc = (c & 7) * 8; rv[i] = GLD16(Vg + (size_t)dv * Tk + kc); }
  for (int kt = 0; kt < nkt; kt++) {
    __syncthreads();
#pragma unroll
    for (int i = 0; i < 6; i++) { int c = tid + i * 256; int row = c / 24, kc = (c % 24) * 8; *(u32x4*)(sK + row * KLD + kc) = rk[i]; }
#pragma unroll
    for (int i = 0; i < 4; i++) { int c = tid + i * 256; int dv = c >> 3, kc = (c & 7) * 8; *(u32x4*)(sV + dv * VLD + kc) = rv[i]; }
    __syncthreads();
    if (kt + 1 < nkt) {
#pragma unroll
      for (int i = 0; i < 6; i++) { int c = tid + i * 256; int row = c / 24, kc = (c % 24) * 8; rk[i] = GLD16(Kg + (size_t)((kt + 1) * 64 + row) * 1536 + kc); }
#pragma unroll
      for (int i = 0; i < 4; i++) { int c = tid + i * 256; int dv = c >> 3, kc = (c & 7) * 8; rv[i] = GLD16(Vg + (size_t)dv * Tk + (kt + 1) * 64 + kc); }
    }
    f32x16 S;
#pragma unroll
    for (int e = 0; e < 16; e++) S[e] = 0.f;
    const ushort_t* kp = sK + (kh * 32 + r) * KLD + h * 8;
#pragma unroll
    for (int s = 0; s < 12; s++) { bf16x8 kf = *(const bf16x8*)(kp + s * 16); S = MFMA32(kf, qf[s], S); }
    float mx = S[0];
#pragma unroll
    for (int e = 1; e < 16; e++) mx = fmaxf(mx, S[e]);
    mx = fmaxf(mx, __shfl_xor(mx, 32));
    float mn = fmaxf(m, mx);
    float alpha = __builtin_amdgcn_exp2f(m - mn);
    float rs = 0.f;
#pragma unroll
    for (int e = 0; e < 16; e++) { S[e] = __builtin_amdgcn_exp2f(S[e] - mn); rs += S[e]; }
    rs += __shfl_xor(rs, 32);
    lsum = lsum * alpha + rs; m = mn;
#pragma unroll
    for (int i = 0; i < 4; i++)
#pragma unroll
      for (int e = 0; e < 16; e++) O[i][e] *= alpha;
    bf16x8 pf[2];
#pragma unroll
    for (int s2 = 0; s2 < 2; s2++) {
      u32x4 u; u.x = pack_bf16(S[8 * s2], S[8 * s2 + 1]); u.y = pack_bf16(S[8 * s2 + 2], S[8 * s2 + 3]);
      u.z = pack_bf16(S[8 * s2 + 4], S[8 * s2 + 5]); u.w = pack_bf16(S[8 * s2 + 6], S[8 * s2 + 7]);
      pf[s2] = __builtin_bit_cast(bf16x8, u);
    }
    const ushort_t* vp = sV + r * VLD + kh * 32 + h * 8;
#pragma unroll
    for (int dt = 0; dt < 4; dt++)
#pragma unroll
      for (int s2 = 0; s2 < 2; s2++) {
        bf16x8 vf = *(const bf16x8*)(vp + dt * 32 * VLD + s2 * 16);
        O[dt] = MFMA32(vf, pf[s2], O[dt]);
      }
  }
  __syncthreads();
  float* cO = (float*)smem;
  float* cML = cO + 2 * 64 * 64;
  if (kh == 1) {
#pragma unroll
    for (int dt = 0; dt < 4; dt++)
#pragma unroll
      for (int e = 0; e < 16; e++) cO[(qs * 64 + dt * 16 + e) * 64 + lane] = O[dt][e];
    cML[(qs * 2 + 0) * 64 + lane] = m; cML[(qs * 2 + 1) * 64 + lane] = lsum;
  }
  __syncthreads();
  if (kh == 0) {
    float m1 = cML[(qs * 2 + 0) * 64 + lane], l1 = cML[(qs * 2 + 1) * 64 + lane];
    float mf = fmaxf(m, m1);
    float a0 = exp2f(m - mf), a1 = exp2f(m1 - mf);
    float inv = 1.f / (lsum * a0 + l1 * a1);
    a0 *= inv; a1 *= inv;
    ushort_t* op = p.attn + (size_t)(tq0 + qs * 32 + r) * 1024 + hh * 128;
#pragma unroll
    for (int dt = 0; dt < 4; dt++)
#pragma unroll
      for (int gq = 0; gq < 4; gq++) {
        float o0 = O[dt][4 * gq] * a0 + cO[(qs * 64 + dt * 16 + 4 * gq) * 64 + lane] * a1;
        float o1 = O[dt][4 * gq + 1] * a0 + cO[(qs * 64 + dt * 16 + 4 * gq + 1) * 64 + lane] * a1;
        float o2 = O[dt][4 * gq + 2] * a0 + cO[(qs * 64 + dt * 16 + 4 * gq + 2) * 64 + lane] * a1;
        float o3 = O[dt][4 * gq + 3] * a0 + cO[(qs * 64 + dt * 16 + 4 * gq + 3) * 64 + lane] * a1;
        uint2 ov; ov.x = pack_bf16(o0, o1); ov.y = pack_bf16(o2, o3); *(uint2*)(op + dt * 32 + 8 * gq + 4 * h) = ov;
      }
  }
  __syncthreads();
}

DI void merge_tokens(const Params& p, int l) {
  int tidq = opaque(threadIdx.x); int lane = tidq & 63, gw = blockIdx.x * 4 + (tidq >> 6), nw = gridDim.x * 4;
  const float* gg = p.grp_g + l * DM;
  for (int t = gw; t < NTOK; t += nw) {
    {
      const ushort_t* ar = p.attn + (size_t)t * 1024;
      float4 v[4]; float ss = 0.f;
#pragma unroll
      for (int j = 0; j < 4; j++) { uint2 u_ = *(const uint2*)(ar + j * 256 + lane * 4); v[j] = make_float4(bf_lo(u_.x), bf_hi(u_.x), bf_lo(u_.y), bf_hi(u_.y)); ss += v[j].x * v[j].x + v[j].y * v[j].y + v[j].z * v[j].z + v[j].w * v[j].w; }
      ss = wave_sum(ss);
      float rinv = rsqrtf(ss * (1.f / 1024.f) + 1e-6f);
#pragma unroll
      for (int j = 0; j < 4; j++) {
        int col = j * 256 + lane * 4; float4 g = *(const float4*)(gg + col);
        uint2 o; o.x = pack_bf16(v[j].x * rinv * g.x, v[j].y * rinv * g.y); o.y = pack_bf16(v[j].z * rinv * g.z, v[j].w * rinv * g.w);
        *(uint2*)(p.mixed + (size_t)t * DM + col) = o;
      }
    }
    {
      float val[8]; float ss = 0.f;
      int ch = t >> 8;
#pragma unroll
      for (int j = 0; j < 2; j++) {
        int col = j * 256 + lane * 4;
        float cf[4] = {0, 0, 0, 0}, cbk[4] = {0, 0, 0, 0};
        if (t >= NCTX) {
          int b = (t - NCTX) >> 10, cc = (ch - 16) & 3, chb = 16 + b * 4;
          float4 h0f = *(const float4*)(p.state_lru + ((size_t)(b * 2 + l) * 2 + 0) * 512 + col);
          float4 h0b = *(const float4*)(p.state_lru + ((size_t)(b * 2 + l) * 2 + 1) * 512 + col);
          cf[0] = h0f.x; cf[1] = h0f.y; cf[2] = h0f.z; cf[3] = h0f.w;
          cbk[0] = h0b.x; cbk[1] = h0b.y; cbk[2] = h0b.z; cbk[3] = h0b.w;
          for (int jj = 0; jj < cc; jj++) {
            float4 he = *(const float4*)(p.hend + (size_t)(0 * 32 + chb + jj) * 512 + col), pe = *(const float4*)(p.Pend + (size_t)(0 * 32 + chb + jj) * 512 + col);
            cf[0] = he.x + pe.x * cf[0]; cf[1] = he.y + pe.y * cf[1]; cf[2] = he.z + pe.z * cf[2]; cf[3] = he.w + pe.w * cf[3];
          }
          for (int jj = 3; jj > cc; jj--) {
            float4 he = *(const float4*)(p.hend + (size_t)(1 * 32 + chb + jj) * 512 + col), pe = *(const float4*)(p.Pend + (size_t)(1 * 32 + chb + jj) * 512 + col);
            cbk[0] = he.x + pe.x * cbk[0]; cbk[1] = he.y + pe.y * cbk[1]; cbk[2] = he.z + pe.z * cbk[2]; cbk[3] = he.w + pe.w * cbk[3];
          }
        }
        uint2 uhf = *(const uint2*)(p.hs + ((size_t)0 * NTOK + t) * 512 + col), upf = *(const uint2*)(p.Pc + ((size_t)0 * NTOK + t) * 512 + col);
        uint2 uhb = *(const uint2*)(p.hs + ((size_t)1 * NTOK + t) * 512 + col), upb = *(const uint2*)(p.Pc + ((size_t)1 * NTOK + t) * 512 + col);
        float4 hf_ = make_float4(bf_lo(uhf.x), bf_hi(uhf.x), bf_lo(uhf.y), bf_hi(uhf.y)), pf_ = make_float4(bf_lo(upf.x), bf_hi(upf.x), bf_lo(upf.y), bf_hi(upf.y));
        float4 hb_ = make_float4(bf_lo(uhb.x), bf_hi(uhb.x), bf_lo(uhb.y), bf_hi(uhb.y)), pb_ = make_float4(bf_lo(upb.x), bf_hi(upb.x), bf_lo(upb.y), bf_hi(upb.y));
        float4 zg = *(const float4*)(p.z + (size_t)t * INW + OFF_ZG + col);
        float y0 = hf_.x + pf_.x * cf[0] + hb_.x + pb_.x * cbk[0];
        float y1 = hf_.y + pf_.y * cf[1] + hb_.y + pb_.y * cbk[1];
        float y2 = hf_.z + pf_.z * cf[2] + hb_.z + pb_.z * cbk[2];
        float y3 = hf_.w + pf_.w * cf[3] + hb_.w + pb_.w * cbk[3];
        y0 *= gelu_tanh(zg.x); y1 *= gelu_tanh(zg.y); y2 *= gelu_tanh(zg.z); y3 *= gelu_tanh(zg.w);
        val[j * 4] = y0; val[j * 4 + 1] = y1; val[j * 4 + 2] = y2; val[j * 4 + 3] = y3;
        ss += y0 * y0 + y1 * y1 + y2 * y2 + y3 * y3;
      }
      ss = wave_sum(ss);
      float rinv = rsqrtf(ss * (1.f / 512.f) + 1e-6f);
#pragma unroll
      for (int j = 0; j < 2; j++) {
        int col = j * 256 + lane * 4; float4 g = *(const float4*)(gg + 1024 + col);
        uint2 o; o.x = pack_bf16(val[j * 4] * rinv * g.x, val[j * 4 + 1] * rinv * g.y); o.y = pack_bf16(val[j * 4 + 2] * rinv * g.z, val[j * 4 + 3] * rinv * g.w);
        *(uint2*)(p.mixed + (size_t)t * DM + 1024 + col) = o;
      }
    }
  }
}

#define TOPK_INS(TV, TI, XV, XI) { float xv_ = (XV); int xi_ = (XI); _Pragma("unroll") for (int i_ = 0; i_ < 16; i_++) { bool c_ = xv_ > TV[i_]; float nv_ = c_ ? xv_ : TV[i_]; float ov_ = c_ ? TV[i_] : xv_; int ni_ = c_ ? xi_ : TI[i_]; int oi_ = c_ ? TI[i_] : xi_; TV[i_] = nv_; TI[i_] = ni_; xv_ = ov_; xi_ = oi_; } }
DI void peer_phase(const Params& p, int l, char* smem) {
  const int tid = opaque(threadIdx.x), wave = tid >> 6, lane = tid & 63;
  float* wsm = (float*)(smem + wave * 12288);
  float* lv = wsm;
  int* lidx = (int*)(wsm + 1024);
  int* pki = (int*)(wsm + 2048);
  float* pkg = wsm + 2560;
  const float* scores = p.z;
  const unsigned char* Ub = p.Ub + (size_t)l * NEXP * DM;
  const unsigned char* Vb = p.Vb + (size_t)l * NEXP * DM;
  const float* Us = p.Us + l * NEXP;
  const float* Vs = p.Vs + l * NEXP;
  float* dst = l == 0 ? p.xA : p.out;
  for (int tb = blockIdx.x; tb < NTOK / 16; tb += gridDim.x) {
    const int tg = tb * 4 + wave;
    {
      const GAS f32x4* sp = (const GAS f32x4*)(scores + (size_t)(tg * 4 + (lane >> 4)) * 2048 + (lane & 15) * 128);
      float tv[16]; int ti[16];
#pragma unroll
      for (int i = 0; i < 16; i++) { tv[i] = -INFINITY; ti[i] = 0; }
      for (int k = 0; k < 128; k += 8) {
        float x[8];
        { f32x4 xa_ = sp[k >> 2], xb_ = sp[(k >> 2) + 1]; x[0] = xa_[0]; x[1] = xa_[1]; x[2] = xa_[2]; x[3] = xa_[3]; x[4] = xb_[0]; x[5] = xb_[1]; x[6] = xb_[2]; x[7] = xb_[3]; }
#pragma unroll
        for (int u = 0; u < 8; u++) TOPK_INS(tv, ti, x[u], k + u);
      }
#pragma unroll
      for (int i = 0; i < 16; i++) { lv[i * 64 + lane] = tv[i]; lidx[i * 64 + lane] = ti[i]; }
    }
    __syncthreads();
    if (lane < 32) {
      const int tt = lane >> 3, hh = lane & 7;
      const int la = tt * 16 + 2 * hh, lb = la + 1;
      float s1[16], s2[16];
#pragma unroll
      for (int i = 0; i < 16; i++) { s1[i] = lv[i * 64 + la]; s2[i] = lv[i * 64 + lb]; }
      float cv[16]; int cf[16];
#pragma unroll
      for (int i = 0; i < 16; i++) { cv[i] = -INFINITY; cf[i] = 0; }
#pragma unroll
      for (int i = 0; i < 16; i++) {
#pragma unroll
        for (int j = 0; j < 16; j++) {
          if ((i + 1) * (j + 1) <= 16) TOPK_INS(cv, cf, s1[i] + s2[j], i * 16 + j);
        }
      }
      float e[16]; float sum = 0.f;
#pragma unroll
      for (int r = 0; r < 16; r++) { e[r] = __expf(cv[r] - cv[0]); sum += e[r]; }
      const float inv = 1.f / sum;
#pragma unroll
      for (int r = 0; r < 16; r++) {
        int id = lidx[(cf[r] >> 4) * 64 + la] * 128 + lidx[(cf[r] & 15) * 64 + lb];
        pki[tt * 128 + hh * 16 + r] = id; pkg[tt * 128 + hh * 16 + r] = e[r] * inv;
      }
    }
    __syncthreads();
    for (int tt = 0; tt < 4; tt++) {
    const int t = tg * 4 + tt;
    const int idx0 = pki[tt * 128 + lane], idx1 = pki[tt * 128 + 64 + lane];
    const float g0 = pkg[tt * 128 + lane], g1 = pkg[tt * 128 + 64 + lane];
    float xs[32];
#pragma unroll
    for (int j = 0; j < 2; j++) {
      const uint4* xp = (const uint4*)(p.hn + (size_t)t * DM + (j * 64 + lane) * 16);
      uint4 xa = xp[0], xb = xp[1];
      xs[j * 16 + 0] = bf_lo(xa.x); xs[j * 16 + 1] = bf_hi(xa.x); xs[j * 16 + 2] = bf_lo(xa.y); xs[j * 16 + 3] = bf_hi(xa.y);
      xs[j * 16 + 4] = bf_lo(xa.z); xs[j * 16 + 5] = bf_hi(xa.z); xs[j * 16 + 6] = bf_lo(xa.w); xs[j * 16 + 7] = bf_hi(xa.w);
      xs[j * 16 + 8] = bf_lo(xb.x); xs[j * 16 + 9] = bf_hi(xb.x); xs[j * 16 + 10] = bf_lo(xb.y); xs[j * 16 + 11] = bf_hi(xb.y);
      xs[j * 16 + 12] = bf_lo(xb.z); xs[j * 16 + 13] = bf_hi(xb.z); xs[j * 16 + 14] = bf_lo(xb.w); xs[j * 16 + 15] = bf_hi(xb.w);
    }
    const float us0 = Us[idx0], us1 = Us[idx1], vs0 = Vs[idx0], vs1 = Vs[idx1];
    float a0 = 0.f, a1 = 0.f;
    {
      u32x4 ld[8][2];
#pragma unroll
      for (int rr = 0; rr < 8; rr++) {
        int idx = __builtin_amdgcn_readlane(idx0, rr);
        const unsigned char* row = Ub + (size_t)idx * DM;
#pragma unroll
        for (int j = 0; j < 2; j++) ld[rr][j] = GLD16(row + (j * 64 + lane) * 16);
      }
      for (int k0 = 0; k0 < 128; k0 += 8) {
        int nsrc = (k0 + 8 < 64) ? idx0 : idx1;
        float part[8];
#pragma unroll
        for (int rr = 0; rr < 8; rr++) {
          float s = 0.f;
#pragma unroll
          for (int j = 0; j < 2; j++)
#pragma unroll
            for (int q = 0; q < 4; q++) {
              f32x2_t lo = __builtin_amdgcn_cvt_pk_f32_fp8((int)ld[rr][j][q], false);
              f32x2_t hi = __builtin_amdgcn_cvt_pk_f32_fp8((int)ld[rr][j][q], true);
              s += lo[0] * xs[j * 16 + q * 4] + lo[1] * xs[j * 16 + q * 4 + 1] + hi[0] * xs[j * 16 + q * 4 + 2] + hi[1] * xs[j * 16 + q * 4 + 3];
            }
          part[rr] = s;
          if (k0 + 8 < 128) {
            int idx = __builtin_amdgcn_readlane(nsrc, (k0 + 8 + rr) & 63);
            const unsigned char* row = Ub + (size_t)idx * DM;
#pragma unroll
            for (int j = 0; j < 2; j++) ld[rr][j] = GLD16(row + (j * 64 + lane) * 16);
          }
        }
#pragma unroll
        for (int o = 32; o; o >>= 1) {
#pragma unroll
          for (int rr = 0; rr < 8; rr++) part[rr] += __shfl_xor(part[rr], o);
        }
#pragma unroll
        for (int rr = 0; rr < 8; rr++) {
          if (lane == ((k0 + rr) & 63)) { if (k0 < 64) a0 = part[rr]; else a1 = part[rr]; }
        }
      }
    }
    float w0 = g0 * gelu_tanh(a0 * us0) * vs0, w1 = g1 * gelu_tanh(a1 * us1) * vs1;
    float acc[32];
#pragma unroll
    for (int e = 0; e < 32; e++) acc[e] = 0.f;
    {
      u32x4 ld[4][2];
#pragma unroll
      for (int rr = 0; rr < 4; rr++) {
        int idx = __builtin_amdgcn_readlane(idx0, rr);
        const unsigned char* row = Vb + (size_t)idx * DM;
#pragma unroll
        for (int j = 0; j < 2; j++) ld[rr][j] = GLD16(row + (j * 64 + lane) * 16);
      }
      for (int k0 = 0; k0 < 128; k0 += 4) {
        float wsrc = (k0 < 64) ? w0 : w1;
        int nsrc = (k0 + 4 < 64) ? idx0 : idx1;
#pragma unroll
        for (int rr = 0; rr < 4; rr++) {
          float w = rdlane_f(wsrc, (k0 + rr) & 63);
#pragma unroll
          for (int j = 0; j < 2; j++)
#pragma unroll
            for (int q = 0; q < 4; q++) {
              f32x2_t lo = __builtin_amdgcn_cvt_pk_f32_fp8((int)ld[rr][j][q], false);
              f32x2_t hi = __builtin_amdgcn_cvt_pk_f32_fp8((int)ld[rr][j][q], true);
              acc[j * 16 + q * 4 + 0] += w * lo[0]; acc[j * 16 + q * 4 + 1] += w * lo[1];
              acc[j * 16 + q * 4 + 2] += w * hi[0]; acc[j * 16 + q * 4 + 3] += w * hi[1];
            }
          if (k0 + 4 < 128) {
            int idx = __builtin_amdgcn_readlane(nsrc, (k0 + 4 + rr) & 63);
            const unsigned char* row = Vb + (size_t)idx * DM;
#pragma unroll
            for (int j = 0; j < 2; j++) ld[rr][j] = GLD16(row + (j * 64 + lane) * 16);
          }
        }
      }
    }
    const float* md = p.mod + (size_t)(l * 5 + cvidx(t)) * 12288 + 10240;
    float ssq = 0.f;
#pragma unroll
    for (int j = 0; j < 2; j++)
#pragma unroll
      for (int q = 0; q < 4; q++) {
        int col = (j * 64 + lane) * 16 + q * 4;
        float4 xa = *(const float4*)(p.x1 + (size_t)t * DM + col);
        float4 ga = *(const float4*)(md + col);
        float4 oa = make_float4(xa.x + ga.x * acc[j * 16 + q * 4], xa.y + ga.y * acc[j * 16 + q * 4 + 1], xa.z + ga.z * acc[j * 16 + q * 4 + 2], xa.w + ga.w * acc[j * 16 + q * 4 + 3]);
        *(float4*)(dst + (size_t)t * DM + col) = oa;
        acc[j * 16 + q * 4] = oa.x; acc[j * 16 + q * 4 + 1] = oa.y; acc[j * 16 + q * 4 + 2] = oa.z; acc[j * 16 + q * 4 + 3] = oa.w;
        ssq += oa.x * oa.x + oa.y * oa.y + oa.z * oa.z + oa.w * oa.w;
      }
    if (l == 0) {
      ssq = wave_sum(ssq);
      const float rinv = rsqrtf(ssq * (1.f / DM) + 1e-6f);
      const float* g = p.norm_mix_g + DM;
      const float* md1 = p.mod + (size_t)(5 + cvidx(t)) * 12288;
#pragma unroll
      for (int j = 0; j < 2; j++)
#pragma unroll
        for (int q = 0; q < 4; q++) {
          int col = (j * 64 + lane) * 16 + q * 4;
          float4 gg = *(const float4*)(g + col), sc = *(const float4*)(md1 + 2048 + col), sh = *(const float4*)(md1 + col);
          float y0 = acc[j * 16 + q * 4] * rinv * gg.x * (1.f + sc.x) + sh.x;
          float y1 = acc[j * 16 + q * 4 + 1] * rinv * gg.y * (1.f + sc.y) + sh.y;
          float y2 = acc[j * 16 + q * 4 + 2] * rinv * gg.z * (1.f + sc.z) + sh.z;
          float y3 = acc[j * 16 + q * 4 + 3] * rinv * gg.w * (1.f + sc.w) + sh.w;
          uint2 o; o.x = pack_bf16(y0, y1); o.y = pack_bf16(y2, y3);
          *(uint2*)(p.hn + (size_t)t * DM + col) = o;
        }
    }
    }
    __syncthreads();
  }
}

#define XB_TMO      128
#define XB_XCNT(j)  (256  + 64 * (j))
#define XB_XSUB(j)  (1280 + 64 * (j))
#define XB_XGEN(j)  (2304 + 64 * (j))
#define XB_TOP      3328
#define XB_TOPGEN   3392
#define XCD_BAR_WORDS 3456
#define XB_SPIN_CAP (1u << 18)
#define LAS __attribute__((address_space(3)))

__device__ __forceinline__ unsigned xb_ld(unsigned* p)              { return __hip_atomic_load(p, __ATOMIC_RELAXED, __HIP_MEMORY_SCOPE_AGENT); }
__device__ __forceinline__ unsigned xb_add(unsigned* p, unsigned v) { return __hip_atomic_fetch_add(p, v, __ATOMIC_RELAXED, __HIP_MEMORY_SCOPE_AGENT); }
__device__ __forceinline__ unsigned xb_xcc_id() { return (unsigned)__builtin_amdgcn_s_getreg((3 << 11) | 20) & 0xFu; }
#define XB_SPIN(cond, bar) do { unsigned _sp = 0; while (cond) { __builtin_amdgcn_s_sleep(1); \
    if ((++_sp & 255u) == 0u) { if (xb_ld(&(bar)[XB_TMO])) break; if (_sp > XB_SPIN_CAP) { atomicAdd(&(bar)[XB_TMO], 1u); break; } } } } while (0)

struct XcdBarrier {
    unsigned* bar; unsigned x;
    volatile LAS unsigned* st;
};

__device__ __forceinline__ XcdBarrier xcd_barrier_post(unsigned* bar, volatile LAS unsigned* st) {
    XcdBarrier b; b.bar = bar; b.x = xb_xcc_id(); b.st = st;
    if (threadIdx.x == 0) (void)xb_add(&bar[XB_XCNT(b.x)], 1u);
    return b;
}
__device__ __forceinline__ void xcd_barrier_complete(unsigned* bar, unsigned x, unsigned& nloc, unsigned& nx) {
    const unsigned G = gridDim.x * gridDim.y * gridDim.z;
    unsigned sum, cnt, mine, sp = 0u;
    for (;;) {
        sum = 0u; cnt = 0u; mine = 0u;
#pragma unroll
        for (unsigned j = 0; j < 16; ++j) { const unsigned c = xb_ld(&bar[XB_XCNT(j)]); sum += c; cnt += (c > 0u) ? 1u : 0u; mine = (j == x) ? c : mine; }
        if (sum == G) break;
        __builtin_amdgcn_s_sleep(1);
        if ((++sp & 255u) == 0u) { if (xb_ld(&bar[XB_TMO])) break; if (sp > XB_SPIN_CAP) { atomicAdd(&bar[XB_TMO], 1u); break; } }
    }
    nloc = mine > 0u ? mine : 1u; nx = cnt > 0u ? cnt : 1u;
}

__device__ __forceinline__ void xcd_barrier(const XcdBarrier& b) {
    asm volatile("s_waitcnt vmcnt(0)" ::: "memory");
    __syncthreads();
    if (threadIdx.x == 0) {
        unsigned* bar;
        {
            const unsigned long long bp = (unsigned long long)b.bar;
            const unsigned lo = (unsigned)__builtin_amdgcn_readfirstlane(opaque((int)(unsigned)bp));
            const unsigned hi = (unsigned)__builtin_amdgcn_readfirstlane(opaque((int)(unsigned)(bp >> 32)));
            bar = (unsigned*)(((unsigned long long)hi << 32) | lo);
        }
        const unsigned bx = xb_xcc_id() + (unsigned)opaque(0);
        __builtin_amdgcn_s_waitcnt(0);
        unsigned nloc = b.st[0], nx = b.st[1];
        if (nloc == 0u) { xcd_barrier_complete(bar, bx, nloc, nx); b.st[0] = nloc; b.st[1] = nx; }
        const unsigned old = xb_add(&bar[XB_XSUB(bx)], 1u);
        const unsigned gen = old / nloc;
        if (old + 1u == (gen + 1u) * nloc) {
            __builtin_amdgcn_fence(__ATOMIC_RELEASE, "agent");
            asm volatile("s_waitcnt vmcnt(0)" ::: "memory");
            const unsigned og = xb_add(&bar[XB_TOP], 1u);
            const unsigned tg = og / nx;
            if (og + 1u == (tg + 1u) * nx) xb_add(&bar[XB_TOPGEN], 1u);
            else XB_SPIN(xb_ld(&bar[XB_TOPGEN]) == tg, bar);
            __builtin_amdgcn_fence(__ATOMIC_ACQUIRE, "agent");
            xb_add(&bar[XB_XGEN(bx)], 1u);
            asm volatile("s_waitcnt vmcnt(0)" ::: "memory");
        } else {
            XB_SPIN(xb_ld(&bar[XB_XGEN(bx)]) == gen, bar);
            __builtin_amdgcn_fence(__ATOMIC_ACQUIRE, "agent");
            asm volatile("s_waitcnt vmcnt(0)" ::: "memory");
        }
    }
    __syncthreads();
}


DI void gsync(unsigned* bar, unsigned& gen) {
  asm volatile("s_waitcnt vmcnt(0) lgkmcnt(0)" ::: "memory");
  __syncthreads();
  if (threadIdx.x == 0) {
    __builtin_amdgcn_fence(__ATOMIC_RELEASE, "agent");
    asm volatile("s_waitcnt vmcnt(0)" ::: "memory");
    gen++;
    const unsigned ng = gridDim.x >> 3;
    unsigned* gc = bar + 32 * (1 + (blockIdx.x & 7));
    (void)__hip_atomic_fetch_add(gc, 1u, __ATOMIC_RELAXED, __HIP_MEMORY_SCOPE_AGENT);
    if (blockIdx.x < 8) {
      const unsigned gt = gen * ng;
      while (__hip_atomic_load(gc, __ATOMIC_RELAXED, __HIP_MEMORY_SCOPE_AGENT) < gt) __builtin_amdgcn_s_sleep(1);
      (void)__hip_atomic_fetch_add(bar, 1u, __ATOMIC_RELAXED, __HIP_MEMORY_SCOPE_AGENT);
    }
    const unsigned target = gen * 8u;
    while (__hip_atomic_load(bar, __ATOMIC_RELAXED, __HIP_MEMORY_SCOPE_AGENT) < target) __builtin_amdgcn_s_sleep(4);
    __builtin_amdgcn_fence(__ATOMIC_ACQUIRE, "agent");
    asm volatile("s_waitcnt vmcnt(0)" ::: "memory");
  }
  __syncthreads();
}

DI void dump_bf16(const Params& p, const ushort_t* src) {
  size_t n = (size_t)NTOK * DM; size_t tot = n + 16 * 2 * 256 * 256 + 16 * 2 * 256 * 64 + 16 * 2 * 2 * 512;
  for (size_t i = (size_t)blockIdx.x * 256 + threadIdx.x; i < tot; i += (size_t)gridDim.x * 256)
    p.out[i] = i < n ? __uint_as_float(((unsigned)src[i]) << 16) : (i < n + 2 * 5 * 12288 ? p.mod[i - n] : 0.f);
}


DI void dump_f32(const Params& p, const float* src, size_t n) {
  size_t tot = (size_t)NTOK * DM + 16 * 2 * 256 * 256 + 16 * 2 * 256 * 64 + 16 * 2 * 2 * 512;
  for (size_t i = (size_t)blockIdx.x * 256 + threadIdx.x; i < tot; i += (size_t)gridDim.x * 256)
    p.out[i] = i < n ? src[i] : 0.f;
}

__global__ void __launch_bounds__(256, 2) fwd_megakernel(Params pk) {
  __shared__ __attribute__((aligned(16))) char smem[SMEM_BYTES];
  __shared__ __attribute__((aligned(16))) unsigned long long spw[(sizeof(Params) + 7) / 8];
  {
    const unsigned long long* ka = (const unsigned long long*)__builtin_amdgcn_kernarg_segment_ptr();
    if (threadIdx.x < (sizeof(Params) + 7) / 8) spw[threadIdx.x] = ka[threadIdx.x];
    __syncthreads();
  }
#define PP (*(const Params*)((const char*)spw + opaque(0)))
  __shared__ uint4 xb_words;
  if (threadIdx.x == 0) xb_words = make_uint4(0u, 0u, 0u, 0u);
  __syncthreads();
  const XcdBarrier xb = xcd_barrier_post(PP.bar, (volatile LAS unsigned*)&xb_words);
  const int nb = gridDim.x, bid = blockIdx.x;
  const int wave = threadIdx.x >> 6, lane = threadIdx.x & 63;

  for (int rep = 0; rep < REP_A; rep++) {
  { const Params& p = PP; prep_phase(p, smem); }
  xcd_barrier(xb);
  }

  for (int l = 0; l < 2; l++) {
    for (int rep = 0; rep < REP_D; rep++) {
    if (l == 0) { { const Params& p = PP; norm_phase(p, l, 0); } xcd_barrier(xb); }
    }
    for (int rep = 0; rep < REP_B; rep++) {
    {
      const Params& p = PP;
      const ushort_t* Bt = p.WinT + (size_t)l * INW * DM;
      float* z = p.z;
      for (int j = bid >> 3; j < 192; j += nb >> 3) {
        int mt = (bid & 7) * 8 + ((j & 63) >> 3), nt = (j >> 6) * 8 + (j & 7);
        if (nt >= 23) continue;
        gemm_tile(p.hn, DM, Bt, DM, DM, INW, mt * 128, nt * 128, smem, [&](int row, int col, float v) { z[(size_t)row * INW + col] = v; });
      }
    }
    xcd_barrier(xb);
    }
    for (int rep = 0; rep < REP_D; rep++) {
    {
      const Params& p = PP;
      for (int it = bid; it < 512 + NTOK / CMT; it += nb) {
        if (it < 512) lru_item(p, l, it, smem); else cm_item(p, l, it - 512, smem);
      }
    }
    { const Params& p = PP; post_inproj_tokens(p, l); }
    xcd_barrier(xb);
    }
    for (int rep = 0; rep < REP_B; rep++) {
    {
      const Params& p = PP;
      const ushort_t* Bq = p.WqbT + (size_t)l * 1536 * 512;
      const ushort_t* Bkv = p.WkvbT + (size_t)l * 2048 * 256;
      ushort_t* qraw = p.qraw; ushort_t* kvraw = p.kvraw;
      for (int j = bid >> 3; j < 256; j += nb >> 3) {
        if (j < 160) {
          int rem = j % 80; int mt = (bid & 7) * 10 + (rem >> 3), nt = (j / 80) * 8 + (rem & 7);
          gemm_tile(p.ckv, 256, Bkv, 256, 256, 2048, mt * 128, nt * 128, smem, [&](int row, int col, float v) { kvraw[(size_t)row * 2048 + col] = f2bf(v); });
        } else {
          int j2 = j - 160; int rem = j2 % 48; int mt = (bid & 7) * 8 + rem / 6, nt = (j2 / 48) * 6 + rem % 6;
          gemm_tile(p.qa, 512, Bq, 512, 512, 1536, mt * 128, nt * 128, smem, [&](int row, int col, float v) { qraw[(size_t)row * 1536 + col] = f2bf(v); });
        }
      }
    }
    xcd_barrier(xb);
    }
    for (int rep = 0; rep < REP_D; rep++) {
    { const Params& p = PP; for (int it = bid; it < 160 * 8; it += nb) kv_item(p, l, it, smem); }
    { const Params& p = PP; qnorm_tokens(p, l); }
    xcd_barrier(xb);
    }
    for (int rep = 0; rep < REP_D; rep++) {
    { const Params& p = PP; for (int it = bid; it < 1024; it += nb) attn_item(p, it, smem); }
    xcd_barrier(xb);
    }
    for (int rep = 0; rep < REP_D; rep++) {
    { const Params& p = PP; merge_tokens(p, l); }
    xcd_barrier(xb);
    }
    for (int rep = 0; rep < REP_B; rep++) {
    {
      const Params& p = PP;
      const ushort_t* Bt = p.WoutT + (size_t)l * DM * DM;
      float* x1 = p.x1;
      for (int j = bid >> 3; j < 128; j += nb >> 3) {
        int mt = (bid & 7) * 8 + ((j & 63) >> 3), nt = (j >> 6) * 8 + (j & 7);
        gemm_tile(p.mixed, DM, Bt, DM, DM, DM, mt * 128, nt * 128, smem, [&](int row, int col, float v) {
          const float* xr = xrow_in(p, l, row);
          float g1 = p.mod[(size_t)(l * 5 + cvidx(row)) * 12288 + 4096 + col];
          x1[(size_t)row * DM + col] = xr[col] + g1 * v;
        });
      }
    }
    xcd_barrier(xb);
    }
    for (int rep = 0; rep < REP_D; rep++) {
    { const Params& p = PP; norm_phase(p, l, 1); }
    xcd_barrier(xb);
    }
    for (int rep = 0; rep < REP_B; rep++) {
    {
      const Params& p = PP;
      const ushort_t* Bt = p.WpqT + (size_t)l * DM * DM;
      const ushort_t* Kb = p.KeysB + (size_t)l * 2048 * 128;
      float* sc = (float*)p.z;
      ushort_t* sP = (ushort_t*)smem;
      for (int j = bid >> 3; j < 128; j += nb >> 3) {
        int mt = (bid & 7) * 8 + ((j & 63) >> 3), nt = (j >> 6) * 8 + (j & 7);
        gemm_tile(p.hn, DM, Bt, DM, DM, DM, mt * 128, nt * 128, smem, [&](int row, int col, float v) { sP[(row - mt * 128) * PLD + (col - nt * 128)] = f2bf(v); });
        scores_tile(Kb + (size_t)nt * 128 * 128, sc, mt, nt, smem);
      }
    }
    xcd_barrier(xb);
    }
    for (int rep = 0; rep < REP_C; rep++) {
    { const Params& p = PP; peer_phase(p, l, smem); }
    xcd_barrier(xb);
    }
  }
}

extern "C" void kernel_launch(void* const* d_in, const int* in_sizes, int n_in, void* d_out, int out_size, void* d_ws, size_t ws_size, hipStream_t stream) {
  static int grid_blocks = 0;
  if (!grid_blocks) {
    int dev = 0, cus = 0, per_cu = 0;
    hipGetDevice(&dev);
    hipDeviceGetAttribute(&cus, hipDeviceAttributeMultiprocessorCount, dev);
    hipOccupancyMaxActiveBlocksPerMultiprocessor(&per_cu, fwd_megakernel, 256, 0);
    if (per_cu > 2) per_cu = 2;
    if (per_cu < 1) per_cu = 1;
    grid_blocks = (cus * per_cu) & ~7;
  }
  Params p{};
  const float** pin = (const float**)&p;
  for (int i = 0; i < 35; i++) pin[i] = (const float*)d_in[i];
  p.out = (float*)d_out;
  char* w = (char*)d_ws; size_t off = 0;
  auto take = [&](size_t bytes) { char* r = w + off; off += (bytes + 255) & ~(size_t)255; return r; };
  p.bar = (unsigned*)take(16384);
  p.WinT = (ushort_t*)take((size_t)2 * INW * DM * 2);
  p.WqbT = (ushort_t*)take((size_t)2 * 1536 * 512 * 2);
  p.WkvbT = (ushort_t*)take((size_t)2 * 2048 * 256 * 2);
  p.WoutT = (ushort_t*)take((size_t)2 * DM * DM * 2);
  p.WpqT = (ushort_t*)take((size_t)2 * DM * DM * 2);
  p.KeysB = (ushort_t*)take((size_t)2 * 2048 * 128 * 2);
  p.LruW = (ushort_t*)take((size_t)2 * 16 * 2 * 4096 * 2);
  p.Ub = (unsigned char*)take((size_t)2 * NEXP * DM);
  p.Vb = (unsigned char*)take((size_t)2 * NEXP * DM);
  p.Us = (float*)take((size_t)2 * NEXP * 4);
  p.Vs = (float*)take((size_t)2 * NEXP * 4);
  p.hn = (ushort_t*)take((size_t)NTOK * DM * 2);
  p.qa = (ushort_t*)take((size_t)NTOK * 512 * 2);
  p.ckv = (ushort_t*)take((size_t)NKV * 256 * 2);
  p.Q = (ushort_t*)take((size_t)NTOK * 1536 * 2);
  p.K = (ushort_t*)take((size_t)NKV * 1536 * 2);
  p.Vt = (ushort_t*)take((size_t)NKV * 1024 * 2);
  p.mixed = (ushort_t*)take((size_t)NTOK * DM * 2);
  p.z = (float*)take((size_t)NTOK * INW * 4);
  p.qraw = (ushort_t*)take((size_t)NTOK * 1536 * 2);
  p.kvraw = (ushort_t*)take((size_t)NKV * 2048 * 2);
  p.attn = (ushort_t*)take((size_t)NTOK * 1024 * 2);
  p.hs = (ushort_t*)take((size_t)2 * NTOK * 512 * 2);
  p.Pc = (ushort_t*)take((size_t)2 * NTOK * 512 * 2);
  p.hend = (float*)take((size_t)2 * 32 * 512 * 4);
  p.Pend = (float*)take((size_t)2 * 32 * 512 * 4);
  p.x1 = (float*)take((size_t)NTOK * DM * 4);
  p.xA = (float*)take((size_t)NTOK * DM * 4);
  p.mod = (float*)take((size_t)2 * 5 * 12288 * 4);
  p.rope = (float*)take((size_t)1024 * 64 * 4);
  if (off > ws_size) { fprintf(stderr, "workspace too small: need %zu have %zu\n", off, ws_size); return; }
  if (hipMemsetAsync(p.bar, 0, 16384, stream) != hipSuccess) { fprintf(stderr, "memset failed\n"); return; }
  hipLaunchKernelGGL(fwd_megakernel, dim3(grid_blocks), dim3(256), 0, stream, p);
}
```

```cpp
#include <hip/hip_runtime.h>
#include <hip/hip_cooperative_groups.h>
#include <cstdio>
#include <cstdint>
namespace cg = cooperative_groups;

typedef unsigned short ushort_t;
typedef __attribute__((ext_vector_type(8))) short bf16x8;
typedef __attribute__((ext_vector_type(16))) float f32x16;
typedef __attribute__((ext_vector_type(4))) unsigned u32x4;
typedef __attribute__((ext_vector_type(4))) float f32x4;
typedef __attribute__((ext_vector_type(2))) float f32x2_t;
typedef __attribute__((ext_vector_type(2))) __bf16 bf16x2_t;
#define DI __device__ __forceinline__
#define GAS __attribute__((address_space(1)))
#define GLD16(ptr) (*(const GAS u32x4*)(ptr))
#define MFMA32(a, b, c) __builtin_amdgcn_mfma_f32_32x32x16_bf16((a), (b), (c), 0, 0, 0)

#define DM 2048
#define NTOK 8192
#define NCTX 4096
#define INW 2880
#define NKV 10240
#define OFF_ZKV 512
#define OFF_ZKR 768
#define OFF_ZX 832
#define OFF_ZG 1344
#define OFF_ZC 1856
#define NEXP 16384
#define SMEM_BYTES 78848
#ifndef REP_A
#define REP_A 1
#define REP_B 1
#define REP_C 1
#define REP_D 1
#endif

struct Params {
  const float *x_prompt, *x_sample, *cache_ckv, *cache_krope, *state_lru, *c, *c_ctx;
  const float *ada_w, *ada_b, *norm_mix_g, *w_in, *mla_qa_g, *mla_w_qb, *mla_q_g, *mla_kva_g, *mla_w_kvb, *mla_k_g;
  const float *lru_conv_w, *lru_conv_b, *lru_w_a, *lru_b_a, *lru_w_i, *lru_b_i, *lru_lam;
  const float *cm_dw_w, *cm_dw_b, *cm_ln_g, *cm_ln_b, *grp_g, *w_out, *norm_ffn_g;
  const float *peer_w_q, *peer_keys, *peer_u, *peer_v;
  float* out;
  unsigned* bar;
  ushort_t *WinT, *WqbT, *WkvbT, *WoutT, *WpqT, *KeysB, *LruW;
  unsigned char *Ub, *Vb;
  float *Us, *Vs;
  ushort_t *hn, *qa, *ckv, *Q, *K, *Vt, *mixed;
  ushort_t *qraw, *kvraw, *attn, *hs, *Pc;
  float *z, *hend, *Pend, *x1, *xA, *mod, *rope;
};

DI unsigned pack_bf16(float lo, float hi) { f32x2_t v = {lo, hi}; bf16x2_t b = __builtin_convertvector(v, bf16x2_t); return __builtin_bit_cast(unsigned, b); }
DI ushort_t f2bf(float x) { return (ushort_t)(pack_bf16(x, 0.f) & 0xffffu); }
DI float bf_lo(unsigned u) { return __uint_as_float(u << 16); }
DI float bf_hi(unsigned u) { return __uint_as_float(u & 0xffff0000u); }
DI float wave_sum(float v) { for (int o = 32; o; o >>= 1) v += __shfl_xor(v, o); return v; }
DI float sigmoidf_(float x) { return __builtin_amdgcn_rcpf(1.f + __expf(-x)); }
DI float gelu_tanh(float x) { const float y = 0.7978845608028654f * (x + 0.044715f * x * x * x); return x * __builtin_amdgcn_rcpf(1.f + __expf(-2.f * y)); }
DI int crow(int reg, int h) { return (reg & 3) + 8 * (reg >> 2) + 4 * h; }
DI int cvidx(int t) { return t < NCTX ? 0 : 1 + ((t - NCTX) >> 10); }
DI int kvrow_of_token(int t) { if (t < NCTX) return t; int tl = t - NCTX; return NCTX + (tl >> 10) * 1536 + 512 + (tl & 1023); }
DI const float* xrow_in(const Params& p, int l, int t) {
  if (l == 0) return t < NCTX ? p.x_prompt + (size_t)t * DM : p.x_sample + (size_t)(t - NCTX) * DM;
  return p.xA + (size_t)t * DM;
}
DI float dot2bf(unsigned a, unsigned b, float acc) { return __builtin_amdgcn_fdot2_f32_bf16(__builtin_bit_cast(bf16x2_t, a), __builtin_bit_cast(bf16x2_t, b), acc, false); }
DI int opaque(int x) { asm volatile("" : "+v"(x)); return x; }
DI float rdlane_f(float v, int l) { return __int_as_float(__builtin_amdgcn_readlane(__float_as_int(v), l)); }

#define GLD 72
template <class Epi>
DI void gemm_tile(const ushort_t* A, int lda, const ushort_t* Bt, int ldb, int K, int N, int m0, int n0, char* smem, Epi epi) {
  ushort_t* sA = (ushort_t*)smem;
  ushort_t* sB = sA + 128 * GLD;
  const int tid = opaque(threadIdx.x), wave = tid >> 6, lane = tid & 63, wm = wave & 1, wn = wave >> 1;
  const int r = lane & 31, h = lane >> 5;
  f32x16 acc[2][2];
#pragma unroll
  for (int i = 0; i < 2; i++)
#pragma unroll
    for (int j = 0; j < 2; j++)
#pragma unroll
      for (int e = 0; e < 16; e++) acc[i][j][e] = 0.f;
  u32x4 ra0[4], rb0[4], ra1[4], rb1[4];
  const int lrow = tid >> 3, lkc = (tid & 7) * 8;
  const ushort_t* Ap = A + (size_t)(m0 + lrow) * lda + lkc;
  const ushort_t* Bp[4];
#pragma unroll
  for (int i = 0; i < 4; i++) { int br = n0 + lrow + 32 * i; br = br < N ? br : N - 1; Bp[i] = Bt + (size_t)br * ldb + lkc; }
  auto gload = [&](u32x4* ra, u32x4* rb, int k0) {
#pragma unroll
    for (int i = 0; i < 4; i++) {
      ra[i] = GLD16(Ap + (size_t)(32 * i) * lda + k0);
      rb[i] = GLD16(Bp[i] + k0);
    }
  };
  auto lstore = [&](const u32x4* ra, const u32x4* rb, int buf) {
    ushort_t* dA = sA + buf * (2 * 128 * GLD) + lrow * GLD + lkc;
    ushort_t* dB = sB + buf * (2 * 128 * GLD) + lrow * GLD + lkc;
#pragma unroll
    for (int i = 0; i < 4; i++) { *(u32x4*)(dA + 32 * i * GLD) = ra[i]; *(u32x4*)(dB + 32 * i * GLD) = rb[i]; }
  };
  auto compute = [&](int buf) {
    const ushort_t* cA = sA + buf * (2 * 128 * GLD);
    const ushort_t* cB = sB + buf * (2 * 128 * GLD);
    bf16x8 a[2][2], b[2][2];
#pragma unroll
    for (int i = 0; i < 2; i++) {
      a[0][i] = *(const bf16x8*)(cA + (wm * 64 + i * 32 + r) * GLD + h * 8);
      b[0][i] = *(const bf16x8*)(cB + (wn * 64 + i * 32 + r) * GLD + h * 8);
    }
#pragma unroll
    for (int ks = 0; ks < 4; ks++) {
      if (ks < 3) {
#pragma unroll
        for (int i = 0; i < 2; i++) {
          a[(ks + 1) & 1][i] = *(const bf16x8*)(cA + (wm * 64 + i * 32 + r) * GLD + (ks + 1) * 16 + h * 8);
          b[(ks + 1) & 1][i] = *(const bf16x8*)(cB + (wn * 64 + i * 32 + r) * GLD + (ks + 1) * 16 + h * 8);
        }
      }
#pragma unroll
      for (int i = 0; i < 2; i++)
#pragma unroll
        for (int j = 0; j < 2; j++) acc[i][j] = MFMA32(a[ks & 1][i], b[ks & 1][j], acc[i][j]);
    }
  };
  gload(ra0, rb0, 0);
  gload(ra1, rb1, 64);
  lstore(ra0, rb0, 0);
  __syncthreads();
  const int klast = K - 64;
  gload(ra0, rb0, 128 < K ? 128 : klast);
  for (int k0 = 0; k0 < K; k0 += 128) {
    compute(0);
    lstore(ra1, rb1, 1);
    __syncthreads();
    gload(ra1, rb1, k0 + 192 < K ? k0 + 192 : klast);
    compute(1);
    lstore(ra0, rb0, 0);
    __syncthreads();
    gload(ra0, rb0, k0 + 256 < K ? k0 + 256 : klast);
  }
#pragma unroll
  for (int i = 0; i < 2; i++)
#pragma unroll
    for (int j = 0; j < 2; j++)
#pragma unroll
      for (int e = 0; e < 16; e++) {
        int row = m0 + wm * 64 + i * 32 + crow(e, h);
        int col = n0 + wn * 64 + j * 32 + r;
        if (col < N) epi(row, col, acc[i][j][e]);
      }
  __syncthreads();
}

#define PLD 136
DI void scores_tile(const ushort_t* Kt, float* sc, int mt, int nt, char* smem) {
  ushort_t* sP = (ushort_t*)smem;
  ushort_t* sK2 = sP + 128 * PLD;
  const int tid = opaque(threadIdx.x), wave = tid >> 6, lane = tid & 63, wm = wave & 1, wn = wave >> 1;
  const int r = lane & 31, h = lane >> 5;
#pragma unroll
  for (int i = 0; i < 8; i++) { int c = tid + i * 256; int row = c >> 4, kc = (c & 15) * 8; *(u32x4*)(sK2 + row * PLD + kc) = GLD16(Kt + row * 128 + kc); }
  __syncthreads();
  f32x16 acc[2][2];
#pragma unroll
  for (int i = 0; i < 2; i++)
#pragma unroll
    for (int j = 0; j < 2; j++)
#pragma unroll
      for (int e = 0; e < 16; e++) acc[i][j][e] = 0.f;
#pragma unroll
  for (int ks = 0; ks < 8; ks++) {
    bf16x8 a[2], b[2];
#pragma unroll
    for (int i = 0; i < 2; i++) {
      a[i] = *(const bf16x8*)(sP + (wm * 64 + i * 32 + r) * PLD + ks * 16 + h * 8);
      b[i] = *(const bf16x8*)(sK2 + (wn * 64 + i * 32 + r) * PLD + ks * 16 + h * 8);
    }
#pragma unroll
    for (int i = 0; i < 2; i++)
#pragma unroll
      for (int j = 0; j < 2; j++) acc[i][j] = MFMA32(a[i], b[j], acc[i][j]);
  }
#pragma unroll
  for (int i = 0; i < 2; i++)
#pragma unroll
    for (int j = 0; j < 2; j++)
#pragma unroll
      for (int e = 0; e < 16; e++) {
        int row = mt * 128 + wm * 64 + i * 32 + crow(e, h);
        int col = wn * 64 + j * 32 + r;
        sc[(size_t)row * 2048 + nt * 128 + col] = acc[i][j][e];
      }
  __syncthreads();
}

DI void transpose_item(const float* src, int lds_, ushort_t* dst, int ldd, int kt, int nt, float* tile) {
  int tid = opaque(threadIdx.x); int c = tid & 63, r0 = tid >> 6;
#pragma unroll 4
  for (int i = 0; i < 16; i++) { int r = r0 + 4 * i; tile[r * 65 + c] = src[(size_t)(kt * 64 + r) * lds_ + nt * 64 + c]; }
  __syncthreads();
#pragma unroll 4
  for (int i = 0; i < 16; i++) { int r = r0 + 4 * i; dst[(size_t)(nt * 64 + r) * ldd + kt * 64 + c] = f2bf(tile[c * 65 + r]); }
  __syncthreads();
}

DI void convert_chunk(const float* src, ushort_t* dst, size_t base) {
  int tid = opaque(threadIdx.x);
#pragma unroll
  for (int it = 0; it < 4; it++) {
    size_t e = base + it * 2048 + tid * 8;
    float4 a = *(const float4*)(src + e), b = *(const float4*)(src + e + 4);
    uint4 o; o.x = pack_bf16(a.x, a.y); o.y = pack_bf16(a.z, a.w); o.z = pack_bf16(b.x, b.y); o.w = pack_bf16(b.z, b.w);
    *(uint4*)(dst + e) = o;
  }
}


DI void quant_rows(const float* src, unsigned char* dst, float* scl, size_t row0) {
  int tid = opaque(threadIdx.x); int wave = tid >> 6, lane = tid & 63;
  const size_t rowa = row0 + wave * 2;
  float4 v[2][8]; float am[2] = {0.f, 0.f};
#pragma unroll
  for (int q = 0; q < 2; q++)
#pragma unroll
    for (int j = 0; j < 8; j++) { f32x4 t_ = *(const GAS f32x4*)(src + (rowa + q) * DM + (j * 64 + lane) * 4); v[q][j] = make_float4(t_[0], t_[1], t_[2], t_[3]); }
#pragma unroll
  for (int q = 0; q < 2; q++)
#pragma unroll
    for (int j = 0; j < 8; j++) am[q] = fmaxf(am[q], fmaxf(fmaxf(fabsf(v[q][j].x), fabsf(v[q][j].y)), fmaxf(fabsf(v[q][j].z), fabsf(v[q][j].w))));
  for (int o = 32; o; o >>= 1) { am[0] = fmaxf(am[0], __shfl_xor(am[0], o)); am[1] = fmaxf(am[1], __shfl_xor(am[1], o)); }
#pragma unroll
  for (int q = 0; q < 2; q++) {
    float sc = am[q] > 0.f ? 224.f / am[q] : 1.f;
    if (lane == 0) scl[rowa + q] = am[q] > 0.f ? am[q] * (1.f / 224.f) : 1.f;
#pragma unroll
    for (int j = 0; j < 8; j++) {
      int w = 0;
      w = __builtin_amdgcn_cvt_pk_fp8_f32(v[q][j].x * sc, v[q][j].y * sc, w, false);
      w = __builtin_amdgcn_cvt_pk_fp8_f32(v[q][j].z * sc, v[q][j].w * sc, w, true);
      *(int*)(dst + (rowa + q) * DM + (j * 64 + lane) * 4) = w;
    }
  }
}

DI void mod_item(const Params& p, int item, char* smem) {
  int l = item / 48, cgp = item % 48;
  float* s = (float*)smem;
  float* red = s + 5 * 2048;
  int tid = opaque(threadIdx.x), wave = tid >> 6, lane = tid & 63;
  for (int i = tid; i < 5 * 2048; i += 256) {
    int cv = i >> 11, k = i & 2047;
    float v = cv == 0 ? p.c_ctx[k] : p.c[(cv - 1) * DM + k];
    s[i] = v * sigmoidf_(v);
  }
  __syncthreads();
  const float* W = p.ada_w + (size_t)l * DM * 12288 + cgp * 256 + lane * 4;
  float4 acc[5];
#pragma unroll
  for (int cv = 0; cv < 5; cv++) acc[cv] = make_float4(0, 0, 0, 0);
  int kb = wave * 512;
#pragma unroll 8
  for (int k = kb; k < kb + 512; k++) {
    float4 w = *(const float4*)(W + (size_t)k * 12288);
#pragma unroll
    for (int cv = 0; cv < 5; cv++) {
      float sv = s[cv * 2048 + k];
      acc[cv].x += sv * w.x; acc[cv].y += sv * w.y; acc[cv].z += sv * w.z; acc[cv].w += sv * w.w;
    }
  }
#pragma unroll
  for (int cv = 0; cv < 5; cv++) *(float4*)(red + (wave * 5 + cv) * 256 + lane * 4) = acc[cv];
  __syncthreads();
  for (int i = tid; i < 5 * 256; i += 256) {
    int cv = i >> 8, col = i & 255;
    float v = red[(0 * 5 + cv) * 256 + col] + red[(1 * 5 + cv) * 256 + col] + red[(2 * 5 + cv) * 256 + col] + red[(3 * 5 + cv) * 256 + col];
    int gc = cgp * 256 + col;
    p.mod[(size_t)(l * 5 + cv) * 12288 + gc] = v + p.ada_b[l * 12288 + gc];
  }
  __syncthreads();
}

#define N_MOD 96
#define N_TR_LAYER 3840
#define N_TR (2 * N_TR_LAYER)
#define N_CV_KEYS 64
#define N_CV_U 4096
#define N_PREP (N_MOD + N_TR + N_CV_KEYS + 2 * N_CV_U + 1)

DI void prep_phase(const Params& p, char* smem) {
  for (int it = blockIdx.x; it < N_PREP; it += gridDim.x) {
    if (it < N_MOD) { mod_item(p, it, smem); continue; }
    int i = it - N_MOD;
    if (i < N_TR) {
      int l = i / N_TR_LAYER, j = i % N_TR_LAYER;
      float* tile = (float*)smem;
      if (j < 1440) { transpose_item(p.w_in + (size_t)l * DM * INW, INW, p.WinT + (size_t)l * INW * DM, DM, j / 45, j % 45, tile); continue; }
      j -= 1440;
      if (j < 192) { transpose_item(p.mla_w_qb + (size_t)l * 512 * 1536, 1536, p.WqbT + (size_t)l * 1536 * 512, 512, j / 24, j % 24, tile); continue; }
      j -= 192;
      if (j < 128) { transpose_item(p.mla_w_kvb + (size_t)l * 256 * 2048, 2048, p.WkvbT + (size_t)l * 2048 * 256, 256, j / 32, j % 32, tile); continue; }
      j -= 128;
      if (j < 1024) { transpose_item(p.w_out + (size_t)l * DM * DM, DM, p.WoutT + (size_t)l * DM * DM, DM, j / 32, j % 32, tile); continue; }
      j -= 1024;
      if (j < 1024) { transpose_item(p.peer_w_q + (size_t)l * DM * DM, DM, p.WpqT + (size_t)l * DM * DM, DM, j / 32, j % 32, tile); continue; }
      j -= 1024;
      {
        int mat = j >> 4, dh = j & 15;
        const float* src = (mat ? p.lru_w_i : p.lru_w_a) + (size_t)(l * 16 + dh) * 4096;
        ushort_t* dst = p.LruW + ((size_t)(l * 16 + dh) * 2 + mat) * 4096;
        transpose_item(src, 64, dst, 64, 0, 0, tile);
      }
      continue;
    }
    i -= N_TR;
    if (i < N_CV_KEYS) { convert_chunk(p.peer_keys, p.KeysB, (size_t)i * 8192); continue; }
    i -= N_CV_KEYS;
    if (i < N_CV_U) { quant_rows(p.peer_u, p.Ub, p.Us, (size_t)i * 8); continue; }
    i -= N_CV_U;
    if (i < N_CV_U) { quant_rows(p.peer_v, p.Vb, p.Vs, (size_t)i * 8); continue; }
    for (int e = threadIdx.x; e < 1024 * 32; e += 256) {
      int pos = e >> 5, f = e & 31;
      int fi = f & 15;
      float inv = 1.0f / powf(10000.0f, (float)fi / 16.0f);
      float base = (f < 16) ? (float)(pos >> 6) : (float)(pos & 63);
      float ang = base * inv;
      float sn, cs; sincosf(ang, &sn, &cs);
      p.rope[pos * 64 + f] = cs; p.rope[pos * 64 + 32 + f] = sn;
    }
  }
}

DI void norm_phase(const Params& p, int l, int which) {
  int tidq = opaque(threadIdx.x); int lane = tidq & 63, gw = blockIdx.x * 4 + (tidq >> 6), nw = gridDim.x * 4;
  const float* g = (which ? p.norm_ffn_g : p.norm_mix_g) + l * DM;
  int sh_off = which ? 6144 : 0, sc_off = which ? 8192 : 2048;
  for (int t = gw; t < NTOK; t += nw) {
    const float* xr = which ? p.x1 + (size_t)t * DM : xrow_in(p, l, t);
    const float* md = p.mod + (size_t)(l * 5 + cvidx(t)) * 12288;
    float4 v[8]; float ss = 0.f;
#pragma unroll
    for (int j = 0; j < 8; j++) { v[j] = *(const float4*)(xr + j * 256 + lane * 4); ss += v[j].x * v[j].x + v[j].y * v[j].y + v[j].z * v[j].z + v[j].w * v[j].w; }
    ss = wave_sum(ss);
    float rinv = rsqrtf(ss * (1.f / DM) + 1e-6f);
#pragma unroll
    for (int j = 0; j < 8; j++) {
      int col = j * 256 + lane * 4;
      float4 gg = *(const float4*)(g + col), sc = *(const float4*)(md + sc_off + col), sh = *(const float4*)(md + sh_off + col);
      float y0 = v[j].x * rinv * gg.x * (1.f + sc.x) + sh.x;
      float y1 = v[j].y * rinv * gg.y * (1.f + sc.y) + sh.y;
      float y2 = v[j].z * rinv * gg.z * (1.f + sc.z) + sh.z;
      float y3 = v[j].w * rinv * gg.w * (1.f + sc.w) + sh.w;
      uint2 o; o.x = pack_bf16(y0, y1); o.y = pack_bf16(y2, y3);
      *(uint2*)(p.hn + (size_t)t * DM + col) = o;
    }
  }
}

DI void lru_item(const Params& p, int l, int item, char* smem) {
  int ch = item >> 4, hd = (item >> 1) & 7, d = item & 1;
  int t0 = ch * 256, seq_t0, T, p0;
  if (ch < 16) { seq_t0 = ch * 256; T = 256; p0 = 0; }
  else { int b = (ch - 16) >> 2, cc = (ch - 16) & 3; seq_t0 = NCTX + b * 1024; T = 1024; p0 = cc * 256; }
  ushort_t* sBt = (ushort_t*)smem;
  ushort_t* sA = sBt + 128 * GLD;
  float* sXc = (float*)(sA + 64 * GLD);
  float* sG = sXc + 64 * 64;
  const int tid = opaque(threadIdx.x), wave = tid >> 6, lane = tid & 63;
  const int c = tid & 63, tg = tid >> 6;
  const ushort_t* Bt = p.LruW + ((size_t)((l * 2 + d) * 8 + hd) * 2) * 4096;
#pragma unroll
  for (int i = 0; i < 4; i++) { int cidx = tid + i * 256; int row = cidx >> 3, kc = (cidx & 7) * 8; *(uint4*)(sBt + row * GLD + kc) = *(const uint4*)(Bt + row * 64 + kc); }
  const int chn = hd * 64 + c;
  float cw[4];
#pragma unroll
  for (int j = 0; j < 4; j++) cw[j] = p.lru_conv_w[(l * 4 + j) * 512 + chn];
  const float cb = p.lru_conv_b[l * 512 + chn];
  const float ba = p.lru_b_a[(l * 2 + d) * 512 + chn], bi = p.lru_b_i[(l * 2 + d) * 512 + chn];
  const float lam = p.lru_lam[(l * 2 + d) * 512 + chn];
  const float sp = log1pf(expf(-lam));
  float hst = 0.f, Pp = 1.f;
  const int r = lane & 31, h8 = lane >> 5;
  for (int si = 0; si < 4; si++) {
    int sub = d ? 3 - si : si;
#pragma unroll 4
    for (int i = 0; i < 16; i++) {
      int lt = tg * 16 + i; int pos = p0 + sub * 64 + lt;
      float xc = cb;
#pragma unroll
      for (int j = 0; j < 4; j++) {
        int q = pos - 2 + j;
        float zv = (q >= 0 && q < T) ? p.z[(size_t)(seq_t0 + q) * INW + OFF_ZX + chn] : 0.f;
        xc += cw[j] * zv;
      }
      sXc[lt * 64 + c] = xc; sA[lt * GLD + c] = f2bf(xc);
    }
    __syncthreads();
    {
      int mt = wave & 1, nh = wave >> 1;
      f32x16 acc[2];
#pragma unroll
      for (int i = 0; i < 2; i++)
#pragma unroll
        for (int e = 0; e < 16; e++) acc[i][e] = 0.f;
#pragma unroll
      for (int ks = 0; ks < 4; ks++) {
        bf16x8 a = *(const bf16x8*)(sA + (mt * 32 + r) * GLD + ks * 16 + h8 * 8);
#pragma unroll
        for (int ni = 0; ni < 2; ni++) {
          bf16x8 b = *(const bf16x8*)(sBt + (nh * 64 + ni * 32 + r) * GLD + ks * 16 + h8 * 8);
          acc[ni] = MFMA32(a, b, acc[ni]);
        }
      }
#pragma unroll
      for (int ni = 0; ni < 2; ni++)
#pragma unroll
        for (int e = 0; e < 16; e++) sG[(mt * 32 + crow(e, h8)) * 132 + nh * 64 + ni * 32 + r] = acc[ni][e];
    }
    __syncthreads();
#pragma unroll 4
    for (int i = 0; i < 16; i++) {
      int lt = tg * 16 + i;
      float ga = sG[lt * 132 + c] + ba, gi = sG[lt * 132 + 64 + c] + bi;
      float rr = sigmoidf_(ga), ii = sigmoidf_(gi);
      float la = -8.0f * rr * sp;
      float a = __expf(la);
      const float x2 = 2.f * la;
      const float em = (x2 > -0.25f) ? -x2 * (1.f + x2 * (0.5f + x2 * (0.16666667f + x2 * (0.041666668f + x2 * 0.0083333338f)))) : -expm1f(x2);
      float u = __builtin_sqrtf(em) * ii * sXc[lt * 64 + c];
      sG[lt * 132 + c] = a; sG[lt * 132 + 64 + c] = u;
    }
    __syncthreads();
    if (tid < 64) {
      for (int s = 0; s < 64; s++) {
        int lt = d ? 63 - s : s;
        float a = sG[lt * 132 + c], u = sG[lt * 132 + 64 + c];
        hst = a * hst + u; Pp *= a;
        size_t o = ((size_t)d * NTOK + t0 + sub * 64 + lt) * 512 + chn;
        p.hs[o] = f2bf(hst); p.Pc[o] = f2bf(Pp);
      }
    }
    __syncthreads();
  }
  if (tid < 64) {
    p.hend[(d * 32 + ch) * 512 + chn] = hst; p.Pend[(d * 32 + ch) * 512 + chn] = Pp;
    if (ch < 16) p.out[(size_t)NTOK * DM + 16 * 2 * 256 * 256 + 16 * 2 * 256 * 64 + ((ch * 2 + l) * 2 + d) * 512 + chn] = hst;
  }
}

#define CMT 16
DI void cm_item(const Params& p, int l, int item, char* smem) {
  int t0 = item * CMT, seq_t0, T;
  if (t0 < NCTX) { seq_t0 = (t0 >> 8) << 8; T = 256; } else { seq_t0 = NCTX + (((t0 - NCTX) >> 10) << 10); T = 1024; }
  int p0 = t0 - seq_t0;
  unsigned* sGlu = (unsigned*)smem;
  float* red = (float*)(sGlu + (CMT + 30) * 256);
  float* red2 = red + 256;
  const int tid = opaque(threadIdx.x), wave = tid >> 6, lane = tid & 63;
#pragma unroll 8
  for (int rr = 0; rr < CMT + 30; rr++) {
    int pos = p0 - 15 + rr;
    unsigned v = 0;
    if (pos >= 0 && pos < T) {
      const float* zr = p.z + (size_t)(seq_t0 + pos) * INW + OFF_ZC;
      float2 a = *(const float2*)(zr + 2 * tid), b = *(const float2*)(zr + 512 + 2 * tid);
      v = pack_bf16(a.x * sigmoidf_(b.x), a.y * sigmoidf_(b.y));
    }
    sGlu[rr * 256 + tid] = v;
  }
  __syncthreads();
  float acc0[CMT], acc1[CMT];
  {
    float2 bb = *(const float2*)(p.cm_dw_b + l * 512 + 2 * tid);
#pragma unroll
    for (int t = 0; t < CMT; t++) { acc0[t] = bb.x; acc1[t] = bb.y; }
  }
  for (int j = 0; j < 31; j++) {
    float2 w = *(const float2*)(p.cm_dw_w + (size_t)(l * 31 + j) * 512 + 2 * tid);
#pragma unroll
    for (int t = 0; t < CMT; t++) { unsigned u = sGlu[(t + j) * 256 + tid]; acc0[t] += w.x * bf_lo(u); acc1[t] += w.y * bf_hi(u); }
  }
  {
    float ks = 0.f, kss = 0.f;
#pragma unroll
    for (int t = 0; t < CMT; t++) {
      float s = wave_sum(acc0[t] + acc1[t]);
      float ss = wave_sum(acc0[t] * acc0[t] + acc1[t] * acc1[t]);
      if (lane == t) { ks = s; kss = ss; }
    }
    if (lane < CMT) { red[(wave * CMT + lane) * 2] = ks; red[(wave * CMT + lane) * 2 + 1] = kss; }
  }
  __syncthreads();
  {
    float2 lg = *(const float2*)(p.cm_ln_g + l * 512 + 2 * tid), lb = *(const float2*)(p.cm_ln_b + l * 512 + 2 * tid);
    float k2 = 0.f;
#pragma unroll
    for (int t = 0; t < CMT; t++) {
      float s = red[(0 * CMT + t) * 2] + red[(1 * CMT + t) * 2] + red[(2 * CMT + t) * 2] + red[(3 * CMT + t) * 2];
      float ss = red[(0 * CMT + t) * 2 + 1] + red[(1 * CMT + t) * 2 + 1] + red[(2 * CMT + t) * 2 + 1] + red[(3 * CMT + t) * 2 + 1];
      float mu = s * (1.f / 512.f); float var = ss * (1.f / 512.f) - mu * mu; float rstd = rsqrtf(var + 1e-5f);
      float y0 = (acc0[t] - mu) * rstd * lg.x + lb.x, y1 = (acc1[t] - mu) * rstd * lg.y + lb.y;
      y0 = y0 * sigmoidf_(y0); y1 = y1 * sigmoidf_(y1);
      acc0[t] = y0; acc1[t] = y1;
      float s2 = wave_sum(y0 * y0 + y1 * y1);
      if (lane == t) k2 = s2;
    }
    if (lane < CMT) red2[wave * CMT + lane] = k2;
  }
  __syncthreads();
  {
    float2 gg = *(const float2*)(p.grp_g + l * DM + 1536 + 2 * tid);
#pragma unroll
    for (int t = 0; t < CMT; t++) {
      float tot = red2[t] + red2[CMT + t] + red2[2 * CMT + t] + red2[3 * CMT + t];
      float rinv = rsqrtf(tot * (1.f / 512.f) + 1e-6f);
      *(unsigned*)(p.mixed + (size_t)(t0 + t) * DM + 1536 + 2 * tid) = pack_bf16(acc0[t] * rinv * gg.x, acc1[t] * rinv * gg.y);
    }
  }
  __syncthreads();
}

DI void post_inproj_tokens(const Params& p, int l) {
  int tidq = opaque(threadIdx.x); int lane = tidq & 63, gw = blockIdx.x * 4 + (tidq >> 6), nw = gridDim.x * 4;
  float* new_ckv = p.out + (size_t)NTOK * DM;
  float* new_krope = new_ckv + 16 * 2 * 256 * 256;
  for (int t = gw; t < NTOK + 2048; t += nw) {
    if (t >= NTOK) {
      int rr = t - NTOK; int b = rr >> 9, j = rr & 511;
      float4 v = *(const float4*)(p.cache_ckv + ((size_t)(b * 2 + l) * 512 + j) * 256 + lane * 4);
      uint2 o; o.x = pack_bf16(v.x, v.y); o.y = pack_bf16(v.z, v.w);
      *(uint2*)(p.ckv + (size_t)(NCTX + b * 1536 + j) * 256 + lane * 4) = o;
      continue;
    }
    const float* zr = p.z + (size_t)t * INW;
    {
      float4 a = *(const float4*)(zr + lane * 4), b = *(const float4*)(zr + 256 + lane * 4);
      float ss = a.x * a.x + a.y * a.y + a.z * a.z + a.w * a.w + b.x * b.x + b.y * b.y + b.z * b.z + b.w * b.w;
      ss = wave_sum(ss);
      float rinv = rsqrtf(ss * (1.f / 512.f) + 1e-6f);
      float4 g0 = *(const float4*)(p.mla_qa_g + l * 512 + lane * 4), g1 = *(const float4*)(p.mla_qa_g + l * 512 + 256 + lane * 4);
      uint2 o0, o1;
      o0.x = pack_bf16(a.x * rinv * g0.x, a.y * rinv * g0.y); o0.y = pack_bf16(a.z * rinv * g0.z, a.w * rinv * g0.w);
      o1.x = pack_bf16(b.x * rinv * g1.x, b.y * rinv * g1.y); o1.y = pack_bf16(b.z * rinv * g1.z, b.w * rinv * g1.w);
      *(uint2*)(p.qa + (size_t)t * 512 + lane * 4) = o0;
      *(uint2*)(p.qa + (size_t)t * 512 + 256 + lane * 4) = o1;
    }
    {
      float4 a = *(const float4*)(zr + OFF_ZKV + lane * 4);
      float ss = wave_sum(a.x * a.x + a.y * a.y + a.z * a.z + a.w * a.w);
      float rinv = rsqrtf(ss * (1.f / 256.f) + 1e-6f);
      float4 g = *(const float4*)(p.mla_kva_g + l * 256 + lane * 4);
      float4 o = make_float4(a.x * rinv * g.x, a.y * rinv * g.y, a.z * rinv * g.z, a.w * rinv * g.w);
      uint2 ob; ob.x = pack_bf16(o.x, o.y); ob.y = pack_bf16(o.z, o.w);
      *(uint2*)(p.ckv + (size_t)kvrow_of_token(t) * 256 + lane * 4) = ob;
      if (t < NCTX) {
        int b = t >> 8, pos = t & 255;
        *(float4*)(new_ckv + ((size_t)(b * 2 + l) * 256 + pos) * 256 + lane * 4) = o;
        new_krope[((size_t)(b * 2 + l) * 256 + pos) * 64 + lane] = zr[OFF_ZKR + lane];
      }
    }
  }
}

DI void qnorm_tokens(const Params& p, int l) {
  int tidq = opaque(threadIdx.x); int lane = tidq & 63, gw = blockIdx.x * 4 + (tidq >> 6), nw = gridDim.x * 4;
  const float qscale = 0.07216878364870322f * 1.4426950408889634f;
  const float* g = p.mla_q_g + l * 192;
  float g0 = g[lane], g1 = g[64 + lane], g2 = g[128 + lane];
  for (int t = gw; t < NTOK; t += nw) {
    const ushort_t* qr = p.qraw + (size_t)t * 1536;
    bool lat = t >= NCTX; int pos = (t - NCTX) & 1023;
    float cs = 1.f, sn = 0.f;
    if (lat) { cs = p.rope[pos * 64 + (lane & 31)]; sn = p.rope[pos * 64 + 32 + (lane & 31)]; }
#pragma unroll
    for (int hh = 0; hh < 8; hh++) {
      float a = __uint_as_float((unsigned)qr[hh * 192 + lane] << 16), b = __uint_as_float((unsigned)qr[hh * 192 + 64 + lane] << 16), c = __uint_as_float((unsigned)qr[hh * 192 + 128 + lane] << 16);
      float ss = wave_sum(a * a + b * b + c * c);
      float rinv = rsqrtf(ss * (1.f / 192.f) + 1e-6f);
      a *= rinv * g0; b *= rinv * g1; c *= rinv * g2;
      if (lat) {
        float o = __shfl_xor(c, 32);
        c = (lane < 32) ? (c * cs - o * sn) : (o * sn + c * cs);
      }
      ushort_t* qo = p.Q + (size_t)t * 1536 + hh * 192;
      qo[lane] = f2bf(a * qscale); qo[64 + lane] = f2bf(b * qscale); qo[128 + lane] = f2bf(c * qscale);
    }
  }
}

DI void kv_item(const Params& p, int l, int item, char* smem) {
  int rt = item >> 3, hh = item & 7;
  int row0 = rt * 64;
  const int tid = opaque(threadIdx.x), wave = tid >> 6, lane = tid & 63;
  float* tile = (float*)smem;
  const float* g = p.mla_k_g + l * 192;
  float g0 = g[lane], g1 = g[64 + lane], g2 = g[128 + lane];
#pragma unroll 4
  for (int i = 0; i < 16; i++) {
    int lr = wave * 16 + i; int row = row0 + lr;
    const float* kr_src; bool rot = false; int pos = 0;
    if (row < NCTX) { kr_src = p.z + (size_t)row * INW + OFF_ZKR; }
    else {
      int rr = row - NCTX; int b = rr / 1536, j = rr % 1536;
      if (j < 512) kr_src = p.cache_krope + ((size_t)(b * 2 + l) * 512 + j) * 64;
      else { pos = j - 512; kr_src = p.z + (size_t)(NCTX + b * 1024 + pos) * INW + OFF_ZKR; rot = true; }
    }
    const ushort_t* kv = p.kvraw + (size_t)row * 2048 + hh * 256;
    float a = __uint_as_float((unsigned)kv[lane] << 16), b2 = __uint_as_float((unsigned)kv[64 + lane] << 16), c = kr_src[lane];
    float ss = wave_sum(a * a + b2 * b2 + c * c);
    float rinv = rsqrtf(ss * (1.f / 192.f) + 1e-6f);
    a *= rinv * g0; b2 *= rinv * g1; c *= rinv * g2;
    if (rot) {
      float cs = p.rope[pos * 64 + (lane & 31)], sn = p.rope[pos * 64 + 32 + (lane & 31)];
      float o = __shfl_xor(c, 32);
      c = (lane < 32) ? (c * cs - o * sn) : (o * sn + c * cs);
    }
    ushort_t* ko = p.K + (size_t)row * 1536 + hh * 192;
    ko[lane] = f2bf(a); ko[64 + lane] = f2bf(b2); ko[128 + lane] = f2bf(c);
    tile[lr * 129 + lane] = __uint_as_float((unsigned)kv[128 + lane] << 16); tile[lr * 129 + 64 + lane] = __uint_as_float((unsigned)kv[192 + lane] << 16);
  }
  __syncthreads();
  size_t vbase; int T, krow0;
  if (row0 < NCTX) { int sid = row0 >> 8; vbase = (size_t)(sid * 8 + hh) * 128 * 256; T = 256; krow0 = row0 & 255; }
  else { int rr = row0 - NCTX; int b = rr / 1536; vbase = (size_t)16 * 8 * 128 * 256 + (size_t)(b * 8 + hh) * 128 * 1536; T = 1536; krow0 = rr % 1536; }
#pragma unroll
  for (int i = 0; i < 4; i++) {
    int cidx = tid + i * 256; int dv = cidx >> 3, kg = cidx & 7;
    int G = kg >> 1, hhalf = kg & 1;
    float v[8];
#pragma unroll
    for (int s = 0; s < 8; s++) { int key = 16 * G + 8 * (s >> 2) + 4 * hhalf + (s & 3); v[s] = tile[key * 129 + dv]; }
    uint4 o; o.x = pack_bf16(v[0], v[1]); o.y = pack_bf16(v[2], v[3]); o.z = pack_bf16(v[4], v[5]); o.w = pack_bf16(v[6], v[7]);
    *(uint4*)(p.Vt + vbase + (size_t)dv * T + krow0 + kg * 8) = o;
  }
  __syncthreads();
}

#define KLD 200
#define VLD 72
DI void attn_item(const Params& p, int item, char* smem) {
  const int tid = opaque(threadIdx.x), wave = tid >> 6, lane = tid & 63;
  const int qs = wave & 1, kh = wave >> 1;
  int hh, Tk, tq0, kvbase; size_t vbase;
  if (item < 512) {
    int b = item >> 7; hh = (item >> 4) & 7; int qb = item & 15;
    Tk = 1536; tq0 = NCTX + b * 1024 + qb * 64; kvbase = NCTX + b * 1536;
    vbase = (size_t)16 * 8 * 128 * 256 + (size_t)(b * 8 + hh) * 128 * 1536;
  } else {
    int i2 = item - 512; int s = i2 >> 5; hh = (i2 >> 2) & 7; int qb = i2 & 3;
    Tk = 256; tq0 = s * 256 + qb * 64; kvbase = s * 256;
    vbase = (size_t)(s * 8 + hh) * 128 * 256;
  }
  ushort_t* sK = (ushort_t*)smem;
  ushort_t* sV = sK + 64 * KLD;
  const int r = lane & 31, h = lane >> 5;
  bf16x8 qf[12];
  {
    const ushort_t* qp = p.Q + (size_t)(tq0 + qs * 32 + r) * 1536 + hh * 192 + h * 8;
#pragma unroll
    for (int s = 0; s < 12; s++) qf[s] = *(const bf16x8*)(qp + s * 16);
  }
  f32x16 O[4];
#pragma unroll
  for (int i = 0; i < 4; i++)
#pragma unroll
    for (int e = 0; e < 16; e++) O[i][e] = 0.f;
  float m = -INFINITY, lsum = 0.f;
  const int nkt = Tk >> 6;
  const ushort_t* Kg = p.K + (size_t)kvbase * 1536 + hh * 192;
  const ushort_t* Vg = p.Vt + vbase;
  u32x4 rk[6], rv[4];
#pragma unroll
  for (int i = 0; i < 6; i++) { int c = tid + i * 256; int row = c / 24, kc = (c % 24) * 8; rk[i] = GLD16(Kg + (size_t)row * 1536 + kc); }
#pragma unroll
  for (int i = 0; i < 4; i++) { int c = tid + i * 256; int dv = c >> 3, kc = (c & 7) * 8; rv[i] = GLD16(Vg + (size_t)dv * Tk + kc); }
  for (int kt = 0; kt < nkt; kt++) {
    __syncthreads();
#pragma unroll
    for (int i = 0; i < 6; i++) { int c = tid + i * 256; int row = c / 24, kc = (c % 24) * 8; *(u32x4*)(sK + row * KLD + kc) = rk[i]; }
#pragma unroll
    for (int i = 0; i < 4; i++) { int c = tid + i * 256; int dv = c >> 3, kc = (c & 7) * 8; *(u32x4*)(sV + dv * VLD + kc) = rv[i]; }
    __syncthreads();
    if (kt + 1 < nkt) {
#pragma unroll
      for (int i = 0; i < 6; i++) { int c = tid + i * 256; int row = c / 24, kc = (c % 24) * 8; rk[i] = GLD16(Kg + (size_t)((kt + 1) * 64 + row) * 1536 + kc); }
#pragma unroll
      for (int i = 0; i < 4; i++) { int c = tid + i * 256; int dv = c >> 3, kc = (c & 7) * 8; rv[i] = GLD16(Vg + (size_t)dv * Tk + (kt + 1) * 64 + kc); }
    }
    f32x16 S;
#pragma unroll
    for (int e = 0; e < 16; e++) S[e] = 0.f;
    const ushort_t* kp = sK + (kh * 32 + r) * KLD + h * 8;
#pragma unroll
    for (int s = 0; s < 12; s++) { bf16x8 kf = *(const bf16x8*)(kp + s * 16); S = MFMA32(kf, qf[s], S); }
    float mx = S[0];
#pragma unroll
    for (int e = 1; e < 16; e++) mx = fmaxf(mx, S[e]);
    mx = fmaxf(mx, __shfl_xor(mx, 32));
    float mn = fmaxf(m, mx);
    float alpha = __builtin_amdgcn_exp2f(m - mn);
    float rs = 0.f;
#pragma unroll
    for (int e = 0; e < 16; e++) { S[e] = __builtin_amdgcn_exp2f(S[e] - mn); rs += S[e]; }
    rs += __shfl_xor(rs, 32);
    lsum = lsum * alpha + rs; m = mn;
#pragma unroll
    for (int i = 0; i < 4; i++)
#pragma unroll
      for (int e = 0; e < 16; e++) O[i][e] *= alpha;
    bf16x8 pf[2];
#pragma unroll
    for (int s2 = 0; s2 < 2; s2++) {
      u32x4 u; u.x = pack_bf16(S[8 * s2], S[8 * s2 + 1]); u.y = pack_bf16(S[8 * s2 + 2], S[8 * s2 + 3]);
      u.z = pack_bf16(S[8 * s2 + 4], S[8 * s2 + 5]); u.w = pack_bf16(S[8 * s2 + 6], S[8 * s2 + 7]);
      pf[s2] = __builtin_bit_cast(bf16x8, u);
    }
    const ushort_t* vp = sV + r * VLD + kh * 32 + h * 8;
#pragma unroll
    for (int dt = 0; dt < 4; dt++)
#pragma unroll
      for (int s2 = 0; s2 < 2; s2++) {
        bf16x8 vf = *(const bf16x8*)(vp + dt * 32 * VLD + s2 * 16);
        O[dt] = MFMA32(vf, pf[s2], O[dt]);
      }
  }
  __syncthreads();
  float* cO = (float*)smem;
  float* cML = cO + 2 * 64 * 64;
  if (kh == 1) {
#pragma unroll
    for (int dt = 0; dt < 4; dt++)
#pragma unroll
      for (int e = 0; e < 16; e++) cO[(qs * 64 + dt * 16 + e) * 64 + lane] = O[dt][e];
    cML[(qs * 2 + 0) * 64 + lane] = m; cML[(qs * 2 + 1) * 64 + lane] = lsum;
  }
  __syncthreads();
  if (kh == 0) {
    float m1 = cML[(qs * 2 + 0) * 64 + lane], l1 = cML[(qs * 2 + 1) * 64 + lane];
    float mf = fmaxf(m, m1);
    float a0 = exp2f(m - mf), a1 = exp2f(m1 - mf);
    float inv = 1.f / (lsum * a0 + l1 * a1);
    a0 *= inv; a1 *= inv;
    ushort_t* op = p.attn + (size_t)(tq0 + qs * 32 + r) * 1024 + hh * 128;
#pragma unroll
    for (int dt = 0; dt < 4; dt++)
#pragma unroll
      for (int gq = 0; gq < 4; gq++) {
        float o0 = O[dt][4 * gq] * a0 + cO[(qs * 64 + dt * 16 + 4 * gq) * 64 + lane] * a1;
        float o1 = O[dt][4 * gq + 1] * a0 + cO[(qs * 64 + dt * 16 + 4 * gq + 1) * 64 + lane] * a1;
        float o2 = O[dt][4 * gq + 2] * a0 + cO[(qs * 64 + dt * 16 + 4 * gq + 2) * 64 + lane] * a1;
        float o3 = O[dt][4 * gq + 3] * a0 + cO[(qs * 64 + dt * 16 + 4 * gq + 3) * 64 + lane] * a1;
        uint2 ov; ov.x = pack_bf16(o0, o1); ov.y = pack_bf16(o2, o3); *(uint2*)(op + dt * 32 + 8 * gq + 4 * h) = ov;
      }
  }
  __syncthreads();
}

DI void merge_tokens(const Params& p, int l) {
  int tidq = opaque(threadIdx.x); int lane = tidq & 63, gw = blockIdx.x * 4 + (tidq >> 6), nw = gridDim.x * 4;
  const float* gg = p.grp_g + l * DM;
  for (int t = gw; t < NTOK; t += nw) {
    {
      const ushort_t* ar = p.attn + (size_t)t * 1024;
      float4 v[4]; float ss = 0.f;
#pragma unroll
      for (int j = 0; j < 4; j++) { uint2 u_ = *(const uint2*)(ar + j * 256 + lane * 4); v[j] = make_float4(bf_lo(u_.x), bf_hi(u_.x), bf_lo(u_.y), bf_hi(u_.y)); ss += v[j].x * v[j].x + v[j].y * v[j].y + v[j].z * v[j].z + v[j].w * v[j].w; }
      ss = wave_sum(ss);
      float rinv = rsqrtf(ss * (1.f / 1024.f) + 1e-6f);
#pragma unroll
      for (int j = 0; j < 4; j++) {
        int col = j * 256 + lane * 4; float4 g = *(const float4*)(gg + col);
        uint2 o; o.x = pack_bf16(v[j].x * rinv * g.x, v[j].y * rinv * g.y); o.y = pack_bf16(v[j].z * rinv * g.z, v[j].w * rinv * g.w);
        *(uint2*)(p.mixed + (size_t)t * DM + col) = o;
      }
    }
    {
      float val[8]; float ss = 0.f;
      int ch = t >> 8;
#pragma unroll
      for (int j = 0; j < 2; j++) {
        int col = j * 256 + lane * 4;
        float cf[4] = {0, 0, 0, 0}, cbk[4] = {0, 0, 0, 0};
        if (t >= NCTX) {
          int b = (t - NCTX) >> 10, cc = (ch - 16) & 3, chb = 16 + b * 4;
          float4 h0f = *(const float4*)(p.state_lru + ((size_t)(b * 2 + l) * 2 + 0) * 512 + col);
          float4 h0b = *(const float4*)(p.state_lru + ((size_t)(b * 2 + l) * 2 + 1) * 512 + col);
          cf[0] = h0f.x; cf[1] = h0f.y; cf[2] = h0f.z; cf[3] = h0f.w;
          cbk[0] = h0b.x; cbk[1] = h0b.y; cbk[2] = h0b.z; cbk[3] = h0b.w;
          for (int jj = 0; jj < cc; jj++) {
            float4 he = *(const float4*)(p.hend + (size_t)(0 * 32 + chb + jj) * 512 + col), pe = *(const float4*)(p.Pend + (size_t)(0 * 32 + chb + jj) * 512 + col);
            cf[0] = he.x + pe.x * cf[0]; cf[1] = he.y + pe.y * cf[1]; cf[2] = he.z + pe.z * cf[2]; cf[3] = he.w + pe.w * cf[3];
          }
          for (int jj = 3; jj > cc; jj--) {
            float4 he = *(const float4*)(p.hend + (size_t)(1 * 32 + chb + jj) * 512 + col), pe = *(const float4*)(p.Pend + (size_t)(1 * 32 + chb + jj) * 512 + col);
            cbk[0] = he.x + pe.x * cbk[0]; cbk[1] = he.y + pe.y * cbk[1]; cbk[2] = he.z + pe.z * cbk[2]; cbk[3] = he.w + pe.w * cbk[3];
          }
        }
        uint2 uhf = *(const uint2*)(p.hs + ((size_t)0 * NTOK + t) * 512 + col), upf = *(const uint2*)(p.Pc + ((size_t)0 * NTOK + t) * 512 + col);
        uint2 uhb = *(const uint2*)(p.hs + ((size_t)1 * NTOK + t) * 512 + col), upb = *(const uint2*)(p.Pc + ((size_t)1 * NTOK + t) * 512 + col);
        float4 hf_ = make_float4(bf_lo(uhf.x), bf_hi(uhf.x), bf_lo(uhf.y), bf_hi(uhf.y)), pf_ = make_float4(bf_lo(upf.x), bf_hi(upf.x), bf_lo(upf.y), bf_hi(upf.y));
        float4 hb_ = make_float4(bf_lo(uhb.x), bf_hi(uhb.x), bf_lo(uhb.y), bf_hi(uhb.y)), pb_ = make_float4(bf_lo(upb.x), bf_hi(upb.x), bf_lo(upb.y), bf_hi(upb.y));
        float4 zg = *(const float4*)(p.z + (size_t)t * INW + OFF_ZG + col);
        float y0 = hf_.x + pf_.x * cf[0] + hb_.x + pb_.x * cbk[0];
        float y1 = hf_.y + pf_.y * cf[1] + hb_.y + pb_.y * cbk[1];
        float y2 = hf_.z + pf_.z * cf[2] + hb_.z + pb_.z * cbk[2];
        float y3 = hf_.w + pf_.w * cf[3] + hb_.w + pb_.w * cbk[3];
        y0 *= gelu_tanh(zg.x); y1 *= gelu_tanh(zg.y); y2 *= gelu_tanh(zg.z); y3 *= gelu_tanh(zg.w);
        val[j * 4] = y0; val[j * 4 + 1] = y1; val[j * 4 + 2] = y2; val[j * 4 + 3] = y3;
        ss += y0 * y0 + y1 * y1 + y2 * y2 + y3 * y3;
      }
      ss = wave_sum(ss);
      float rinv = rsqrtf(ss * (1.f / 512.f) + 1e-6f);
#pragma unroll
      for (int j = 0; j < 2; j++) {
        int col = j * 256 + lane * 4; float4 g = *(const float4*)(gg + 1024 + col);
        uint2 o; o.x = pack_bf16(val[j * 4] * rinv * g.x, val[j * 4 + 1] * rinv * g.y); o.y = pack_bf16(val[j * 4 + 2] * rinv * g.z, val[j * 4 + 3] * rinv * g.w);
        *(uint2*)(p.mixed + (size_t)t * DM + 1024 + col) = o;
      }
    }
  }
}

#define TOPK_INS(TV, TI, XV, XI) { float xv_ = (XV); int xi_ = (XI); _Pragma("unroll") for (int i_ = 0; i_ < 16; i_++) { bool c_ = xv_ > TV[i_]; float nv_ = c_ ? xv_ : TV[i_]; float ov_ = c_ ? TV[i_] : xv_; int ni_ = c_ ? xi_ : TI[i_]; int oi_ = c_ ? TI[i_] : xi_; TV[i_] = nv_; TI[i_] = ni_; xv_ = ov_; xi_ = oi_; } }
DI void peer_phase(const Params& p, int l, char* smem) {
  const int tid = opaque(threadIdx.x), wave = tid >> 6, lane = tid & 63;
  float* wsm = (float*)(smem + wave * 12288);
  float* lv = wsm;
  int* lidx = (int*)(wsm + 1024);
  int* pki = (int*)(wsm + 2048);
  float* pkg = wsm + 2560;
  const float* scores = p.z;
  const unsigned char* Ub = p.Ub + (size_t)l * NEXP * DM;
  const unsigned char* Vb = p.Vb + (size_t)l * NEXP * DM;
  const float* Us = p.Us + l * NEXP;
  const float* Vs = p.Vs + l * NEXP;
  float* dst = l == 0 ? p.xA : p.out;
  for (int tb = blockIdx.x; tb < NTOK / 16; tb += gridDim.x) {
    const int tg = tb * 4 + wave;
    {
      const GAS f32x4* sp = (const GAS f32x4*)(scores + (size_t)(tg * 4 + (lane >> 4)) * 2048 + (lane & 15) * 128);
      float tv[16]; int ti[16];
#pragma unroll
      for (int i = 0; i < 16; i++) { tv[i] = -INFINITY; ti[i] = 0; }
      for (int k = 0; k < 128; k += 8) {
        float x[8];
        { f32x4 xa_ = sp[k >> 2], xb_ = sp[(k >> 2) + 1]; x[0] = xa_[0]; x[1] = xa_[1]; x[2] = xa_[2]; x[3] = xa_[3]; x[4] = xb_[0]; x[5] = xb_[1]; x[6] = xb_[2]; x[7] = xb_[3]; }
#pragma unroll
        for (int u = 0; u < 8; u++) TOPK_INS(tv, ti, x[u], k + u);
      }
#pragma unroll
      for (int i = 0; i < 16; i++) { lv[i * 64 + lane] = tv[i]; lidx[i * 64 + lane] = ti[i]; }
    }
    __syncthreads();
    if (lane < 32) {
      const int tt = lane >> 3, hh = lane & 7;
      const int la = tt * 16 + 2 * hh, lb = la + 1;
      float s1[16], s2[16];
#pragma unroll
      for (int i = 0; i < 16; i++) { s1[i] = lv[i * 64 + la]; s2[i] = lv[i * 64 + lb]; }
      float cv[16]; int cf[16];
#pragma unroll
      for (int i = 0; i < 16; i++) { cv[i] = -INFINITY; cf[i] = 0; }
#pragma unroll
      for (int i = 0; i < 16; i++) {
#pragma unroll
        for (int j = 0; j < 16; j++) {
          if ((i + 1) * (j + 1) <= 16) TOPK_INS(cv, cf, s1[i] + s2[j], i * 16 + j);
        }
      }
      float e[16]; float sum = 0.f;
#pragma unroll
      for (int r = 0; r < 16; r++) { e[r] = __expf(cv[r] - cv[0]); sum += e[r]; }
      const float inv = 1.f / sum;
#pragma unroll
      for (int r = 0; r < 16; r++) {
        int id = lidx[(cf[r] >> 4) * 64 + la] * 128 + lidx[(cf[r] & 15) * 64 + lb];
        pki[tt * 128 + hh * 16 + r] = id; pkg[tt * 128 + hh * 16 + r] = e[r] * inv;
      }
    }
    __syncthreads();
    for (int tt = 0; tt < 4; tt++) {
    const int t = tg * 4 + tt;
    const int idx0 = pki[tt * 128 + lane], idx1 = pki[tt * 128 + 64 + lane];
    const float g0 = pkg[tt * 128 + lane], g1 = pkg[tt * 128 + 64 + lane];
    float xs[32];
#pragma unroll
    for (int j = 0; j < 2; j++) {
      const uint4* xp = (const uint4*)(p.hn + (size_t)t * DM + (j * 64 + lane) * 16);
      uint4 xa = xp[0], xb = xp[1];
      xs[j * 16 + 0] = bf_lo(xa.x); xs[j * 16 + 1] = bf_hi(xa.x); xs[j * 16 + 2] = bf_lo(xa.y); xs[j * 16 + 3] = bf_hi(xa.y);
      xs[j * 16 + 4] = bf_lo(xa.z); xs[j * 16 + 5] = bf_hi(xa.z); xs[j * 16 + 6] = bf_lo(xa.w); xs[j * 16 + 7] = bf_hi(xa.w);
      xs[j * 16 + 8] = bf_lo(xb.x); xs[j * 16 + 9] = bf_hi(xb.x); xs[j * 16 + 10] = bf_lo(xb.y); xs[j * 16 + 11] = bf_hi(xb.y);
      xs[j * 16 + 12] = bf_lo(xb.z); xs[j * 16 + 13] = bf_hi(xb.z); xs[j * 16 + 14] = bf_lo(xb.w); xs[j * 16 + 15] = bf_hi(xb.w);
    }
    const float us0 = Us[idx0], us1 = Us[idx1], vs0 = Vs[idx0], vs1 = Vs[idx1];
    float a0 = 0.f, a1 = 0.f;
    {
      u32x4 ld[8][2];
#pragma unroll
      for (int rr = 0; rr < 8; rr++) {
        int idx = __builtin_amdgcn_readlane(idx0, rr);
        const unsigned char* row = Ub + (size_t)idx * DM;
#pragma unroll
        for (int j = 0; j < 2; j++) ld[rr][j] = GLD16(row + (j * 64 + lane) * 16);
      }
      for (int k0 = 0; k0 < 128; k0 += 8) {
        int nsrc = (k0 + 8 < 64) ? idx0 : idx1;
        float part[8];
#pragma unroll
        for (int rr = 0; rr < 8; rr++) {
          float s = 0.f;
#pragma unroll
          for (int j = 0; j < 2; j++)
#pragma unroll
            for (int q = 0; q < 4; q++) {
              f32x2_t lo = __builtin_amdgcn_cvt_pk_f32_fp8((int)ld[rr][j][q], false);
              f32x2_t hi = __builtin_amdgcn_cvt_pk_f32_fp8((int)ld[rr][j][q], true);
              s += lo[0] * xs[j * 16 + q * 4] + lo[1] * xs[j * 16 + q * 4 + 1] + hi[0] * xs[j * 16 + q * 4 + 2] + hi[1] * xs[j * 16 + q * 4 + 3];
            }
          part[rr] = s;
          if (k0 + 8 < 128) {
            int idx = __builtin_amdgcn_readlane(nsrc, (k0 + 8 + rr) & 63);
            const unsigned char* row = Ub + (size_t)idx * DM;
#pragma unroll
            for (int j = 0; j < 2; j++) ld[rr][j] = GLD16(row + (j * 64 + lane) * 16);
          }
        }
#pragma unroll
        for (int o = 32; o; o >>= 1) {
#pragma unroll
          for (int rr = 0; rr < 8; rr++) part[rr] += __shfl_xor(part[rr], o);
        }
#pragma unroll
        for (int rr = 0; rr < 8; rr++) {
          if (lane == ((k0 + rr) & 63)) { if (k0 < 64) a0 = part[rr]; else a1 = part[rr]; }
        }
      }
    }
    float w0 = g0 * gelu_tanh(a0 * us0) * vs0, w1 = g1 * gelu_tanh(a1 * us1) * vs1;
    float acc[32];
#pragma unroll
    for (int e = 0; e < 32; e++) acc[e] = 0.f;
    {
      u32x4 ld[4][2];
#pragma unroll
      for (int rr = 0; rr < 4; rr++) {
        int idx = __builtin_amdgcn_readlane(idx0, rr);
        const unsigned char* row = Vb + (size_t)idx * DM;
#pragma unroll
        for (int j = 0; j < 2; j++) ld[rr][j] = GLD16(row + (j * 64 + lane) * 16);
      }
      for (int k0 = 0; k0 < 128; k0 += 4) {
        float wsrc = (k0 < 64) ? w0 : w1;
        int nsrc = (k0 + 4 < 64) ? idx0 : idx1;
#pragma unroll
        for (int rr = 0; rr < 4; rr++) {
          float w = rdlane_f(wsrc, (k0 + rr) & 63);
#pragma unroll
          for (int j = 0; j < 2; j++)
#pragma unroll
            for (int q = 0; q < 4; q++) {
              f32x2_t lo = __builtin_amdgcn_cvt_pk_f32_fp8((int)ld[rr][j][q], false);
              f32x2_t hi = __builtin_amdgcn_cvt_pk_f32_fp8((int)ld[rr][j][q], true);
              acc[j * 16 + q * 4 + 0] += w * lo[0]; acc[j * 16 + q * 4 + 1] += w * lo[1];
              acc[j * 16 + q * 4 + 2] += w * hi[0]; acc[j * 16 + q * 4 + 3] += w * hi[1];
            }
          if (k0 + 4 < 128) {
            int idx = __builtin_amdgcn_readlane(nsrc, (k0 + 4 + rr) & 63);
            const unsigned char* row = Vb + (size_t)idx * DM;
#pragma unroll
            for (int j = 0; j < 2; j++) ld[rr][j] = GLD16(row + (j * 64 + lane) * 16);
          }
        }
      }
    }
    const float* md = p.mod + (size_t)(l * 5 + cvidx(t)) * 12288 + 10240;
    float ssq = 0.f;
#pragma unroll
    for (int j = 0; j < 2; j++)
#pragma unroll
      for (int q = 0; q < 4; q++) {
        int col = (j * 64 + lane) * 16 + q * 4;
        float4 xa = *(const float4*)(p.x1 + (size_t)t * DM + col);
        float4 ga = *(const float4*)(md + col);
        float4 oa = make_float4(xa.x + ga.x * acc[j * 16 + q * 4], xa.y + ga.y * acc[j * 16 + q * 4 + 1], xa.z + ga.z * acc[j * 16 + q * 4 + 2], xa.w + ga.w * acc[j * 16 + q * 4 + 3]);
        *(float4*)(dst + (size_t)t * DM + col) = oa;
        acc[j * 16 + q * 4] = oa.x; acc[j * 16 + q * 4 + 1] = oa.y; acc[j * 16 + q * 4 + 2] = oa.z; acc[j * 16 + q * 4 + 3] = oa.w;
        ssq += oa.x * oa.x + oa.y * oa.y + oa.z * oa.z + oa.w * oa.w;
      }
    if (l == 0) {
      ssq = wave_sum(ssq);
      const float rinv = rsqrtf(ssq * (1.f / DM) + 1e-6f);
      const float* g = p.norm_mix_g + DM;
      const float* md1 = p.mod + (size_t)(5 + cvidx(t)) * 12288;
#pragma unroll
      for (int j = 0; j < 2; j++)
#pragma unroll
        for (int q = 0; q < 4; q++) {
          int col = (j * 64 + lane) * 16 + q * 4;
          float4 gg = *(const float4*)(g + col), sc = *(const float4*)(md1 + 2048 + col), sh = *(const float4*)(md1 + col);
          float y0 = acc[j * 16 + q * 4] * rinv * gg.x * (1.f + sc.x) + sh.x;
          float y1 = acc[j * 16 + q * 4 + 1] * rinv * gg.y * (1.f + sc.y) + sh.y;
          float y2 = acc[j * 16 + q * 4 + 2] * rinv * gg.z * (1.f + sc.z) + sh.z;
          float y3 = acc[j * 16 + q * 4 + 3] * rinv * gg.w * (1.f + sc.w) + sh.w;
          uint2 o; o.x = pack_bf16(y0, y1); o.y = pack_bf16(y2, y3);
          *(uint2*)(p.hn + (size_t)t * DM + col) = o;
        }
    }
    }
    __syncthreads();
  }
}

#define XB_TMO      128
#define XB_XCNT(j)  (256  + 64 * (j))
#define XB_XSUB(j)  (1280 + 64 * (j))
#define XB_XGEN(j)  (2304 + 64 * (j))
#define XB_TOP      3328
#define XB_TOPGEN   3392
#define XCD_BAR_WORDS 3456
#define XB_SPIN_CAP (1u << 18)
#define LAS __attribute__((address_space(3)))

__device__ __forceinline__ unsigned xb_ld(unsigned* p)              { return __hip_atomic_load(p, __ATOMIC_RELAXED, __HIP_MEMORY_SCOPE_AGENT); }
__device__ __forceinline__ unsigned xb_add(unsigned* p, unsigned v) { return __hip_atomic_fetch_add(p, v, __ATOMIC_RELAXED, __HIP_MEMORY_SCOPE_AGENT); }
__device__ __forceinline__ unsigned xb_xcc_id() { return (unsigned)__builtin_amdgcn_s_getreg((3 << 11) | 20) & 0xFu; }
#define XB_SPIN(cond, bar) do { unsigned _sp = 0; while (cond) { __builtin_amdgcn_s_sleep(1); \
    if ((++_sp & 255u) == 0u) { if (xb_ld(&(bar)[XB_TMO])) break; if (_sp > XB_SPIN_CAP) { atomicAdd(&(bar)[XB_TMO], 1u); break; } } } } while (0)

struct XcdBarrier {
    unsigned* bar; unsigned x;
    volatile LAS unsigned* st;
};

__device__ __forceinline__ XcdBarrier xcd_barrier_post(unsigned* bar, volatile LAS unsigned* st) {
    XcdBarrier b; b.bar = bar; b.x = xb_xcc_id(); b.st = st;
    if (threadIdx.x == 0) (void)xb_add(&bar[XB_XCNT(b.x)], 1u);
    return b;
}
__device__ __forceinline__ void xcd_barrier_complete(unsigned* bar, unsigned x, unsigned& nloc, unsigned& nx) {
    const unsigned G = gridDim.x * gridDim.y * gridDim.z;
    unsigned sum, cnt, mine, sp = 0u;
    for (;;) {
        sum = 0u; cnt = 0u; mine = 0u;
#pragma unroll
        for (unsigned j = 0; j < 16; ++j) { const unsigned c = xb_ld(&bar[XB_XCNT(j)]); sum += c; cnt += (c > 0u) ? 1u : 0u; mine = (j == x) ? c : mine; }
        if (sum == G) break;
        __builtin_amdgcn_s_sleep(1);
        if ((++sp & 255u) == 0u) { if (xb_ld(&bar[XB_TMO])) break; if (sp > XB_SPIN_CAP) { atomicAdd(&bar[XB_TMO], 1u); break; } }
    }
    nloc = mine > 0u ? mine : 1u; nx = cnt > 0u ? cnt : 1u;
}

__device__ __forceinline__ void xcd_barrier(const XcdBarrier& b) {
    asm volatile("s_waitcnt vmcnt(0)" ::: "memory");
    __syncthreads();
    if (threadIdx.x == 0) {
        unsigned* bar;
        {
            const unsigned long long bp = (unsigned long long)b.bar;
            const unsigned lo = (unsigned)__builtin_amdgcn_readfirstlane(opaque((int)(unsigned)bp));
            const unsigned hi = (unsigned)__builtin_amdgcn_readfirstlane(opaque((int)(unsigned)(bp >> 32)));
            bar = (unsigned*)(((unsigned long long)hi << 32) | lo);
        }
        const unsigned bx = xb_xcc_id() + (unsigned)opaque(0);
        __builtin_amdgcn_s_waitcnt(0);
        unsigned nloc = b.st[0], nx = b.st[1];
        if (nloc == 0u) { xcd_barrier_complete(bar, bx, nloc, nx); b.st[0] = nloc; b.st[1] = nx; }
        const unsigned old = xb_add(&bar[XB_XSUB(bx)], 1u);
        const unsigned gen = old / nloc;
        if (old + 1u == (gen + 1u) * nloc) {
            __builtin_amdgcn_fence(__ATOMIC_RELEASE, "agent");
            asm volatile("s_waitcnt vmcnt(0)" ::: "memory");
            const unsigned og = xb_add(&bar[XB_TOP], 1u);
            const unsigned tg = og / nx;
            if (og + 1u == (tg + 1u) * nx) xb_add(&bar[XB_TOPGEN], 1u);
            else XB_SPIN(xb_ld(&bar[XB_TOPGEN]) == tg, bar);
            __builtin_amdgcn_fence(__ATOMIC_ACQUIRE, "agent");
            xb_add(&bar[XB_XGEN(bx)], 1u);
            asm volatile("s_waitcnt vmcnt(0)" ::: "memory");
        } else {
            XB_SPIN(xb_ld(&bar[XB_XGEN(bx)]) == gen, bar);
            __builtin_amdgcn_fence(__ATOMIC_ACQUIRE, "agent");
            asm volatile("s_waitcnt vmcnt(0)" ::: "memory");
        }
    }
    __syncthreads();
}


DI void gsync(unsigned* bar, unsigned& gen) {
  asm volatile("s_waitcnt vmcnt(0) lgkmcnt(0)" ::: "memory");
  __syncthreads();
  if (threadIdx.x == 0) {
    __builtin_amdgcn_fence(__ATOMIC_RELEASE, "agent");
    asm volatile("s_waitcnt vmcnt(0)" ::: "memory");
    gen++;
    const unsigned ng = gridDim.x >> 3;
    unsigned* gc = bar + 32 * (1 + (blockIdx.x & 7));
    (void)__hip_atomic_fetch_add(gc, 1u, __ATOMIC_RELAXED, __HIP_MEMORY_SCOPE_AGENT);
    if (blockIdx.x < 8) {
      const unsigned gt = gen * ng;
      while (__hip_atomic_load(gc, __ATOMIC_RELAXED, __HIP_MEMORY_SCOPE_AGENT) < gt) __builtin_amdgcn_s_sleep(1);
      (void)__hip_atomic_fetch_add(bar, 1u, __ATOMIC_RELAXED, __HIP_MEMORY_SCOPE_AGENT);
    }
    const unsigned target = gen * 8u;
    while (__hip_atomic_load(bar, __ATOMIC_RELAXED, __HIP_MEMORY_SCOPE_AGENT) < target) __builtin_amdgcn_s_sleep(4);
    __builtin_amdgcn_fence(__ATOMIC_ACQUIRE, "agent");
    asm volatile("s_waitcnt vmcnt(0)" ::: "memory");
  }
  __syncthreads();
}

DI void dump_bf16(const Params& p, const ushort_t* src) {
  size_t n = (size_t)NTOK * DM; size_t tot = n + 16 * 2 * 256 * 256 + 16 * 2 * 256 * 64 + 16 * 2 * 2 * 512;
  for (size_t i = (size_t)blockIdx.x * 256 + threadIdx.x; i < tot; i += (size_t)gridDim.x * 256)
    p.out[i] = i < n ? __uint_as_float(((unsigned)src[i]) << 16) : (i < n + 2 * 5 * 12288 ? p.mod[i - n] : 0.f);
}


DI void dump_f32(const Params& p, const float* src, size_t n) {
  size_t tot = (size_t)NTOK * DM + 16 * 2 * 256 * 256 + 16 * 2 * 256 * 64 + 16 * 2 * 2 * 512;
  for (size_t i = (size_t)blockIdx.x * 256 + threadIdx.x; i < tot; i += (size_t)gridDim.x * 256)
    p.out[i] = i < n ? src[i] : 0.f;
}

__global__ void __launch_bounds__(256, 2) fwd_megakernel(Params pk) {
  __shared__ __attribute__((aligned(16))) char smem[SMEM_BYTES];
  __shared__ __attribute__((aligned(16))) unsigned long long spw[(sizeof(Params) + 7) / 8];
  {
    const unsigned long long* ka = (const unsigned long long*)__builtin_amdgcn_kernarg_segment_ptr();
    if (threadIdx.x < (sizeof(Params) + 7) / 8) spw[threadIdx.x] = ka[threadIdx.x];
    __syncthreads();
  }
#define PP (*(const Params*)((const char*)spw + opaque(0)))
  __shared__ uint4 xb_words;
  if (threadIdx.x == 0) xb_words = make_uint4(0u, 0u, 0u, 0u);
  __syncthreads();
  const XcdBarrier xb = xcd_barrier_post(PP.bar, (volatile LAS unsigned*)&xb_words);
  const int nb = gridDim.x, bid = blockIdx.x;
  const int wave = threadIdx.x >> 6, lane = threadIdx.x & 63;

  for (int rep = 0; rep < REP_A; rep++) {
  { const Params& p = PP; prep_phase(p, smem); }
  xcd_barrier(xb);
  }

  for (int l = 0; l < 2; l++) {
    for (int rep = 0; rep < REP_D; rep++) {
    if (l == 0) { { const Params& p = PP; norm_phase(p, l, 0); } xcd_barrier(xb); }
    }
    for (int rep = 0; rep < REP_B; rep++) {
    {
      const Params& p = PP;
      const ushort_t* Bt = p.WinT + (size_t)l * INW * DM;
      float* z = p.z;
      for (int j = bid >> 3; j < 192; j += nb >> 3) {
        int mt = (bid & 7) * 8 + ((j & 63) >> 3), nt = (j >> 6) * 8 + (j & 7);
        if (nt >= 23) continue;
        gemm_tile(p.hn, DM, Bt, DM, DM, INW, mt * 128, nt * 128, smem, [&](int row, int col, float v) { z[(size_t)row * INW + col] = v; });
      }
    }
    xcd_barrier(xb);
    }
    for (int rep = 0; rep < REP_D; rep++) {
    {
      const Params& p = PP;
      for (int it = bid; it < 512 + NTOK / CMT; it += nb) {
        if (it < 512) lru_item(p, l, it, smem); else cm_item(p, l, it - 512, smem);
      }
    }
    { const Params& p = PP; post_inproj_tokens(p, l); }
    xcd_barrier(xb);
    }
    for (int rep = 0; rep < REP_B; rep++) {
    {
      const Params& p = PP;
      const ushort_t* Bq = p.WqbT + (size_t)l * 1536 * 512;
      const ushort_t* Bkv = p.WkvbT + (size_t)l * 2048 * 256;
      ushort_t* qraw = p.qraw; ushort_t* kvraw = p.kvraw;
      for (int j = bid >> 3; j < 256; j += nb >> 3) {
        if (j < 160) {
          int rem = j % 80; int mt = (bid & 7) * 10 + (rem >> 3), nt = (j / 80) * 8 + (rem & 7);
          gemm_tile(p.ckv, 256, Bkv, 256, 256, 2048, mt * 128, nt * 128, smem, [&](int row, int col, float v) { kvraw[(size_t)row * 2048 + col] = f2bf(v); });
        } else {
          int j2 = j - 160; int rem = j2 % 48; int mt = (bid & 7) * 8 + rem / 6, nt = (j2 / 48) * 6 + rem % 6;
          gemm_tile(p.qa, 512, Bq, 512, 512, 1536, mt * 128, nt * 128, smem, [&](int row, int col, float v) { qraw[(size_t)row * 1536 + col] = f2bf(v); });
        }
      }
    }
    xcd_barrier(xb);
    }
    for (int rep = 0; rep < REP_D; rep++) {
    { const Params& p = PP; for (int it = bid; it < 160 * 8; it += nb) kv_item(p, l, it, smem); }
    { const Params& p = PP; qnorm_tokens(p, l); }
    xcd_barrier(xb);
    }
    for (int rep = 0; rep < REP_D; rep++) {
    { const Params& p = PP; for (int it = bid; it < 1024; it += nb) attn_item(p, it, smem); }
    xcd_barrier(xb);
    }
    for (int rep = 0; rep < REP_D; rep++) {
    { const Params& p = PP; merge_tokens(p, l); }
    xcd_barrier(xb);
    }
    for (int rep = 0; rep < REP_B; rep++) {
    {
      const Params& p = PP;
      const ushort_t* Bt = p.WoutT + (size_t)l * DM * DM;
      float* x1 = p.x1;
      for (int j = bid >> 3; j < 128; j += nb >> 3) {
        int mt = (bid & 7) * 8 + ((j & 63) >> 3), nt = (j >> 6) * 8 + (j & 7);
        gemm_tile(p.mixed, DM, Bt, DM, DM, DM, mt * 128, nt * 128, smem, [&](int row, int col, float v) {
          const float* xr = xrow_in(p, l, row);
          float g1 = p.mod[(size_t)(l * 5 + cvidx(row)) * 12288 + 4096 + col];
          x1[(size_t)row * DM + col] = xr[col] + g1 * v;
        });
      }
    }
    xcd_barrier(xb);
    }
    for (int rep = 0; rep < REP_D; rep++) {
    { const Params& p = PP; norm_phase(p, l, 1); }
    xcd_barrier(xb);
    }
    for (int rep = 0; rep < REP_B; rep++) {
    {
      const Params& p = PP;
      const ushort_t* Bt = p.WpqT + (size_t)l * DM * DM;
      const ushort_t* Kb = p.KeysB + (size_t)l * 2048 * 128;
      float* sc = (float*)p.z;
      ushort_t* sP = (ushort_t*)smem;
      for (int j = bid >> 3; j < 128; j += nb >> 3) {
        int mt = (bid & 7) * 8 + ((j & 63) >> 3), nt = (j >> 6) * 8 + (j & 7);
        gemm_tile(p.hn, DM, Bt, DM, DM, DM, mt * 128, nt * 128, smem, [&](int row, int col, float v) { sP[(row - mt * 128) * PLD + (col - nt * 128)] = f2bf(v); });
        scores_tile(Kb + (size_t)nt * 128 * 128, sc, mt, nt, smem);
      }
    }
    xcd_barrier(xb);
    }
    for (int rep = 0; rep < REP_C; rep++) {
    { const Params& p = PP; peer_phase(p, l, smem); }
    xcd_barrier(xb);
    }
  }
}

extern "C" void kernel_launch(void* const* d_in, const int* in_sizes, int n_in, void* d_out, int out_size, void* d_ws, size_t ws_size, hipStream_t stream) {
  static int grid_blocks = 0;
  if (!grid_blocks) {
    int dev = 0, cus = 0, per_cu = 0;
    hipGetDevice(&dev);
    hipDeviceGetAttribute(&cus, hipDeviceAttributeMultiprocessorCount, dev);
    hipOccupancyMaxActiveBlocksPerMultiprocessor(&per_cu, fwd_megakernel, 256, 0);
    if (per_cu > 2) per_cu = 2;
    if (per_cu < 1) per_cu = 1;
    grid_blocks = (cus * per_cu) & ~7;
  }
  Params p{};
  const float** pin = (const float**)&p;
  for (int i = 0; i < 35; i++) pin[i] = (const float*)d_in[i];
  p.out = (float*)d_out;
  char* w = (char*)d_ws; size_t off = 0;
  auto take = [&](size_t bytes) { char* r = w + off; off += (bytes + 255) & ~(size_t)255; return r; };
  p.bar = (unsigned*)take(16384);
  p.WinT = (ushort_t*)take((size_t)2 * INW * DM * 2);
  p.WqbT = (ushort_t*)take((size_t)2 * 1536 * 512 * 2);
  p.WkvbT = (ushort_t*)take((size_t)2 * 2048 * 256 * 2);
  p.WoutT = (ushort_t*)take((size_t)2 * DM * DM * 2);
  p.WpqT = (ushort_t*)take((size_t)2 * DM * DM * 2);
  p.KeysB = (ushort_t*)take((size_t)2 * 2048 * 128 * 2);
  p.LruW = (ushort_t*)take((size_t)2 * 16 * 2 * 4096 * 2);
  p.Ub = (unsigned char*)take((size_t)2 * NEXP * DM);
  p.Vb = (unsigned char*)take((size_t)2 * NEXP * DM);
  p.Us = (float*)take((size_t)2 * NEXP * 4);
  p.Vs = (float*)take((size_t)2 * NEXP * 4);
  p.hn = (ushort_t*)take((size_t)NTOK * DM * 2);
  p.qa = (ushort_t*)take((size_t)NTOK * 512 * 2);
  p.ckv = (ushort_t*)take((size_t)NKV * 256 * 2);
  p.Q = (ushort_t*)take((size_t)NTOK * 1536 * 2);
  p.K = (ushort_t*)take((size_t)NKV * 1536 * 2);
  p.Vt = (ushort_t*)take((size_t)NKV * 1024 * 2);
  p.mixed = (ushort_t*)take((size_t)NTOK * DM * 2);
  p.z = (float*)take((size_t)NTOK * INW * 4);
  p.qraw = (ushort_t*)take((size_t)NTOK * 1536 * 2);
  p.kvraw = (ushort_t*)take((size_t)NKV * 2048 * 2);
  p.attn = (ushort_t*)take((size_t)NTOK * 1024 * 2);
  p.hs = (ushort_t*)take((size_t)2 * NTOK * 512 * 2);
  p.Pc = (ushort_t*)take((size_t)2 * NTOK * 512 * 2);
  p.hend = (float*)take((size_t)2 * 32 * 512 * 4);
  p.Pend = (float*)take((size_t)2 * 32 * 512 * 4);
  p.x1 = (float*)take((size_t)NTOK * DM * 4);
  p.xA = (float*)take((size_t)NTOK * DM * 4);
  p.mod = (float*)take((size_t)2 * 5 * 12288 * 4);
  p.rope = (float*)take((size_t)1024 * 64 * 4);
  if (off > ws_size) { fprintf(stderr, "workspace too small: need %zu have %zu\n", off, ws_size); return; }
  if (hipMemsetAsync(p.bar, 0, 16384, stream) != hipSuccess) { fprintf(stderr, "memset failed\n"); return; }
  hipLaunchKernelGGL(fwd_megakernel, dim3(grid_blocks), dim3(256), 0, stream, p);
}
```

```cpp
#include <hip/hip_runtime.h>
#include <hip/hip_cooperative_groups.h>
#include <cstdio>
#include <cstdint>
namespace cg = cooperative_groups;

typedef unsigned short ushort_t;
typedef __attribute__((ext_vector_type(8))) short bf16x8;
typedef __attribute__((ext_vector_type(16))) float f32x16;
typedef __attribute__((ext_vector_type(4))) unsigned u32x4;
typedef __attribute__((ext_vector_type(4))) float f32x4;
typedef __attribute__((ext_vector_type(2))) float f32x2_t;
typedef __attribute__((ext_vector_type(2))) __bf16 bf16x2_t;
#define DI __device__ __forceinline__
#define GAS __attribute__((address_space(1)))
#define GLD16(ptr) (*(const GAS u32x4*)(ptr))
#define MFMA32(a, b, c) __builtin_amdgcn_mfma_f32_32x32x16_bf16((a), (b), (c), 0, 0, 0)

#define DM 2048
#define NTOK 8192
#define NCTX 4096
#define INW 2880
#define NKV 10240
#define OFF_ZKV 512
#define OFF_ZKR 768
#define OFF_ZX 832
#define OFF_ZG 1344
#define OFF_ZC 1856
#define NEXP 16384
#define SMEM_BYTES 78848
#ifndef REP_A
#define REP_A 1
#define REP_B 1
#define REP_C 1
#define REP_D 1
#endif

struct Params {
  const float *x_prompt, *x_sample, *cache_ckv, *cache_krope, *state_lru, *c, *c_ctx;
  const float *ada_w, *ada_b, *norm_mix_g, *w_in, *mla_qa_g, *mla_w_qb, *mla_q_g, *mla_kva_g, *mla_w_kvb, *mla_k_g;
  const float *lru_conv_w, *lru_conv_b, *lru_w_a, *lru_b_a, *lru_w_i, *lru_b_i, *lru_lam;
  const float *cm_dw_w, *cm_dw_b, *cm_ln_g, *cm_ln_b, *grp_g, *w_out, *norm_ffn_g;
  const float *peer_w_q, *peer_keys, *peer_u, *peer_v;
  float* out;
  unsigned* bar;
  ushort_t *WinT, *WqbT, *WkvbT, *WoutT, *WpqT, *KeysB, *LruW;
  unsigned char *Ub, *Vb;
  float *Us, *Vs;
  ushort_t *hn, *qa, *ckv, *Q, *K, *Vt, *mixed;
  ushort_t *qraw, *kvraw, *attn, *hs, *Pc;
  float *z, *hend, *Pend, *x1, *xA, *mod, *rope;
};

DI unsigned pack_bf16(float lo, float hi) { f32x2_t v = {lo, hi}; bf16x2_t b = __builtin_convertvector(v, bf16x2_t); return __builtin_bit_cast(unsigned, b); }
DI ushort_t f2bf(float x) { return (ushort_t)(pack_bf16(x, 0.f) & 0xffffu); }
DI float bf_lo(unsigned u) { return __uint_as_float(u << 16); }
DI float bf_hi(unsigned u) { return __uint_as_float(u & 0xffff0000u); }
DI float wave_sum(float v) { for (int o = 32; o; o >>= 1) v += __shfl_xor(v, o); return v; }
DI float sigmoidf_(float x) { return __builtin_amdgcn_rcpf(1.f + __expf(-x)); }
DI float gelu_tanh(float x) { const float y = 0.7978845608028654f * (x + 0.044715f * x * x * x); return x * __builtin_amdgcn_rcpf(1.f + __expf(-2.f * y)); }
DI int crow(int reg, int h) { return (reg & 3) + 8 * (reg >> 2) + 4 * h; }
DI int cvidx(int t) { return t < NCTX ? 0 : 1 + ((t - NCTX) >> 10); }
DI int kvrow_of_token(int t) { if (t < NCTX) return t; int tl = t - NCTX; return NCTX + (tl >> 10) * 1536 + 512 + (tl & 1023); }
DI const float* xrow_in(const Params& p, int l, int t) {
  if (l == 0) return t < NCTX ? p.x_prompt + (size_t)t * DM : p.x_sample + (size_t)(t - NCTX) * DM;
  return p.xA + (size_t)t * DM;
}
DI float dot2bf(unsigned a, unsigned b, float acc) { return __builtin_amdgcn_fdot2_f32_bf16(__builtin_bit_cast(bf16x2_t, a), __builtin_bit_cast(bf16x2_t, b), acc, false); }
DI int opaque(int x) { asm volatile("" : "+v"(x)); return x; }
DI float rdlane_f(float v, int l) { return __int_as_float(__builtin_amdgcn_readlane(__float_as_int(v), l)); }

#define GLD 72
template <class Epi>
DI void gemm_tile(const ushort_t* A, int lda, const ushort_t* Bt, int ldb, int K, int N, int m0, int n0, char* smem, Epi epi) {
  ushort_t* sA = (ushort_t*)smem;
  ushort_t* sB = sA + 128 * GLD;
  const int tid = opaque(threadIdx.x), wave = tid >> 6, lane = tid & 63, wm = wave & 1, wn = wave >> 1;
  const int r = lane & 31, h = lane >> 5;
  f32x16 acc[2][2];
#pragma unroll
  for (int i = 0; i < 2; i++)
#pragma unroll
    for (int j = 0; j < 2; j++)
#pragma unroll
      for (int e = 0; e < 16; e++) acc[i][j][e] = 0.f;
  u32x4 ra0[4], rb0[4], ra1[4], rb1[4];
  const int lrow = tid >> 3, lkc = (tid & 7) * 8;
  const ushort_t* Ap = A + (size_t)(m0 + lrow) * lda + lkc;
  const ushort_t* Bp[4];
#pragma unroll
  for (int i = 0; i < 4; i++) { int br = n0 + lrow + 32 * i; br = br < N ? br : N - 1; Bp[i] = Bt + (size_t)br * ldb + lkc; }
  auto gload = [&](u32x4* ra, u32x4* rb, int k0) {
#pragma unroll
    for (int i = 0; i < 4; i++) {
      ra[i] = GLD16(Ap + (size_t)(32 * i) * lda + k0);
      rb[i] = GLD16(Bp[i] + k0);
    }
  };
  auto lstore = [&](const u32x4* ra, const u32x4* rb, int buf) {
    ushort_t* dA = sA + buf * (2 * 128 * GLD) + lrow * GLD + lkc;
    ushort_t* dB = sB + buf * (2 * 128 * GLD) + lrow * GLD + lkc;
#pragma unroll
    for (int i = 0; i < 4; i++) { *(u32x4*)(dA + 32 * i * GLD) = ra[i]; *(u32x4*)(dB + 32 * i * GLD) = rb[i]; }
  };
  auto compute = [&](int buf) {
    const ushort_t* cA = sA + buf * (2 * 128 * GLD);
    const ushort_t* cB = sB + buf * (2 * 128 * GLD);
    bf16x8 a[2][2], b[2][2];
#pragma unroll
    for (int i = 0; i < 2; i++) {
      a[0][i] = *(const bf16x8*)(cA + (wm * 64 + i * 32 + r) * GLD + h * 8);
      b[0][i] = *(const bf16x8*)(cB + (wn * 64 + i * 32 + r) * GLD + h * 8);
    }
#pragma unroll
    for (int ks = 0; ks < 4; ks++) {
      if (ks < 3) {
#pragma unroll
        for (int i = 0; i < 2; i++) {
          a[(ks + 1) & 1][i] = *(const bf16x8*)(cA + (wm * 64 + i * 32 + r) * GLD + (ks + 1) * 16 + h * 8);
          b[(ks + 1) & 1][i] = *(const bf16x8*)(cB + (wn * 64 + i * 32 + r) * GLD + (ks + 1) * 16 + h * 8);
        }
      }
#pragma unroll
      for (int i = 0; i < 2; i++)
#pragma unroll
        for (int j = 0; j < 2; j++) acc[i][j] = MFMA32(a[ks & 1][i], b[ks & 1][j], acc[i][j]);
    }
  };
  gload(ra0, rb0, 0);
  gload(ra1, rb1, 64);
  lstore(ra0, rb0, 0);
  __syncthreads();
  const int klast = K - 64;
  gload(ra0, rb0, 128 < K ? 128 : klast);
  for (int k0 = 0; k0 < K; k0 += 128) {
    compute(0);
    lstore(ra1, rb1, 1);
    __syncthreads();
    gload(ra1, rb1, k0 + 192 < K ? k0 + 192 : klast);
    compute(1);
    lstore(ra0, rb0, 0);
    __syncthreads();
    gload(ra0, rb0, k0 + 256 < K ? k0 + 256 : klast);
  }
#pragma unroll
  for (int i = 0; i < 2; i++)
#pragma unroll
    for (int j = 0; j < 2; j++)
#pragma unroll
      for (int e = 0; e < 16; e++) {
        int row = m0 + wm * 64 + i * 32 + crow(e, h);
        int col = n0 + wn * 64 + j * 32 + r;
        if (col < N) epi(row, col, acc[i][j][e]);
      }
  __syncthreads();
}

#define PLD 136
DI void scores_tile(const ushort_t* Kt, float* sc, int mt, int nt, char* smem) {
  ushort_t* sP = (ushort_t*)smem;
  ushort_t* sK2 = sP + 128 * PLD;
  const int tid = opaque(threadIdx.x), wave = tid >> 6, lane = tid & 63, wm = wave & 1, wn = wave >> 1;
  const int r = lane & 31, h = lane >> 5;
#pragma unroll
  for (int i = 0; i < 8; i++) { int c = tid + i * 256; int row = c >> 4, kc = (c & 15) * 8; *(u32x4*)(sK2 + row * PLD + kc) = GLD16(Kt + row * 128 + kc); }
  __syncthreads();
  f32x16 acc[2][2];
#pragma unroll
  for (int i = 0; i < 2; i++)
#pragma unroll
    for (int j = 0; j < 2; j++)
#pragma unroll
      for (int e = 0; e < 16; e++) acc[i][j][e] = 0.f;
#pragma unroll
  for (int ks = 0; ks < 8; ks++) {
    bf16x8 a[2], b[2];
#pragma unroll
    for (int i = 0; i < 2; i++) {
      a[i] = *(const bf16x8*)(sP + (wm * 64 + i * 32 + r) * PLD + ks * 16 + h * 8);
      b[i] = *(const bf16x8*)(sK2 + (wn * 64 + i * 32 + r) * PLD + ks * 16 + h * 8);
    }
#pragma unroll
    for (int i = 0; i < 2; i++)
#pragma unroll
      for (int j = 0; j < 2; j++) acc[i][j] = MFMA32(a[i], b[j], acc[i][j]);
  }
#pragma unroll
  for (int i = 0; i < 2; i++)
#pragma unroll
    for (int j = 0; j < 2; j++)
#pragma unroll
      for (int e = 0; e < 16; e++) {
        int row = mt * 128 + wm * 64 + i * 32 + crow(e, h);
        int col = wn * 64 + j * 32 + r;
        sc[(size_t)row * 2048 + nt * 128 + col] = acc[i][j][e];
      }
  __syncthreads();
}

DI void transpose_item(const float* src, int lds_, ushort_t* dst, int ldd, int kt, int nt, float* tile) {
  int tid = opaque(threadIdx.x); int c = tid & 63, r0 = tid >> 6;
#pragma unroll 4
  for (int i = 0; i < 16; i++) { int r = r0 + 4 * i; tile[r * 65 + c] = src[(size_t)(kt * 64 + r) * lds_ + nt * 64 + c]; }
  __syncthreads();
#pragma unroll 4
  for (int i = 0; i < 16; i++) { int r = r0 + 4 * i; dst[(size_t)(nt * 64 + r) * ldd + kt * 64 + c] = f2bf(tile[c * 65 + r]); }
  __syncthreads();
}

DI void convert_chunk(const float* src, ushort_t* dst, size_t base) {
  int tid = opaque(threadIdx.x);
#pragma unroll
  for (int it = 0; it < 4; it++) {
    size_t e = base + it * 2048 + tid * 8;
    float4 a = *(const float4*)(src + e), b = *(const float4*)(src + e + 4);
    uint4 o; o.x = pack_bf16(a.x, a.y); o.y = pack_bf16(a.z, a.w); o.z = pack_bf16(b.x, b.y); o.w = pack_bf16(b.z, b.w);
    *(uint4*)(dst + e) = o;
  }
}


DI void quant_rows(const float* src, unsigned char* dst, float* scl, size_t row0) {
  int tid = opaque(threadIdx.x); int wave = tid >> 6, lane = tid & 63;
  const size_t rowa = row0 + wave * 2;
  float4 v[2][8]; float am[2] = {0.f, 0.f};
#pragma unroll
  for (int q = 0; q < 2; q++)
#pragma unroll
    for (int j = 0; j < 8; j++) { f32x4 t_ = *(const GAS f32x4*)(src + (rowa + q) * DM + (j * 64 + lane) * 4); v[q][j] = make_float4(t_[0], t_[1], t_[2], t_[3]); }
#pragma unroll
  for (int q = 0; q < 2; q++)
#pragma unroll
    for (int j = 0; j < 8; j++) am[q] = fmaxf(am[q], fmaxf(fmaxf(fabsf(v[q][j].x), fabsf(v[q][j].y)), fmaxf(fabsf(v[q][j].z), fabsf(v[q][j].w))));
  for (int o = 32; o; o >>= 1) { am[0] = fmaxf(am[0], __shfl_xor(am[0], o)); am[1] = fmaxf(am[1], __shfl_xor(am[1], o)); }
#pragma unroll
  for (int q = 0; q < 2; q++) {
    float sc = am[q] > 0.f ? 224.f / am[q] : 1.f;
    if (lane == 0) scl[rowa + q] = am[q] > 0.f ? am[q] * (1.f / 224.f) : 1.f;
#pragma unroll
    for (int j = 0; j < 8; j++) {
      int w = 0;
      w = __builtin_amdgcn_cvt_pk_fp8_f32(v[q][j].x * sc, v[q][j].y * sc, w, false);
      w = __builtin_amdgcn_cvt_pk_fp8_f32(v[q][j].z * sc, v[q][j].w * sc, w, true);
      *(int*)(dst + (rowa + q) * DM + (j * 64 + lane) * 4) = w;
    }
  }
}

DI void mod_item(const Params& p, int item, char* smem) {
  int l = item / 48, cgp = item % 48;
  float* s = (float*)smem;
  float* red = s + 5 * 2048;
  int tid = opaque(threadIdx.x), wave = tid >> 6, lane = tid & 63;
  for (int i = tid; i < 5 * 2048; i += 256) {
    int cv = i >> 11, k = i & 2047;
    float v = cv == 0 ? p.c_ctx[k] : p.c[(cv - 1) * DM + k];
    s[i] = v * sigmoidf_(v);
  }
  __syncthreads();
  const float* W = p.ada_w + (size_t)l * DM * 12288 + cgp * 256 + lane * 4;
  float4 acc[5];
#pragma unroll
  for (int cv = 0; cv < 5; cv++) acc[cv] = make_float4(0, 0, 0, 0);
  int kb = wave * 512;
#pragma unroll 8
  for (int k = kb; k < kb + 512; k++) {
    float4 w = *(const float4*)(W + (size_t)k * 12288);
#pragma unroll
    for (int cv = 0; cv < 5; cv++) {
      float sv = s[cv * 2048 + k];
      acc[cv].x += sv * w.x; acc[cv].y += sv * w.y; acc[cv].z += sv * w.z; acc[cv].w += sv * w.w;
    }
  }
#pragma unroll
  for (int cv = 0; cv < 5; cv++) *(float4*)(red + (wave * 5 + cv) * 256 + lane * 4) = acc[cv];
  __syncthreads();
  for (int i = tid; i < 5 * 256; i += 256) {
    int cv = i >> 8, col = i & 255;
    float v = red[(0 * 5 + cv) * 256 + col] + red[(1 * 5 + cv) * 256 + col] + red[(2 * 5 + cv) * 256 + col] + red[(3 * 5 + cv) * 256 + col];
    int gc = cgp * 256 + col;
    p.mod[(size_t)(l * 5 + cv) * 12288 + gc] = v + p.ada_b[l * 12288 + gc];
  }
  __syncthreads();
}

#define N_MOD 96
#define N_TR_LAYER 3840
#define N_TR (2 * N_TR_LAYER)
#define N_CV_KEYS 64
#define N_CV_U 4096
#define N_PREP (N_MOD + N_TR + N_CV_KEYS + 2 * N_CV_U + 1)

DI void prep_phase(const Params& p, char* smem) {
  for (int it = blockIdx.x; it < N_PREP; it += gridDim.x) {
    if (it < N_MOD) { mod_item(p, it, smem); continue; }
    int i = it - N_MOD;
    if (i < N_TR) {
      int l = i / N_TR_LAYER, j = i % N_TR_LAYER;
      float* tile = (float*)smem;
      if (j < 1440) { transpose_item(p.w_in + (size_t)l * DM * INW, INW, p.WinT + (size_t)l * INW * DM, DM, j / 45, j % 45, tile); continue; }
      j -= 1440;
      if (j < 192) { transpose_item(p.mla_w_qb + (size_t)l * 512 * 1536, 1536, p.WqbT + (size_t)l * 1536 * 512, 512, j / 24, j % 24, tile); continue; }
      j -= 192;
      if (j < 128) { transpose_item(p.mla_w_kvb + (size_t)l * 256 * 2048, 2048, p.WkvbT + (size_t)l * 2048 * 256, 256, j / 32, j % 32, tile); continue; }
      j -= 128;
      if (j < 1024) { transpose_item(p.w_out + (size_t)l * DM * DM, DM, p.WoutT + (size_t)l * DM * DM, DM, j / 32, j % 32, tile); continue; }
      j -= 1024;
      if (j < 1024) { transpose_item(p.peer_w_q + (size_t)l * DM * DM, DM, p.WpqT + (size_t)l * DM * DM, DM, j / 32, j % 32, tile); continue; }
      j -= 1024;
      {
        int mat = j >> 4, dh = j & 15;
        const float* src = (mat ? p.lru_w_i : p.lru_w_a) + (size_t)(l * 16 + dh) * 4096;
        ushort_t* dst = p.LruW + ((size_t)(l * 16 + dh) * 2 + mat) * 4096;
        transpose_item(src, 64, dst, 64, 0, 0, tile);
      }
      continue;
    }
    i -= N_TR;
    if (i < N_CV_KEYS) { convert_chunk(p.peer_keys, p.KeysB, (size_t)i * 8192); continue; }
    i -= N_CV_KEYS;
    if (i < N_CV_U) { quant_rows(p.peer_u, p.Ub, p.Us, (size_t)i * 8); continue; }
    i -= N_CV_U;
    if (i < N_CV_U) { quant_rows(p.peer_v, p.Vb, p.Vs, (size_t)i * 8); continue; }
  }
  for (int e = blockIdx.x * 256 + opaque(threadIdx.x); e < 1024 * 32; e += gridDim.x * 256) {
    int pos = e >> 5, f = e & 31;
    int fi = f & 15;
    float inv = 1.0f / powf(10000.0f, (float)fi / 16.0f);
    float base = (f < 16) ? (float)(pos >> 6) : (float)(pos & 63);
    float ang = base * inv;
    float sn, cs; sincosf(ang, &sn, &cs);
    p.rope[pos * 64 + f] = cs; p.rope[pos * 64 + 32 + f] = sn;
  }
}

DI void norm_phase(const Params& p, int l, int which) {
  int tidq = opaque(threadIdx.x); int lane = tidq & 63, gw = blockIdx.x * 4 + (tidq >> 6), nw = gridDim.x * 4;
  const float* g = (which ? p.norm_ffn_g : p.norm_mix_g) + l * DM;
  int sh_off = which ? 6144 : 0, sc_off = which ? 8192 : 2048;
  for (int t = gw; t < NTOK; t += nw) {
    const float* xr = which ? p.x1 + (size_t)t * DM : xrow_in(p, l, t);
    const float* md = p.mod + (size_t)(l * 5 + cvidx(t)) * 12288;
    float4 v[8]; float ss = 0.f;
#pragma unroll
    for (int j = 0; j < 8; j++) { v[j] = *(const float4*)(xr + j * 256 + lane * 4); ss += v[j].x * v[j].x + v[j].y * v[j].y + v[j].z * v[j].z + v[j].w * v[j].w; }
    ss = wave_sum(ss);
    float rinv = rsqrtf(ss * (1.f / DM) + 1e-6f);
#pragma unroll
    for (int j = 0; j < 8; j++) {
      int col = j * 256 + lane * 4;
      float4 gg = *(const float4*)(g + col), sc = *(const float4*)(md + sc_off + col), sh = *(const float4*)(md + sh_off + col);
      float y0 = v[j].x * rinv * gg.x * (1.f + sc.x) + sh.x;
      float y1 = v[j].y * rinv * gg.y * (1.f + sc.y) + sh.y;
      float y2 = v[j].z * rinv * gg.z * (1.f + sc.z) + sh.z;
      float y3 = v[j].w * rinv * gg.w * (1.f + sc.w) + sh.w;
      uint2 o; o.x = pack_bf16(y0, y1); o.y = pack_bf16(y2, y3);
      *(uint2*)(p.hn + (size_t)t * DM + col) = o;
    }
  }
}

DI void lru_item(const Params& p, int l, int item, char* smem) {
  int ch = item >> 4, hd = (item >> 1) & 7, d = item & 1;
  int t0 = ch * 256, seq_t0, T, p0;
  if (ch < 16) { seq_t0 = ch * 256; T = 256; p0 = 0; }
  else { int b = (ch - 16) >> 2, cc = (ch - 16) & 3; seq_t0 = NCTX + b * 1024; T = 1024; p0 = cc * 256; }
  ushort_t* sBt = (ushort_t*)smem;
  ushort_t* sA = sBt + 128 * GLD;
  float* sXc = (float*)(sA + 64 * GLD);
  float* sG = sXc + 64 * 64;
  const int tid = opaque(threadIdx.x), wave = tid >> 6, lane = tid & 63;
  const int c = tid & 63, tg = tid >> 6;
  const ushort_t* Bt = p.LruW + ((size_t)((l * 2 + d) * 8 + hd) * 2) * 4096;
#pragma unroll
  for (int i = 0; i < 4; i++) { int cidx = tid + i * 256; int row = cidx >> 3, kc = (cidx & 7) * 8; *(uint4*)(sBt + row * GLD + kc) = *(const uint4*)(Bt + row * 64 + kc); }
  const int chn = hd * 64 + c;
  float cw[4];
#pragma unroll
  for (int j = 0; j < 4; j++) cw[j] = p.lru_conv_w[(l * 4 + j) * 512 + chn];
  const float cb = p.lru_conv_b[l * 512 + chn];
  const float ba = p.lru_b_a[(l * 2 + d) * 512 + chn], bi = p.lru_b_i[(l * 2 + d) * 512 + chn];
  const float lam = p.lru_lam[(l * 2 + d) * 512 + chn];
  const float sp = log1pf(expf(-lam));
  float hst = 0.f, Pp = 1.f;
  const int r = lane & 31, h8 = lane >> 5;
  for (int si = 0; si < 4; si++) {
    int sub = d ? 3 - si : si;
#pragma unroll 4
    for (int i = 0; i < 16; i++) {
      int lt = tg * 16 + i; int pos = p0 + sub * 64 + lt;
      float xc = cb;
#pragma unroll
      for (int j = 0; j < 4; j++) {
        int q = pos - 2 + j;
        float zv = (q >= 0 && q < T) ? p.z[(size_t)(seq_t0 + q) * INW + OFF_ZX + chn] : 0.f;
        xc += cw[j] * zv;
      }
      sXc[lt * 64 + c] = xc; sA[lt * GLD + c] = f2bf(xc);
    }
    __syncthreads();
    {
      int mt = wave & 1, nh = wave >> 1;
      f32x16 acc[2];
#pragma unroll
      for (int i = 0; i < 2; i++)
#pragma unroll
        for (int e = 0; e < 16; e++) acc[i][e] = 0.f;
#pragma unroll
      for (int ks = 0; ks < 4; ks++) {
        bf16x8 a = *(const bf16x8*)(sA + (mt * 32 + r) * GLD + ks * 16 + h8 * 8);
#pragma unroll
        for (int ni = 0; ni < 2; ni++) {
          bf16x8 b = *(const bf16x8*)(sBt + (nh * 64 + ni * 32 + r) * GLD + ks * 16 + h8 * 8);
          acc[ni] = MFMA32(a, b, acc[ni]);
        }
      }
#pragma unroll
      for (int ni = 0; ni < 2; ni++)
#pragma unroll
        for (int e = 0; e < 16; e++) sG[(mt * 32 + crow(e, h8)) * 132 + nh * 64 + ni * 32 + r] = acc[ni][e];
    }
    __syncthreads();
#pragma unroll 4
    for (int i = 0; i < 16; i++) {
      int lt = tg * 16 + i;
      float ga = sG[lt * 132 + c] + ba, gi = sG[lt * 132 + 64 + c] + bi;
      float rr = sigmoidf_(ga), ii = sigmoidf_(gi);
      float la = -8.0f * rr * sp;
      float a = __expf(la);
      const float x2 = 2.f * la;
      const float em = (x2 > -0.25f) ? -x2 * (1.f + x2 * (0.5f + x2 * (0.16666667f + x2 * (0.041666668f + x2 * 0.0083333338f)))) : -expm1f(x2);
      float u = __builtin_sqrtf(em) * ii * sXc[lt * 64 + c];
      sG[lt * 132 + c] = a; sG[lt * 132 + 64 + c] = u;
    }
    __syncthreads();
    if (tid < 64) {
      for (int s = 0; s < 64; s++) {
        int lt = d ? 63 - s : s;
        float a = sG[lt * 132 + c], u = sG[lt * 132 + 64 + c];
        hst = a * hst + u; Pp *= a;
        size_t o = ((size_t)d * NTOK + t0 + sub * 64 + lt) * 512 + chn;
        p.hs[o] = f2bf(hst); p.Pc[o] = f2bf(Pp);
      }
    }
    __syncthreads();
  }
  if (tid < 64) {
    p.hend[(d * 32 + ch) * 512 + chn] = hst; p.Pend[(d * 32 + ch) * 512 + chn] = Pp;
    if (ch < 16) p.out[(size_t)NTOK * DM + 16 * 2 * 256 * 256 + 16 * 2 * 256 * 64 + ((ch * 2 + l) * 2 + d) * 512 + chn] = hst;
  }
}

#define CMT 16
DI void cm_item(const Params& p, int l, int item, char* smem) {
  int t0 = item * CMT, seq_t0, T;
  if (t0 < NCTX) { seq_t0 = (t0 >> 8) << 8; T = 256; } else { seq_t0 = NCTX + (((t0 - NCTX) >> 10) << 10); T = 1024; }
  int p0 = t0 - seq_t0;
  unsigned* sGlu = (unsigned*)smem;
  float* red = (float*)(sGlu + (CMT + 30) * 256);
  float* red2 = red + 256;
  const int tid = opaque(threadIdx.x), wave = tid >> 6, lane = tid & 63;
#pragma unroll 8
  for (int rr = 0; rr < CMT + 30; rr++) {
    int pos = p0 - 15 + rr;
    unsigned v = 0;
    if (pos >= 0 && pos < T) {
      const float* zr = p.z + (size_t)(seq_t0 + pos) * INW + OFF_ZC;
      float2 a = *(const float2*)(zr + 2 * tid), b = *(const float2*)(zr + 512 + 2 * tid);
      v = pack_bf16(a.x * sigmoidf_(b.x), a.y * sigmoidf_(b.y));
    }
    sGlu[rr * 256 + tid] = v;
  }
  __syncthreads();
  float acc0[CMT], acc1[CMT];
  {
    float2 bb = *(const float2*)(p.cm_dw_b + l * 512 + 2 * tid);
#pragma unroll
    for (int t = 0; t < CMT; t++) { acc0[t] = bb.x; acc1[t] = bb.y; }
  }
  for (int j = 0; j < 31; j++) {
    float2 w = *(const float2*)(p.cm_dw_w + (size_t)(l * 31 + j) * 512 + 2 * tid);
#pragma unroll
    for (int t = 0; t < CMT; t++) { unsigned u = sGlu[(t + j) * 256 + tid]; acc0[t] += w.x * bf_lo(u); acc1[t] += w.y * bf_hi(u); }
  }
  {
    float ks = 0.f, kss = 0.f;
#pragma unroll
    for (int t = 0; t < CMT; t++) {
      float s = wave_sum(acc0[t] + acc1[t]);
      float ss = wave_sum(acc0[t] * acc0[t] + acc1[t] * acc1[t]);
      if (lane == t) { ks = s; kss = ss; }
    }
    if (lane < CMT) { red[(wave * CMT + lane) * 2] = ks; red[(wave * CMT + lane) * 2 + 1] = kss; }
  }
  __syncthreads();
  {
    float2 lg = *(const float2*)(p.cm_ln_g + l * 512 + 2 * tid), lb = *(const float2*)(p.cm_ln_b + l * 512 + 2 * tid);
    float k2 = 0.f;
#pragma unroll
    for (int t = 0; t < CMT; t++) {
      float s = red[(0 * CMT + t) * 2] + red[(1 * CMT + t) * 2] + red[(2 * CMT + t) * 2] + red[(3 * CMT + t) * 2];
      float ss = red[(0 * CMT + t) * 2 + 1] + red[(1 * CMT + t) * 2 + 1] + red[(2 * CMT + t) * 2 + 1] + red[(3 * CMT + t) * 2 + 1];
      float mu = s * (1.f / 512.f); float var = ss * (1.f / 512.f) - mu * mu; float rstd = rsqrtf(var + 1e-5f);
      float y0 = (acc0[t] - mu) * rstd * lg.x + lb.x, y1 = (acc1[t] - mu) * rstd * lg.y + lb.y;
      y0 = y0 * sigmoidf_(y0); y1 = y1 * sigmoidf_(y1);
      acc0[t] = y0; acc1[t] = y1;
      float s2 = wave_sum(y0 * y0 + y1 * y1);
      if (lane == t) k2 = s2;
    }
    if (lane < CMT) red2[wave * CMT + lane] = k2;
  }
  __syncthreads();
  {
    float2 gg = *(const float2*)(p.grp_g + l * DM + 1536 + 2 * tid);
#pragma unroll
    for (int t = 0; t < CMT; t++) {
      float tot = red2[t] + red2[CMT + t] + red2[2 * CMT + t] + red2[3 * CMT + t];
      float rinv = rsqrtf(tot * (1.f / 512.f) + 1e-6f);
      *(unsigned*)(p.mixed + (size_t)(t0 + t) * DM + 1536 + 2 * tid) = pack_bf16(acc0[t] * rinv * gg.x, acc1[t] * rinv * gg.y);
    }
  }
  __syncthreads();
}

DI void post_inproj_tokens(const Params& p, int l) {
  int tidq = opaque(threadIdx.x); int lane = tidq & 63, gw = blockIdx.x * 4 + (tidq >> 6), nw = gridDim.x * 4;
  float* new_ckv = p.out + (size_t)NTOK * DM;
  float* new_krope = new_ckv + 16 * 2 * 256 * 256;
  for (int t = gw; t < NTOK + 2048; t += nw) {
    if (t >= NTOK) {
      int rr = t - NTOK; int b = rr >> 9, j = rr & 511;
      float4 v = *(const float4*)(p.cache_ckv + ((size_t)(b * 2 + l) * 512 + j) * 256 + lane * 4);
      uint2 o; o.x = pack_bf16(v.x, v.y); o.y = pack_bf16(v.z, v.w);
      *(uint2*)(p.ckv + (size_t)(NCTX + b * 1536 + j) * 256 + lane * 4) = o;
      continue;
    }
    const float* zr = p.z + (size_t)t * INW;
    {
      float4 a = *(const float4*)(zr + lane * 4), b = *(const float4*)(zr + 256 + lane * 4);
      float ss = a.x * a.x + a.y * a.y + a.z * a.z + a.w * a.w + b.x * b.x + b.y * b.y + b.z * b.z + b.w * b.w;
      ss = wave_sum(ss);
      float rinv = rsqrtf(ss * (1.f / 512.f) + 1e-6f);
      float4 g0 = *(const float4*)(p.mla_qa_g + l * 512 + lane * 4), g1 = *(const float4*)(p.mla_qa_g + l * 512 + 256 + lane * 4);
      uint2 o0, o1;
      o0.x = pack_bf16(a.x * rinv * g0.x, a.y * rinv * g0.y); o0.y = pack_bf16(a.z * rinv * g0.z, a.w * rinv * g0.w);
      o1.x = pack_bf16(b.x * rinv * g1.x, b.y * rinv * g1.y); o1.y = pack_bf16(b.z * rinv * g1.z, b.w * rinv * g1.w);
      *(uint2*)(p.qa + (size_t)t * 512 + lane * 4) = o0;
      *(uint2*)(p.qa + (size_t)t * 512 + 256 + lane * 4) = o1;
    }
    {
      float4 a = *(const float4*)(zr + OFF_ZKV + lane * 4);
      float ss = wave_sum(a.x * a.x + a.y * a.y + a.z * a.z + a.w * a.w);
      float rinv = rsqrtf(ss * (1.f / 256.f) + 1e-6f);
      float4 g = *(const float4*)(p.mla_kva_g + l * 256 + lane * 4);
      float4 o = make_float4(a.x * rinv * g.x, a.y * rinv * g.y, a.z * rinv * g.z, a.w * rinv * g.w);
      uint2 ob; ob.x = pack_bf16(o.x, o.y); ob.y = pack_bf16(o.z, o.w);
      *(uint2*)(p.ckv + (size_t)kvrow_of_token(t) * 256 + lane * 4) = ob;
      if (t < NCTX) {
        int b = t >> 8, pos = t & 255;
        *(float4*)(new_ckv + ((size_t)(b * 2 + l) * 256 + pos) * 256 + lane * 4) = o;
        new_krope[((size_t)(b * 2 + l) * 256 + pos) * 64 + lane] = zr[OFF_ZKR + lane];
      }
    }
  }
}

DI void qnorm_tokens(const Params& p, int l) {
  int tidq = opaque(threadIdx.x); int lane = tidq & 63, gw = blockIdx.x * 4 + (tidq >> 6), nw = gridDim.x * 4;
  const float qscale = 0.07216878364870322f * 1.4426950408889634f;
  const float* g = p.mla_q_g + l * 192;
  float g0 = g[lane], g1 = g[64 + lane], g2 = g[128 + lane];
  for (int t = gw; t < NTOK; t += nw) {
    const ushort_t* qr = p.qraw + (size_t)t * 1536;
    bool lat = t >= NCTX; int pos = (t - NCTX) & 1023;
    float cs = 1.f, sn = 0.f;
    if (lat) { cs = p.rope[pos * 64 + (lane & 31)]; sn = p.rope[pos * 64 + 32 + (lane & 31)]; }
#pragma unroll
    for (int hh = 0; hh < 8; hh++) {
      float a = __uint_as_float((unsigned)qr[hh * 192 + lane] << 16), b = __uint_as_float((unsigned)qr[hh * 192 + 64 + lane] << 16), c = __uint_as_float((unsigned)qr[hh * 192 + 128 + lane] << 16);
      float ss = wave_sum(a * a + b * b + c * c);
      float rinv = rsqrtf(ss * (1.f / 192.f) + 1e-6f);
      a *= rinv * g0; b *= rinv * g1; c *= rinv * g2;
      if (lat) {
        float o = __shfl_xor(c, 32);
        c = (lane < 32) ? (c * cs - o * sn) : (o * sn + c * cs);
      }
      ushort_t* qo = p.Q + (size_t)t * 1536 + hh * 192;
      qo[lane] = f2bf(a * qscale); qo[64 + lane] = f2bf(b * qscale); qo[128 + lane] = f2bf(c * qscale);
    }
  }
}

DI void kv_item(const Params& p, int l, int item, char* smem) {
  int rt = item >> 3, hh = item & 7;
  int row0 = rt * 64;
  const int tid = opaque(threadIdx.x), wave = tid >> 6, lane = tid & 63;
  float* tile = (float*)smem;
  const float* g = p.mla_k_g + l * 192;
  float g0 = g[lane], g1 = g[64 + lane], g2 = g[128 + lane];
#pragma unroll 4
  for (int i = 0; i < 16; i++) {
    int lr = wave * 16 + i; int row = row0 + lr;
    const float* kr_src; bool rot = false; int pos = 0;
    if (row < NCTX) { kr_src = p.z + (size_t)row * INW + OFF_ZKR; }
    else {
      int rr = row - NCTX; int b = rr / 1536, j = rr % 1536;
      if (j < 512) kr_src = p.cache_krope + ((size_t)(b * 2 + l) * 512 + j) * 64;
      else { pos = j - 512; kr_src = p.z + (size_t)(NCTX + b * 1024 + pos) * INW + OFF_ZKR; rot = true; }
    }
    const ushort_t* kv = p.kvraw + (size_t)row * 2048 + hh * 256;
    float a = __uint_as_float((unsigned)kv[lane] << 16), b2 = __uint_as_float((unsigned)kv[64 + lane] << 16), c = kr_src[lane];
    float ss = wave_sum(a * a + b2 * b2 + c * c);
    float rinv = rsqrtf(ss * (1.f / 192.f) + 1e-6f);
    a *= rinv * g0; b2 *= rinv * g1; c *= rinv * g2;
    if (rot) {
      float cs = p.rope[pos * 64 + (lane & 31)], sn = p.rope[pos * 64 + 32 + (lane & 31)];
      float o = __shfl_xor(c, 32);
      c = (lane < 32) ? (c * cs - o * sn) : (o * sn + c * cs);
    }
    ushort_t* ko = p.K + (size_t)row * 1536 + hh * 192;
    ko[lane] = f2bf(a); ko[64 + lane] = f2bf(b2); ko[128 + lane] = f2bf(c);
    tile[lr * 129 + lane] = __uint_as_float((unsigned)kv[128 + lane] << 16); tile[lr * 129 + 64 + lane] = __uint_as_float((unsigned)kv[192 + lane] << 16);
  }
  __syncthreads();
  size_t vbase; int T, krow0;
  if (row0 < NCTX) { int sid = row0 >> 8; vbase = (size_t)(sid * 8 + hh) * 128 * 256; T = 256; krow0 = row0 & 255; }
  else { int rr = row0 - NCTX; int b = rr / 1536; vbase = (size_t)16 * 8 * 128 * 256 + (size_t)(b * 8 + hh) * 128 * 1536; T = 1536; krow0 = rr % 1536; }
#pragma unroll
  for (int i = 0; i < 4; i++) {
    int cidx = tid + i * 256; int dv = cidx >> 3, kg = cidx & 7;
    int G = kg >> 1, hhalf = kg & 1;
    float v[8];
#pragma unroll
    for (int s = 0; s < 8; s++) { int key = 16 * G + 8 * (s >> 2) + 4 * hhalf + (s & 3); v[s] = tile[key * 129 + dv]; }
    uint4 o; o.x = pack_bf16(v[0], v[1]); o.y = pack_bf16(v[2], v[3]); o.z = pack_bf16(v[4], v[5]); o.w = pack_bf16(v[6], v[7]);
    *(uint4*)(p.Vt + vbase + (size_t)dv * T + krow0 + kg * 8) = o;
  }
  __syncthreads();
}

#define KLD 200
#define VLD 72
DI void attn_item(const Params& p, int item, char* smem) {
  const int tid = opaque(threadIdx.x), wave = tid >> 6, lane = tid & 63;
  const int qs = wave & 1, kh = wave >> 1;
  int hh, Tk, tq0, kvbase; size_t vbase;
  if (item < 512) {
    int b = item >> 7; hh = (item >> 4) & 7; int qb = item & 15;
    Tk = 1536; tq0 = NCTX + b * 1024 + qb * 64; kvbase = NCTX + b * 1536;
    vbase = (size_t)16 * 8 * 128 * 256 + (size_t)(b * 8 + hh) * 128 * 1536;
  } else {
    int i2 = item - 512; int s = i2 >> 5; hh = (i2 >> 2) & 7; int qb = i2 & 3;
    Tk = 256; tq0 = s * 256 + qb * 64; kvbase = s * 256;
    vbase = (size_t)(s * 8 + hh) * 128 * 256;
  }
  ushort_t* sK = (ushort_t*)smem;
  ushort_t* sV = sK + 64 * KLD;
  const int r = lane & 31, h = lane >> 5;
  bf16x8 qf[12];
  {
    const ushort_t* qp = p.Q + (size_t)(tq0 + qs * 32 + r) * 1536 + hh * 192 + h * 8;
#pragma unroll
    for (int s = 0; s < 12; s++) qf[s] = *(const bf16x8*)(qp + s * 16);
  }
  f32x16 O[4];
#pragma unroll
  for (int i = 0; i < 4; i++)
#pragma unroll
    for (int e = 0; e < 16; e++) O[i][e] = 0.f;
  float m = -INFINITY, lsum = 0.f;
  const int nkt = Tk >> 6;
  const ushort_t* Kg = p.K + (size_t)kvbase * 1536 + hh * 192;
  const ushort_t* Vg = p.Vt + vbase;
  u32x4 rk[6], rv[4];
#pragma unroll
  for (int i = 0; i < 6; i++) { int c = tid + i * 256; int row = c / 24, kc = (c % 24) * 8; rk[i] = GLD16(Kg + (size_t)row * 1536 + kc); }
#pragma unroll
  for (int i = 0; i < 4; i++) { int c = tid + i * 256; int dv = c >> 3, kc = (c & 7) * 8; rv[i] = GLD16(Vg + (size_t)dv * Tk + kc); }
  for (int kt = 0; kt < nkt; kt++) {
    __syncthreads();
#pragma unroll
    for (int i = 0; i < 6; i++) { int c = tid + i * 256; int row = c / 24, kc = (c % 24) * 8; *(u32x4*)(sK + row * KLD + kc) = rk[i]; }
#pragma unroll
    for (int i = 0; i < 4; i++) { int c = tid + i * 256; int dv = c >> 3, kc = (c & 7) * 8; *(u32x4*)(sV + dv * VLD + kc) = rv[i]; }
    __syncthreads();
    if (kt + 1 < nkt) {
#pragma unroll
      for (int i = 0; i < 6; i++) { int c = tid + i * 256; int row = c / 24, kc = (c % 24) * 8; rk[i] = GLD16(Kg + (size_t)((kt + 1) * 64 + row) * 1536 + kc); }
#pragma unroll
      for (int i = 0; i < 4; i++) { int c = tid + i * 256; int dv = c >> 3, kc = (c & 7) * 8; rv[i] = GLD16(Vg + (size_t)dv * Tk + (kt + 1) * 64 + kc); }
    }
    f32x16 S;
#pragma unroll
    for (int e = 0; e < 16; e++) S[e] = 0.f;
    const ushort_t* kp = sK + (kh * 32 + r) * KLD + h * 8;
#pragma unroll
    for (int s = 0; s < 12; s++) { bf16x8 kf = *(const bf16x8*)(kp + s * 16); S = MFMA32(kf, qf[s], S); }
    float mx = S[0];
#pragma unroll
    for (int e = 1; e < 16; e++) mx = fmaxf(mx, S[e]);
    mx = fmaxf(mx, __shfl_xor(mx, 32));
    float mn = fmaxf(m, mx);
    float alpha = __builtin_amdgcn_exp2f(m - mn);
    float rs = 0.f;
#pragma unroll
    for (int e = 0; e < 16; e++) { S[e] = __builtin_amdgcn_exp2f(S[e] - mn); rs += S[e]; }
    rs += __shfl_xor(rs, 32);
    lsum = lsum * alpha + rs; m = mn;
#pragma unroll
    for (int i = 0; i < 4; i++)
#pragma unroll
      for (int e = 0; e < 16; e++) O[i][e] *= alpha;
    bf16x8 pf[2];
#pragma unroll
    for (int s2 = 0; s2 < 2; s2++) {
      u32x4 u; u.x = pack_bf16(S[8 * s2], S[8 * s2 + 1]); u.y = pack_bf16(S[8 * s2 + 2], S[8 * s2 + 3]);
      u.z = pack_bf16(S[8 * s2 + 4], S[8 * s2 + 5]); u.w = pack_bf16(S[8 * s2 + 6], S[8 * s2 + 7]);
      pf[s2] = __builtin_bit_cast(bf16x8, u);
    }
    const ushort_t* vp = sV + r * VLD + kh * 32 + h * 8;
#pragma unroll
    for (int dt = 0; dt < 4; dt++)
#pragma unroll
      for (int s2 = 0; s2 < 2; s2++) {
        bf16x8 vf = *(const bf16x8*)(vp + dt * 32 * VLD + s2 * 16);
        O[dt] = MFMA32(vf, pf[s2], O[dt]);
      }
  }
  __syncthreads();
  float* cO = (float*)smem;
  float* cML = cO + 2 * 64 * 64;
  if (kh == 1) {
#pragma unroll
    for (int dt = 0; dt < 4; dt++)
#pragma unroll
      for (int e = 0; e < 16; e++) cO[(qs * 64 + dt * 16 + e) * 64 + lane] = O[dt][e];
    cML[(qs * 2 + 0) * 64 + lane] = m; cML[(qs * 2 + 1) * 64 + lane] = lsum;
  }
  __syncthreads();
  if (kh == 0) {
    float m1 = cML[(qs * 2 + 0) * 64 + lane], l1 = cML[(qs * 2 + 1) * 64 + lane];
    float mf = fmaxf(m, m1);
    float a0 = exp2f(m - mf), a1 = exp2f(m1 - mf);
    float inv = 1.f / (lsum * a0 + l1 * a1);
    a0 *= inv; a1 *= inv;
    ushort_t* op = p.attn + (size_t)(tq0 + qs * 32 + r) * 1024 + hh * 128;
#pragma unroll
    for (int dt = 0; dt < 4; dt++)
#pragma unroll
      for (int gq = 0; gq < 4; gq++) {
        float o0 = O[dt][4 * gq] * a0 + cO[(qs * 64 + dt * 16 + 4 * gq) * 64 + lane] * a1;
        float o1 = O[dt][4 * gq + 1] * a0 + cO[(qs * 64 + dt * 16 + 4 * gq + 1) * 64 + lane] * a1;
        float o2 = O[dt][4 * gq + 2] * a0 + cO[(qs * 64 + dt * 16 + 4 * gq + 2) * 64 + lane] * a1;
        float o3 = O[dt][4 * gq + 3] * a0 + cO[(qs * 64 + dt * 16 + 4 * gq + 3) * 64 + lane] * a1;
        uint2 ov; ov.x = pack_bf16(o0, o1); ov.y = pack_bf16(o2, o3); *(uint2*)(op + dt * 32 + 8 * gq + 4 * h) = ov;
      }
  }
  __syncthreads();
}

DI void merge_tokens(const Params& p, int l) {
  int tidq = opaque(threadIdx.x); int lane = tidq & 63, gw = blockIdx.x * 4 + (tidq >> 6), nw = gridDim.x * 4;
  const float* gg = p.grp_g + l * DM;
  for (int t = gw; t < NTOK; t += nw) {
    {
      const ushort_t* ar = p.attn + (size_t)t * 1024;
      float4 v[4]; float ss = 0.f;
#pragma unroll
      for (int j = 0; j < 4; j++) { uint2 u_ = *(const uint2*)(ar + j * 256 + lane * 4); v[j] = make_float4(bf_lo(u_.x), bf_hi(u_.x), bf_lo(u_.y), bf_hi(u_.y)); ss += v[j].x * v[j].x + v[j].y * v[j].y + v[j].z * v[j].z + v[j].w * v[j].w; }
      ss = wave_sum(ss);
      float rinv = rsqrtf(ss * (1.f / 1024.f) + 1e-6f);
#pragma unroll
      for (int j = 0; j < 4; j++) {
        int col = j * 256 + lane * 4; float4 g = *(const float4*)(gg + col);
        uint2 o; o.x = pack_bf16(v[j].x * rinv * g.x, v[j].y * rinv * g.y); o.y = pack_bf16(v[j].z * rinv * g.z, v[j].w * rinv * g.w);
        *(uint2*)(p.mixed + (size_t)t * DM + col) = o;
      }
    }
    {
      float val[8]; float ss = 0.f;
      int ch = t >> 8;
#pragma unroll
      for (int j = 0; j < 2; j++) {
        int col = j * 256 + lane * 4;
        float cf[4] = {0, 0, 0, 0}, cbk[4] = {0, 0, 0, 0};
        if (t >= NCTX) {
          int b = (t - NCTX) >> 10, cc = (ch - 16) & 3, chb = 16 + b * 4;
          float4 h0f = *(const float4*)(p.state_lru + ((size_t)(b * 2 + l) * 2 + 0) * 512 + col);
          float4 h0b = *(const float4*)(p.state_lru + ((size_t)(b * 2 + l) * 2 + 1) * 512 + col);
          cf[0] = h0f.x; cf[1] = h0f.y; cf[2] = h0f.z; cf[3] = h0f.w;
          cbk[0] = h0b.x; cbk[1] = h0b.y; cbk[2] = h0b.z; cbk[3] = h0b.w;
          for (int jj = 0; jj < cc; jj++) {
            float4 he = *(const float4*)(p.hend + (size_t)(0 * 32 + chb + jj) * 512 + col), pe = *(const float4*)(p.Pend + (size_t)(0 * 32 + chb + jj) * 512 + col);
            cf[0] = he.x + pe.x * cf[0]; cf[1] = he.y + pe.y * cf[1]; cf[2] = he.z + pe.z * cf[2]; cf[3] = he.w + pe.w * cf[3];
          }
          for (int jj = 3; jj > cc; jj--) {
            float4 he = *(const float4*)(p.hend + (size_t)(1 * 32 + chb + jj) * 512 + col), pe = *(const float4*)(p.Pend + (size_t)(1 * 32 + chb + jj) * 512 + col);
            cbk[0] = he.x + pe.x * cbk[0]; cbk[1] = he.y + pe.y * cbk[1]; cbk[2] = he.z + pe.z * cbk[2]; cbk[3] = he.w + pe.w * cbk[3];
          }
        }
        uint2 uhf = *(const uint2*)(p.hs + ((size_t)0 * NTOK + t) * 512 + col), upf = *(const uint2*)(p.Pc + ((size_t)0 * NTOK + t) * 512 + col);
        uint2 uhb = *(const uint2*)(p.hs + ((size_t)1 * NTOK + t) * 512 + col), upb = *(const uint2*)(p.Pc + ((size_t)1 * NTOK + t) * 512 + col);
        float4 hf_ = make_float4(bf_lo(uhf.x), bf_hi(uhf.x), bf_lo(uhf.y), bf_hi(uhf.y)), pf_ = make_float4(bf_lo(upf.x), bf_hi(upf.x), bf_lo(upf.y), bf_hi(upf.y));
        float4 hb_ = make_float4(bf_lo(uhb.x), bf_hi(uhb.x), bf_lo(uhb.y), bf_hi(uhb.y)), pb_ = make_float4(bf_lo(upb.x), bf_hi(upb.x), bf_lo(upb.y), bf_hi(upb.y));
        float4 zg = *(const float4*)(p.z + (size_t)t * INW + OFF_ZG + col);
        float y0 = hf_.x + pf_.x * cf[0] + hb_.x + pb_.x * cbk[0];
        float y1 = hf_.y + pf_.y * cf[1] + hb_.y + pb_.y * cbk[1];
        float y2 = hf_.z + pf_.z * cf[2] + hb_.z + pb_.z * cbk[2];
        float y3 = hf_.w + pf_.w * cf[3] + hb_.w + pb_.w * cbk[3];
        y0 *= gelu_tanh(zg.x); y1 *= gelu_tanh(zg.y); y2 *= gelu_tanh(zg.z); y3 *= gelu_tanh(zg.w);
        val[j * 4] = y0; val[j * 4 + 1] = y1; val[j * 4 + 2] = y2; val[j * 4 + 3] = y3;
        ss += y0 * y0 + y1 * y1 + y2 * y2 + y3 * y3;
      }
      ss = wave_sum(ss);
      float rinv = rsqrtf(ss * (1.f / 512.f) + 1e-6f);
#pragma unroll
      for (int j = 0; j < 2; j++) {
        int col = j * 256 + lane * 4; float4 g = *(const float4*)(gg + 1024 + col);
        uint2 o; o.x = pack_bf16(val[j * 4] * rinv * g.x, val[j * 4 + 1] * rinv * g.y); o.y = pack_bf16(val[j * 4 + 2] * rinv * g.z, val[j * 4 + 3] * rinv * g.w);
        *(uint2*)(p.mixed + (size_t)t * DM + 1024 + col) = o;
      }
    }
  }
}

#define TOPK_INS(TV, TI, XV, XI) { float xv_ = (XV); int xi_ = (XI); _Pragma("unroll") for (int i_ = 0; i_ < 16; i_++) { bool c_ = xv_ > TV[i_]; float nv_ = c_ ? xv_ : TV[i_]; float ov_ = c_ ? TV[i_] : xv_; int ni_ = c_ ? xi_ : TI[i_]; int oi_ = c_ ? TI[i_] : xi_; TV[i_] = nv_; TI[i_] = ni_; xv_ = ov_; xi_ = oi_; } }
DI void peer_phase(const Params& p, int l, char* smem) {
  const int tid = opaque(threadIdx.x), wave = tid >> 6, lane = tid & 63;
  float* wsm = (float*)(smem + wave * 12288);
  float* lv = wsm;
  int* lidx = (int*)(wsm + 1024);
  int* pki = (int*)(wsm + 2048);
  float* pkg = wsm + 2560;
  const float* scores = p.z;
  const unsigned char* Ub = p.Ub + (size_t)l * NEXP * DM;
  const unsigned char* Vb = p.Vb + (size_t)l * NEXP * DM;
  const float* Us = p.Us + l * NEXP;
  const float* Vs = p.Vs + l * NEXP;
  float* dst = l == 0 ? p.xA : p.out;
  for (int tb = blockIdx.x; tb < NTOK / 16; tb += gridDim.x) {
    const int tg = tb * 4 + wave;
    {
      const GAS f32x4* sp = (const GAS f32x4*)(scores + (size_t)(tg * 4 + (lane >> 4)) * 2048 + (lane & 15) * 128);
      float tv[16]; int ti[16];
#pragma unroll
      for (int i = 0; i < 16; i++) { tv[i] = -INFINITY; ti[i] = 0; }
      for (int k = 0; k < 128; k += 8) {
        float x[8];
        { f32x4 xa_ = sp[k >> 2], xb_ = sp[(k >> 2) + 1]; x[0] = xa_[0]; x[1] = xa_[1]; x[2] = xa_[2]; x[3] = xa_[3]; x[4] = xb_[0]; x[5] = xb_[1]; x[6] = xb_[2]; x[7] = xb_[3]; }
#pragma unroll
        for (int u = 0; u < 8; u++) TOPK_INS(tv, ti, x[u], k + u);
      }
#pragma unroll
      for (int i = 0; i < 16; i++) { lv[i * 64 + lane] = tv[i]; lidx[i * 64 + lane] = ti[i]; }
    }
    __syncthreads();
    if (lane < 32) {
      const int tt = lane >> 3, hh = lane & 7;
      const int la = tt * 16 + 2 * hh, lb = la + 1;
      float s1[16], s2[16];
#pragma unroll
      for (int i = 0; i < 16; i++) { s1[i] = lv[i * 64 + la]; s2[i] = lv[i * 64 + lb]; }
      float cv[16]; int cf[16];
#pragma unroll
      for (int i = 0; i < 16; i++) { cv[i] = -INFINITY; cf[i] = 0; }
#pragma unroll
      for (int i = 0; i < 16; i++) {
#pragma unroll
        for (int j = 0; j < 16; j++) {
          if ((i + 1) * (j + 1) <= 16) TOPK_INS(cv, cf, s1[i] + s2[j], i * 16 + j);
        }
      }
      float e[16]; float sum = 0.f;
#pragma unroll
      for (int r = 0; r < 16; r++) { e[r] = __expf(cv[r] - cv[0]); sum += e[r]; }
      const float inv = 1.f / sum;
#pragma unroll
      for (int r = 0; r < 16; r++) {
        int id = lidx[(cf[r] >> 4) * 64 + la] * 128 + lidx[(cf[r] & 15) * 64 + lb];
        pki[tt * 128 + hh * 16 + r] = id; pkg[tt * 128 + hh * 16 + r] = e[r] * inv;
      }
    }
    __syncthreads();
    for (int tt = 0; tt < 4; tt++) {
    const int t = tg * 4 + tt;
    const int idx0 = pki[tt * 128 + lane], idx1 = pki[tt * 128 + 64 + lane];
    const float g0 = pkg[tt * 128 + lane], g1 = pkg[tt * 128 + 64 + lane];
    float xs[32];
#pragma unroll
    for (int j = 0; j < 2; j++) {
      const uint4* xp = (const uint4*)(p.hn + (size_t)t * DM + (j * 64 + lane) * 16);
      uint4 xa = xp[0], xb = xp[1];
      xs[j * 16 + 0] = bf_lo(xa.x); xs[j * 16 + 1] = bf_hi(xa.x); xs[j * 16 + 2] = bf_lo(xa.y); xs[j * 16 + 3] = bf_hi(xa.y);
      xs[j * 16 + 4] = bf_lo(xa.z); xs[j * 16 + 5] = bf_hi(xa.z); xs[j * 16 + 6] = bf_lo(xa.w); xs[j * 16 + 7] = bf_hi(xa.w);
      xs[j * 16 + 8] = bf_lo(xb.x); xs[j * 16 + 9] = bf_hi(xb.x); xs[j * 16 + 10] = bf_lo(xb.y); xs[j * 16 + 11] = bf_hi(xb.y);
      xs[j * 16 + 12] = bf_lo(xb.z); xs[j * 16 + 13] = bf_hi(xb.z); xs[j * 16 + 14] = bf_lo(xb.w); xs[j * 16 + 15] = bf_hi(xb.w);
    }
    const float us0 = Us[idx0], us1 = Us[idx1], vs0 = Vs[idx0], vs1 = Vs[idx1];
    float a0 = 0.f, a1 = 0.f;
    {
      u32x4 ld[8][2];
#pragma unroll
      for (int rr = 0; rr < 8; rr++) {
        int idx = __builtin_amdgcn_readlane(idx0, rr);
        const unsigned char* row = Ub + (size_t)idx * DM;
#pragma unroll
        for (int j = 0; j < 2; j++) ld[rr][j] = GLD16(row + (j * 64 + lane) * 16);
      }
      for (int k0 = 0; k0 < 128; k0 += 8) {
        int nsrc = (k0 + 8 < 64) ? idx0 : idx1;
        float part[8];
#pragma unroll
        for (int rr = 0; rr < 8; rr++) {
          float s = 0.f;
#pragma unroll
          for (int j = 0; j < 2; j++)
#pragma unroll
            for (int q = 0; q < 4; q++) {
              f32x2_t lo = __builtin_amdgcn_cvt_pk_f32_fp8((int)ld[rr][j][q], false);
              f32x2_t hi = __builtin_amdgcn_cvt_pk_f32_fp8((int)ld[rr][j][q], true);
              s += lo[0] * xs[j * 16 + q * 4] + lo[1] * xs[j * 16 + q * 4 + 1] + hi[0] * xs[j * 16 + q * 4 + 2] + hi[1] * xs[j * 16 + q * 4 + 3];
            }
          part[rr] = s;
          if (k0 + 8 < 128) {
            int idx = __builtin_amdgcn_readlane(nsrc, (k0 + 8 + rr) & 63);
            const unsigned char* row = Ub + (size_t)idx * DM;
#pragma unroll
            for (int j = 0; j < 2; j++) ld[rr][j] = GLD16(row + (j * 64 + lane) * 16);
          }
        }
#pragma unroll
        for (int o = 32; o; o >>= 1) {
#pragma unroll
          for (int rr = 0; rr < 8; rr++) part[rr] += __shfl_xor(part[rr], o);
        }
#pragma unroll
        for (int rr = 0; rr < 8; rr++) {
          if (lane == ((k0 + rr) & 63)) { if (k0 < 64) a0 = part[rr]; else a1 = part[rr]; }
        }
      }
    }
    float w0 = g0 * gelu_tanh(a0 * us0) * vs0, w1 = g1 * gelu_tanh(a1 * us1) * vs1;
    float acc[32];
#pragma unroll
    for (int e = 0; e < 32; e++) acc[e] = 0.f;
    {
      u32x4 ld[4][2];
#pragma unroll
      for (int rr = 0; rr < 4; rr++) {
        int idx = __builtin_amdgcn_readlane(idx0, rr);
        const unsigned char* row = Vb + (size_t)idx * DM;
#pragma unroll
        for (int j = 0; j < 2; j++) ld[rr][j] = GLD16(row + (j * 64 + lane) * 16);
      }
      for (int k0 = 0; k0 < 128; k0 += 4) {
        float wsrc = (k0 < 64) ? w0 : w1;
        int nsrc = (k0 + 4 < 64) ? idx0 : idx1;
#pragma unroll
        for (int rr = 0; rr < 4; rr++) {
          float w = rdlane_f(wsrc, (k0 + rr) & 63);
#pragma unroll
          for (int j = 0; j < 2; j++)
#pragma unroll
            for (int q = 0; q < 4; q++) {
              f32x2_t lo = __builtin_amdgcn_cvt_pk_f32_fp8((int)ld[rr][j][q], false);
              f32x2_t hi = __builtin_amdgcn_cvt_pk_f32_fp8((int)ld[rr][j][q], true);
              acc[j * 16 + q * 4 + 0] += w * lo[0]; acc[j * 16 + q * 4 + 1] += w * lo[1];
              acc[j * 16 + q * 4 + 2] += w * hi[0]; acc[j * 16 + q * 4 + 3] += w * hi[1];
            }
          if (k0 + 4 < 128) {
            int idx = __builtin_amdgcn_readlane(nsrc, (k0 + 4 + rr) & 63);
            const unsigned char* row = Vb + (size_t)idx * DM;
#pragma unroll
            for (int j = 0; j < 2; j++) ld[rr][j] = GLD16(row + (j * 64 + lane) * 16);
          }
        }
      }
    }
    const float* md = p.mod + (size_t)(l * 5 + cvidx(t)) * 12288 + 10240;
    float ssq = 0.f;
#pragma unroll
    for (int j = 0; j < 2; j++)
#pragma unroll
      for (int q = 0; q < 4; q++) {
        int col = (j * 64 + lane) * 16 + q * 4;
        float4 xa = *(const float4*)(p.x1 + (size_t)t * DM + col);
        float4 ga = *(const float4*)(md + col);
        float4 oa = make_float4(xa.x + ga.x * acc[j * 16 + q * 4], xa.y + ga.y * acc[j * 16 + q * 4 + 1], xa.z + ga.z * acc[j * 16 + q * 4 + 2], xa.w + ga.w * acc[j * 16 + q * 4 + 3]);
        *(float4*)(dst + (size_t)t * DM + col) = oa;
        acc[j * 16 + q * 4] = oa.x; acc[j * 16 + q * 4 + 1] = oa.y; acc[j * 16 + q * 4 + 2] = oa.z; acc[j * 16 + q * 4 + 3] = oa.w;
        ssq += oa.x * oa.x + oa.y * oa.y + oa.z * oa.z + oa.w * oa.w;
      }
    if (l == 0) {
      ssq = wave_sum(ssq);
      const float rinv = rsqrtf(ssq * (1.f / DM) + 1e-6f);
      const float* g = p.norm_mix_g + DM;
      const float* md1 = p.mod + (size_t)(5 + cvidx(t)) * 12288;
#pragma unroll
      for (int j = 0; j < 2; j++)
#pragma unroll
        for (int q = 0; q < 4; q++) {
          int col = (j * 64 + lane) * 16 + q * 4;
          float4 gg = *(const float4*)(g + col), sc = *(const float4*)(md1 + 2048 + col), sh = *(const float4*)(md1 + col);
          float y0 = acc[j * 16 + q * 4] * rinv * gg.x * (1.f + sc.x) + sh.x;
          float y1 = acc[j * 16 + q * 4 + 1] * rinv * gg.y * (1.f + sc.y) + sh.y;
          float y2 = acc[j * 16 + q * 4 + 2] * rinv * gg.z * (1.f + sc.z) + sh.z;
          float y3 = acc[j * 16 + q * 4 + 3] * rinv * gg.w * (1.f + sc.w) + sh.w;
          uint2 o; o.x = pack_bf16(y0, y1); o.y = pack_bf16(y2, y3);
          *(uint2*)(p.hn + (size_t)t * DM + col) = o;
        }
    }
    }
    __syncthreads();
  }
}

#define XB_TMO      128
#define XB_XCNT(j)  (256  + 64 * (j))
#define XB_XSUB(j)  (1280 + 64 * (j))
#define XB_XGEN(j)  (2304 + 64 * (j))
#define XB_TOP      3328
#define XB_TOPGEN   3392
#define XCD_BAR_WORDS 3456
#define XB_SPIN_CAP (1u << 18)
#define LAS __attribute__((address_space(3)))

__device__ __forceinline__ unsigned xb_ld(unsigned* p)              { return __hip_atomic_load(p, __ATOMIC_RELAXED, __HIP_MEMORY_SCOPE_AGENT); }
__device__ __forceinline__ unsigned xb_add(unsigned* p, unsigned v) { return __hip_atomic_fetch_add(p, v, __ATOMIC_RELAXED, __HIP_MEMORY_SCOPE_AGENT); }
__device__ __forceinline__ unsigned xb_xcc_id() { return (unsigned)__builtin_amdgcn_s_getreg((3 << 11) | 20) & 0xFu; }
#define XB_SPIN(cond, bar) do { unsigned _sp = 0; while (cond) { __builtin_amdgcn_s_sleep(1); \
    if ((++_sp & 255u) == 0u) { if (xb_ld(&(bar)[XB_TMO])) break; if (_sp > XB_SPIN_CAP) { atomicAdd(&(bar)[XB_TMO], 1u); break; } } } } while (0)

struct XcdBarrier {
    unsigned* bar; unsigned x;
    volatile LAS unsigned* st;
};

__device__ __forceinline__ XcdBarrier xcd_barrier_post(unsigned* bar, volatile LAS unsigned* st) {
    XcdBarrier b; b.bar = bar; b.x = xb_xcc_id(); b.st = st;
    if (threadIdx.x == 0) (void)xb_add(&bar[XB_XCNT(b.x)], 1u);
    return b;
}
__device__ __forceinline__ void xcd_barrier_complete(unsigned* bar, unsigned x, unsigned& nloc, unsigned& nx) {
    const unsigned G = gridDim.x * gridDim.y * gridDim.z;
    unsigned sum, cnt, mine, sp = 0u;
    for (;;) {
        sum = 0u; cnt = 0u; mine = 0u;
#pragma unroll
        for (unsigned j = 0; j < 16; ++j) { const unsigned c = xb_ld(&bar[XB_XCNT(j)]); sum += c; cnt += (c > 0u) ? 1u : 0u; mine = (j == x) ? c : mine; }
        if (sum == G) break;
        __builtin_amdgcn_s_sleep(1);
        if ((++sp & 255u) == 0u) { if (xb_ld(&bar[XB_TMO])) break; if (sp > XB_SPIN_CAP) { atomicAdd(&bar[XB_TMO], 1u); break; } }
    }
    nloc = mine > 0u ? mine : 1u; nx = cnt > 0u ? cnt : 1u;
}

__device__ __forceinline__ void xcd_barrier(const XcdBarrier& b) {
    asm volatile("s_waitcnt vmcnt(0)" ::: "memory");
    __syncthreads();
    if (threadIdx.x == 0) {
        unsigned* bar;
        {
            const unsigned long long bp = (unsigned long long)b.bar;
            const unsigned lo = (unsigned)__builtin_amdgcn_readfirstlane(opaque((int)(unsigned)bp));
            const unsigned hi = (unsigned)__builtin_amdgcn_readfirstlane(opaque((int)(unsigned)(bp >> 32)));
            bar = (unsigned*)(((unsigned long long)hi << 32) | lo);
        }
        const unsigned bx = xb_xcc_id() + (unsigned)opaque(0);
        __builtin_amdgcn_s_waitcnt(0);
        unsigned nloc = b.st[0], nx = b.st[1];
        if (nloc == 0u) { xcd_barrier_complete(bar, bx, nloc, nx); b.st[0] = nloc; b.st[1] = nx; }
        const unsigned old = xb_add(&bar[XB_XSUB(bx)], 1u);
        const unsigned gen = old / nloc;
        if (old + 1u == (gen + 1u) * nloc) {
            __builtin_amdgcn_fence(__ATOMIC_RELEASE, "agent");
            asm volatile("s_waitcnt vmcnt(0)" ::: "memory");
            const unsigned og = xb_add(&bar[XB_TOP], 1u);
            const unsigned tg = og / nx;
            if (og + 1u == (tg + 1u) * nx) xb_add(&bar[XB_TOPGEN], 1u);
            else XB_SPIN(xb_ld(&bar[XB_TOPGEN]) == tg, bar);
            __builtin_amdgcn_fence(__ATOMIC_ACQUIRE, "agent");
            xb_add(&bar[XB_XGEN(bx)], 1u);
            asm volatile("s_waitcnt vmcnt(0)" ::: "memory");
        } else {
            XB_SPIN(xb_ld(&bar[XB_XGEN(bx)]) == gen, bar);
            __builtin_amdgcn_fence(__ATOMIC_ACQUIRE, "agent");
            asm volatile("s_waitcnt vmcnt(0)" ::: "memory");
        }
    }
    __syncthreads();
}


DI void gsync(unsigned* bar, unsigned& gen) {
  asm volatile("s_waitcnt vmcnt(0) lgkmcnt(0)" ::: "memory");
  __syncthreads();
  if (threadIdx.x == 0) {
    __builtin_amdgcn_fence(__ATOMIC_RELEASE, "agent");
    asm volatile("s_waitcnt vmcnt(0)" ::: "memory");
    gen++;
    const unsigned ng = gridDim.x >> 3;
    unsigned* gc = bar + 32 * (1 + (blockIdx.x & 7));
    (void)__hip_atomic_fetch_add(gc, 1u, __ATOMIC_RELAXED, __HIP_MEMORY_SCOPE_AGENT);
    if (blockIdx.x < 8) {
      const unsigned gt = gen * ng;
      while (__hip_atomic_load(gc, __ATOMIC_RELAXED, __HIP_MEMORY_SCOPE_AGENT) < gt) __builtin_amdgcn_s_sleep(1);
      (void)__hip_atomic_fetch_add(bar, 1u, __ATOMIC_RELAXED, __HIP_MEMORY_SCOPE_AGENT);
    }
    const unsigned target = gen * 8u;
    while (__hip_atomic_load(bar, __ATOMIC_RELAXED, __HIP_MEMORY_SCOPE_AGENT) < target) __builtin_amdgcn_s_sleep(4);
    __builtin_amdgcn_fence(__ATOMIC_ACQUIRE, "agent");
    asm volatile("s_waitcnt vmcnt(0)" ::: "memory");
  }
  __syncthreads();
}

DI void dump_bf16(const Params& p, const ushort_t* src) {
  size_t n = (size_t)NTOK * DM; size_t tot = n + 16 * 2 * 256 * 256 + 16 * 2 * 256 * 64 + 16 * 2 * 2 * 512;
  for (size_t i = (size_t)blockIdx.x * 256 + threadIdx.x; i < tot; i += (size_t)gridDim.x * 256)
    p.out[i] = i < n ? __uint_as_float(((unsigned)src[i]) << 16) : (i < n + 2 * 5 * 12288 ? p.mod[i - n] : 0.f);
}


DI void dump_f32(const Params& p, const float* src, size_t n) {
  size_t tot = (size_t)NTOK * DM + 16 * 2 * 256 * 256 + 16 * 2 * 256 * 64 + 16 * 2 * 2 * 512;
  for (size_t i = (size_t)blockIdx.x * 256 + threadIdx.x; i < tot; i += (size_t)gridDim.x * 256)
    p.out[i] = i < n ? src[i] : 0.f;
}

__global__ void __launch_bounds__(256, 2) fwd_megakernel(Params pk) {
  __shared__ __attribute__((aligned(16))) char smem[SMEM_BYTES];
  __shared__ __attribute__((aligned(16))) unsigned long long spw[(sizeof(Params) + 7) / 8];
  {
    const unsigned long long* ka = (const unsigned long long*)__builtin_amdgcn_kernarg_segment_ptr();
    if (threadIdx.x < (sizeof(Params) + 7) / 8) spw[threadIdx.x] = ka[threadIdx.x];
    __syncthreads();
  }
#define PP (*(const Params*)((const char*)spw + opaque(0)))
  __shared__ uint4 xb_words;
  if (threadIdx.x == 0) xb_words = make_uint4(0u, 0u, 0u, 0u);
  __syncthreads();
  const XcdBarrier xb = xcd_barrier_post(PP.bar, (volatile LAS unsigned*)&xb_words);
  const int nb = gridDim.x, bid = blockIdx.x;
  const int wave = threadIdx.x >> 6, lane = threadIdx.x & 63;

  for (int rep = 0; rep < REP_A; rep++) {
  { const Params& p = PP; prep_phase(p, smem); }
  xcd_barrier(xb);
  }

  for (int l = 0; l < 2; l++) {
    for (int rep = 0; rep < REP_D; rep++) {
    if (l == 0) { { const Params& p = PP; norm_phase(p, l, 0); } xcd_barrier(xb); }
    }
    for (int rep = 0; rep < REP_B; rep++) {
    {
      const Params& p = PP;
      const ushort_t* Bt = p.WinT + (size_t)l * INW * DM;
      float* z = p.z;
      for (int j = bid >> 3; j < 192; j += nb >> 3) {
        int mt = (bid & 7) * 8 + ((j & 63) >> 3), nt = (j >> 6) * 8 + (j & 7);
        if (nt >= 23) continue;
        gemm_tile(p.hn, DM, Bt, DM, DM, INW, mt * 128, nt * 128, smem, [&](int row, int col, float v) { z[(size_t)row * INW + col] = v; });
      }
    }
    xcd_barrier(xb);
    }
    for (int rep = 0; rep < REP_D; rep++) {
    {
      const Params& p = PP;
      for (int it = bid; it < 512 + NTOK / CMT; it += nb) {
        if (it < 512) lru_item(p, l, it, smem); else cm_item(p, l, it - 512, smem);
      }
    }
    { const Params& p = PP; post_inproj_tokens(p, l); }
    xcd_barrier(xb);
    }
    for (int rep = 0; rep < REP_B; rep++) {
    {
      const Params& p = PP;
      const ushort_t* Bq = p.WqbT + (size_t)l * 1536 * 512;
      const ushort_t* Bkv = p.WkvbT + (size_t)l * 2048 * 256;
      ushort_t* qraw = p.qraw; ushort_t* kvraw = p.kvraw;
      for (int j = bid >> 3; j < 256; j += nb >> 3) {
        if (j < 160) {
          int rem = j % 80; int mt = (bid & 7) * 10 + (rem >> 3), nt = (j / 80) * 8 + (rem & 7);
          gemm_tile(p.ckv, 256, Bkv, 256, 256, 2048, mt * 128, nt * 128, smem, [&](int row, int col, float v) { kvraw[(size_t)row * 2048 + col] = f2bf(v); });
        } else {
          int j2 = j - 160; int rem = j2 % 48; int mt = (bid & 7) * 8 + rem / 6, nt = (j2 / 48) * 6 + rem % 6;
          gemm_tile(p.qa, 512, Bq, 512, 512, 1536, mt * 128, nt * 128, smem, [&](int row, int col, float v) { qraw[(size_t)row * 1536 + col] = f2bf(v); });
        }
      }
    }
    xcd_barrier(xb);
    }
    for (int rep = 0; rep < REP_D; rep++) {
    { const Params& p = PP; for (int it = bid; it < 160 * 8; it += nb) kv_item(p, l, it, smem); }
    { const Params& p = PP; qnorm_tokens(p, l); }
    xcd_barrier(xb);
    }
    for (int rep = 0; rep < REP_D; rep++) {
    { const Params& p = PP; for (int it = bid; it < 1024; it += nb) attn_item(p, it, smem); }
    xcd_barrier(xb);
    }
    for (int rep = 0; rep < REP_D; rep++) {
    { const Params& p = PP; merge_tokens(p, l); }
    xcd_barrier(xb);
    }
    for (int rep = 0; rep < REP_B; rep++) {
    {
      const Params& p = PP;
      const ushort_t* Bt = p.WoutT + (size_t)l * DM * DM;
      float* x1 = p.x1;
      for (int j = bid >> 3; j < 128; j += nb >> 3) {
        int mt = (bid & 7) * 8 + ((j & 63) >> 3), nt = (j >> 6) * 8 + (j & 7);
        gemm_tile(p.mixed, DM, Bt, DM, DM, DM, mt * 128, nt * 128, smem, [&](int row, int col, float v) {
          const float* xr = xrow_in(p, l, row);
          float g1 = p.mod[(size_t)(l * 5 + cvidx(row)) * 12288 + 4096 + col];
          x1[(size_t)row * DM + col] = xr[col] + g1 * v;
        });
      }
    }
    xcd_barrier(xb);
    }
    for (int rep = 0; rep < REP_D; rep++) {
    { const Params& p = PP; norm_phase(p, l, 1); }
    xcd_barrier(xb);
    }
    for (int rep = 0; rep < REP_B; rep++) {
    {
      const Params& p = PP;
      const ushort_t* Bt = p.WpqT + (size_t)l * DM * DM;
      const ushort_t* Kb = p.KeysB + (size_t)l * 2048 * 128;
      float* sc = (float*)p.z;
      ushort_t* sP = (ushort_t*)smem;
      for (int j = bid >> 3; j < 128; j += nb >> 3) {
        int mt = (bid & 7) * 8 + ((j & 63) >> 3), nt = (j >> 6) * 8 + (j & 7);
        gemm_tile(p.hn, DM, Bt, DM, DM, DM, mt * 128, nt * 128, smem, [&](int row, int col, float v) { sP[(row - mt * 128) * PLD + (col - nt * 128)] = f2bf(v); });
        scores_tile(Kb + (size_t)nt * 128 * 128, sc, mt, nt, smem);
      }
    }
    xcd_barrier(xb);
    }
    for (int rep = 0; rep < REP_C; rep++) {
    { const Params& p = PP; peer_phase(p, l, smem); }
    xcd_barrier(xb);
    }
  }
}

extern "C" void kernel_launch(void* const* d_in, const int* in_sizes, int n_in, void* d_out, int out_size, void* d_ws, size_t ws_size, hipStream_t stream) {
  static int grid_blocks = 0;
  if (!grid_blocks) {
    int dev = 0, cus = 0, per_cu = 0;
    hipGetDevice(&dev);
    hipDeviceGetAttribute(&cus, hipDeviceAttributeMultiprocessorCount, dev);
    hipOccupancyMaxActiveBlocksPerMultiprocessor(&per_cu, fwd_megakernel, 256, 0);
    if (per_cu > 2) per_cu = 2;
    if (per_cu < 1) per_cu = 1;
    grid_blocks = (cus * per_cu) & ~7;
  }
  Params p{};
  const float** pin = (const float**)&p;
  for (int i = 0; i < 35; i++) pin[i] = (const float*)d_in[i];
  p.out = (float*)d_out;
  char* w = (char*)d_ws; size_t off = 0;
  auto take = [&](size_t bytes) { char* r = w + off; off += (bytes + 255) & ~(size_t)255; return r; };
  p.bar = (unsigned*)take(16384);
  p.WinT = (ushort_t*)take((size_t)2 * INW * DM * 2);
  p.WqbT = (ushort_t*)take((size_t)2 * 1536 * 512 * 2);
  p.WkvbT = (ushort_t*)take((size_t)2 * 2048 * 256 * 2);
  p.WoutT = (ushort_t*)take((size_t)2 * DM * DM * 2);
  p.WpqT = (ushort_t*)take((size_t)2 * DM * DM * 2);
  p.KeysB = (ushort_t*)take((size_t)2 * 2048 * 128 * 2);
  p.LruW = (ushort_t*)take((size_t)2 * 16 * 2 * 4096 * 2);
  p.Ub = (unsigned char*)take((size_t)2 * NEXP * DM);
  p.Vb = (unsigned char*)take((size_t)2 * NEXP * DM);
  p.Us = (float*)take((size_t)2 * NEXP * 4);
  p.Vs = (float*)take((size_t)2 * NEXP * 4);
  p.hn = (ushort_t*)take((size_t)NTOK * DM * 2);
  p.qa = (ushort_t*)take((size_t)NTOK * 512 * 2);
  p.ckv = (ushort_t*)take((size_t)NKV * 256 * 2);
  p.Q = (ushort_t*)take((size_t)NTOK * 1536 * 2);
  p.K = (ushort_t*)take((size_t)NKV * 1536 * 2);
  p.Vt = (ushort_t*)take((size_t)NKV * 1024 * 2);
  p.mixed = (ushort_t*)take((size_t)NTOK * DM * 2);
  p.z = (float*)take((size_t)NTOK * INW * 4);
  p.qraw = (ushort_t*)take((size_t)NTOK * 1536 * 2);
  p.kvraw = (ushort_t*)take((size_t)NKV * 2048 * 2);
  p.attn = (ushort_t*)take((size_t)NTOK * 1024 * 2);
  p.hs = (ushort_t*)take((size_t)2 * NTOK * 512 * 2);
  p.Pc = (ushort_t*)take((size_t)2 * NTOK * 512 * 2);
  p.hend = (float*)take((size_t)2 * 32 * 512 * 4);
  p.Pend = (float*)take((size_t)2 * 32 * 512 * 4);
  p.x1 = (float*)take((size_t)NTOK * DM * 4);
  p.xA = (float*)take((size_t)NTOK * DM * 4);
  p.mod = (float*)take((size_t)2 * 5 * 12288 * 4);
  p.rope = (float*)take((size_t)1024 * 64 * 4);
  if (off > ws_size) { fprintf(stderr, "workspace too small: need %zu have %zu\n", off, ws_size); return; }
  if (hipMemsetAsync(p.bar, 0, 16384, stream) != hipSuccess) { fprintf(stderr, "memset failed\n"); return; }
  hipLaunchKernelGGL(fwd_megakernel, dim3(grid_blocks), dim3(256), 0, stream, p);
}
```
